# Optimizing an MI355X kernel written in HIP

```python
import math
import jax
import jax.numpy as jnp
from jax import lax
import numpy as np

D_MODEL = 1024
BATCH = 1
SEQ = 16384
DEPTH = 2

ATT_HEAD_DIM = D_MODEL // 16
FOX_HEADS = 4
MLSTM_HEADS = 4
MLSTM_HEAD_DIM = D_MODEL // 8
MOBA_HEADS = 4
FOX_W = FOX_HEADS * ATT_HEAD_DIM
MLSTM_W = MLSTM_HEADS * MLSTM_HEAD_DIM
MOBA_W = MOBA_HEADS * ATT_HEAD_DIM
MIX_W = FOX_W + MLSTM_W + MOBA_W
IN_SPLITS = [FOX_W, FOX_W, FOX_W, FOX_HEADS,
             MLSTM_W, MLSTM_W, MLSTM_W, MLSTM_HEADS, MLSTM_HEADS, MLSTM_W,
             MOBA_W, MOBA_W, MOBA_W]
IN_W = sum(IN_SPLITS)

ROPE_DIM = ATT_HEAD_DIM // 4
ROPE_THETA = 500000.0
Q_BLOCK = 128
MLSTM_CHUNK = 128
CONV_WIDTH = 4
MOBA_BLOCK = 256
MOBA_TOPK = 3

N_GROUPS = 4
EXPERTS_PER_GROUP = 8
N_EXPERTS = N_GROUPS * EXPERTS_PER_GROUP
EXPERT_TOPK = 2
D_EXPERT = 512
MOE_BLOCK = 128

ALPHA = (2 * DEPTH) ** 0.25
BETA = (8 * DEPTH) ** -0.25
EPS = 1e-5

kernel_name = 'hymba_fox_mlstm_moba_hmoe_deepnorm'


def layer_norm(x, g, b):
    xf = x.astype(jnp.float32)
    mu = jnp.mean(xf, -1, keepdims=True)
    var = jnp.mean(jnp.square(xf - mu), -1, keepdims=True)
    return ((xf - mu) * lax.rsqrt(var + EPS) * g + b).astype(x.dtype)


def headwise_rms(u, g, n_heads):
    B, S, W = u.shape
    uf = u.astype(jnp.float32).reshape(B, S, n_heads, W // n_heads)
    uf = uf * lax.rsqrt(jnp.mean(jnp.square(uf), -1, keepdims=True) + EPS)
    return (uf.reshape(B, S, W) * g).astype(u.dtype)


def partial_rope(u, positions):
    half = ROPE_DIM // 2
    inv = 1.0 / (ROPE_THETA ** (jnp.arange(0, ROPE_DIM, 2, dtype=jnp.float32) / ROPE_DIM))
    ang = positions.astype(jnp.float32)[..., None] * inv
    cos = jnp.cos(ang)[:, :, None, :]
    sin = jnp.sin(ang)[:, :, None, :]
    ur = u[..., :ROPE_DIM].astype(jnp.float32)
    u1, u2 = ur[..., :half], ur[..., half:]
    rot = jnp.concatenate([u1 * cos - u2 * sin, u1 * sin + u2 * cos], -1)
    return jnp.concatenate([rot.astype(u.dtype), u[..., ROPE_DIM:]], -1)


def causal_conv(u, w):
    C = u.shape[-1]
    return lax.conv_general_dilated(
        u, w[:, None, :].astype(u.dtype), window_strides=(1,),
        padding=[(CONV_WIDTH - 1, 0)], dimension_numbers=('NWC', 'WIO', 'NWC'),
        feature_group_count=C)


def fox_attention(q, k, v, log_f):
    B, S, H, D = q.shape
    qh = q.transpose(0, 2, 1, 3) * (D ** -0.5)
    kh = k.transpose(0, 2, 1, 3)
    vh = v.transpose(0, 2, 1, 3)
    cum = jnp.cumsum(log_f, axis=1).transpose(0, 2, 1)
    kpos = jnp.arange(S)

    def block(i):
        start = i * Q_BLOCK
        qb = lax.dynamic_slice_in_dim(qh, start, Q_BLOCK, axis=2)
        cb = lax.dynamic_slice_in_dim(cum, start, Q_BLOCK, axis=2)
        s = jnp.einsum('bhqd,bhkd->bhqk', qb, kh).astype(jnp.float32)
        s = s + cb[..., :, None] - cum[..., None, :]
        qpos = start + jnp.arange(Q_BLOCK)
        s = jnp.where(kpos[None, :] <= qpos[:, None], s, -jnp.inf)
        p = jax.nn.softmax(s, axis=-1)
        return jnp.einsum('bhqk,bhkd->bhqd', p.astype(vh.dtype), vh)

    out = lax.map(block, jnp.arange(S // Q_BLOCK))
    return out.transpose(1, 0, 3, 2, 4).reshape(B, S, H * D)


def mlstm(q, k, v, i_pre, f_pre):
    B, S, H, D = q.shape
    L = MLSTM_CHUNK
    NC = S // L
    to_chunks = lambda u: u.astype(jnp.float32).reshape(B, NC, L, H, D).transpose(1, 0, 3, 2, 4)
    gate_chunks = lambda g: g.reshape(B, NC, L, H).transpose(1, 0, 3, 2)
    qc, kc, vc = to_chunks(q), to_chunks(k) * (D ** -0.5), to_chunks(v)
    li = gate_chunks(i_pre)
    lf = gate_chunks(jax.nn.log_sigmoid(f_pre))
    tril = jnp.tril(jnp.ones((L, L), dtype=bool))

    def step(carry, inp):
        C, n, m = carry
        qt, kt, vt, it, ft = inp
        b = jnp.cumsum(ft, axis=-1)
        dmat = jnp.where(tril, b[..., :, None] - b[..., None, :] + it[..., None, :], -jnp.inf)
        inter = b + m[..., None]
        m_t = jnp.maximum(inter, jnp.max(dmat, -1))
        w_intra = jnp.exp(dmat - m_t[..., None])
        w_inter = jnp.exp(inter - m_t)
        a = jnp.einsum('bhtd,bhsd->bhts', qt, kt) * w_intra
        num = jnp.einsum('bhts,bhsd->bhtd', a, vt) + w_inter[..., None] * jnp.einsum('bhtd,bhde->bhte', qt, C)
        den = jnp.sum(a, -1) + w_inter * jnp.einsum('bhtd,bhd->bht', qt, n)
        h = num / jnp.maximum(jnp.abs(den), jnp.exp(-m_t))[..., None]
        b_last = b[..., -1]
        g = b_last[..., None] - b + it
        m_new = jnp.maximum(b_last + m, jnp.max(g, -1))
        decay = jnp.exp(b_last + m - m_new)
        ws = jnp.exp(g - m_new[..., None])
        C_new = decay[..., None, None] * C + jnp.einsum('bhs,bhsd,bhse->bhde', ws, kt, vt)
        n_new = decay[..., None] * n + jnp.einsum('bhs,bhsd->bhd', ws, kt)
        return (C_new, n_new, m_new), h

    init = (jnp.zeros((B, H, D, D), jnp.float32), jnp.zeros((B, H, D), jnp.float32),
            jnp.zeros((B, H), jnp.float32))
    _, hs = lax.scan(step, init, (qc, kc, vc, li, lf))
    return hs.transpose(1, 0, 3, 2, 4).reshape(B, S, H * D).astype(q.dtype)


def moba_attention(q, k, v):
    B, S, H, D = q.shape
    BS = MOBA_BLOCK
    NB = -(-S // BS)
    K_SEL = max(1, min(MOBA_TOPK, NB - 1))
    pad = NB * BS - S
    qh = q.transpose(0, 2, 1, 3) * (D ** -0.5)
    kh = jnp.pad(k.transpose(0, 2, 1, 3), ((0, 0), (0, 0), (0, pad), (0, 0)))
    vh = jnp.pad(v.transpose(0, 2, 1, 3), ((0, 0), (0, 0), (0, pad), (0, 0)))
    kb = kh.reshape(B, H, NB, BS, D)
    vb = vh.reshape(B, H, NB, BS, D)
    kmean = jnp.mean(kb, axis=3)
    bi = jnp.arange(B)[:, None, None, None]
    hi = jnp.arange(H)[None, :, None, None]

    def block(i):
        start = i * Q_BLOCK
        qb = lax.dynamic_slice_in_dim(qh, start, Q_BLOCK, axis=2)
        qpos = start + jnp.arange(Q_BLOCK)
        own = start // BS
        gate = jnp.einsum('bhqd,bhnd->bhqn', qb, kmean).astype(jnp.float32)
        gate = jnp.where(jnp.arange(NB) < own, gate, -jnp.inf)
        _, gidx = lax.top_k(gate, K_SEL)
        valid = jnp.arange(K_SEL) < own
        kg = kb[bi, hi, gidx]
        vg = vb[bi, hi, gidx]
        s_sel = jnp.einsum('bhqd,bhqnjd->bhqnj', qb, kg).astype(jnp.float32)
        s_sel = jnp.where(valid[:, None], s_sel, -jnp.inf)
        k_own = lax.dynamic_index_in_dim(kb, own, axis=2, keepdims=False)
        v_own = lax.dynamic_index_in_dim(vb, own, axis=2, keepdims=False)
        s_own = jnp.einsum('bhqd,bhjd->bhqj', qb, k_own).astype(jnp.float32)
        kpos = own * BS + jnp.arange(BS)
        s_own = jnp.where(kpos[None, :] <= qpos[:, None], s_own, -jnp.inf)
        s = jnp.concatenate([s_sel.reshape(B, H, Q_BLOCK, K_SEL * BS), s_own], -1)
        p = jax.nn.softmax(s, axis=-1).astype(vb.dtype)
        out = jnp.einsum('bhqj,bhqjd->bhqd', p[..., :K_SEL * BS],
                         vg.reshape(B, H, Q_BLOCK, K_SEL * BS, D))
        return out + jnp.einsum('bhqj,bhjd->bhqd', p[..., K_SEL * BS:], v_own)

    out = lax.map(block, jnp.arange(S // Q_BLOCK))
    return out.transpose(1, 0, 3, 2, 4).reshape(B, S, H * D)


def token_mixer(x, positions, w_in, b_fox_f, b_mlstm_i, b_mlstm_f, conv_w,
                g_fox, g_mlstm, g_moba, w_out):
    B, S, _ = x.shape
    z = jnp.einsum('bsd,dn->bsn', x, w_in)
    (fq, fk, fv, ff, mq, mk, mv, mi, mf, mo, bq, bk, bv) = jnp.split(
        z, np.cumsum(IN_SPLITS)[:-1].tolist(), axis=-1)
    heads = lambda u, h: u.reshape(B, S, h, -1)
    log_f = jax.nn.log_sigmoid(ff.astype(jnp.float32) + b_fox_f)
    y_fox = fox_attention(heads(fq, FOX_HEADS), heads(fk, FOX_HEADS), heads(fv, FOX_HEADS), log_f)
    qk = jax.nn.silu(causal_conv(jnp.concatenate([mq, mk], -1), conv_w))
    mq, mk = jnp.split(qk, 2, axis=-1)
    h = mlstm(heads(mq, MLSTM_HEADS), heads(mk, MLSTM_HEADS), heads(mv, MLSTM_HEADS),
              mi.astype(jnp.float32) + b_mlstm_i, mf.astype(jnp.float32) + b_mlstm_f)
    y_mlstm = jax.nn.sigmoid(mo) * h
    y_moba = moba_attention(partial_rope(heads(bq, MOBA_HEADS), positions),
                            partial_rope(heads(bk, MOBA_HEADS), positions),
                            heads(bv, MOBA_HEADS))
    y = jnp.concatenate([headwise_rms(y_fox, g_fox, FOX_HEADS),
                         headwise_rms(y_mlstm, g_mlstm, MLSTM_HEADS),
                         headwise_rms(y_moba, g_moba, MOBA_HEADS)], -1)
    return jnp.einsum('bsm,md->bsd', y, w_out)


def expert_ffn(xb, wg, wu, wd):
    return (jax.nn.silu(xb @ wg) * (xb @ wu)) @ wd


def hier_moe(x, w_grp, b_grp, w_exp_router, b_exp_router, w_gate, w_up, w_down):
    B, S, D = x.shape
    T = B * S
    h = x.reshape(T, D)
    grp_logits = (h @ w_grp).astype(jnp.float32) + b_grp
    g_sel = jnp.argmax(grp_logits, -1)
    p_grp = jnp.take_along_axis(jax.nn.softmax(grp_logits, -1), g_sel[:, None], 1)[:, 0]
    e_logits = jnp.einsum('td,dge->tge', h, w_exp_router).astype(jnp.float32) + b_exp_router
    e_logits = jnp.take_along_axis(e_logits, g_sel[:, None, None], 1)[:, 0]
    top_v, top_i = lax.top_k(e_logits, EXPERT_TOPK)
    gates = jax.nn.softmax(top_v, -1) * p_grp[:, None]
    expert_id = g_sel[:, None] * EXPERTS_PER_GROUP + top_i
    A = T * EXPERT_TOPK
    e_flat = expert_id.reshape(A).astype(jnp.int32)
    tok_flat = jnp.repeat(jnp.arange(T, dtype=jnp.int32), EXPERT_TOPK)
    w_flat = gates.reshape(A)
    order = jnp.argsort(e_flat)
    e_s, tok_s, w_s = e_flat[order], tok_flat[order], w_flat[order]
    counts = jnp.bincount(e_flat, length=N_EXPERTS)
    starts = jnp.cumsum(counts) - counts
    padded = ((counts + MOE_BLOCK - 1) // MOE_BLOCK) * MOE_BLOCK
    pends = jnp.cumsum(padded)
    pstarts = pends - padded
    dest = pstarts[e_s] + (jnp.arange(A, dtype=jnp.int32) - starts[e_s])
    P = A + N_EXPERTS * MOE_BLOCK
    NBLK = P // MOE_BLOCK
    buf = jnp.zeros((P, D), h.dtype).at[dest].set(h[tok_s])
    blk_e = jnp.minimum(jnp.searchsorted(pends, jnp.arange(NBLK) * MOE_BLOCK, side='right'),
                        N_EXPERTS - 1)
    ybuf = lax.map(lambda a: expert_ffn(a[0], w_gate[a[1]], w_up[a[1]], w_down[a[1]]),
                   (buf.reshape(NBLK, MOE_BLOCK, D), blk_e)).reshape(P, D)
    y_assign = (ybuf[dest] * w_s[:, None]).astype(h.dtype)
    y = jax.ops.segment_sum(y_assign, tok_s, num_segments=T)
    return y.reshape(B, S, D)


def setup_inputs(seed: int = 0) -> dict:
    key = jax.random.key(seed)
    ks = jax.random.split(key, 24)
    nrm = lambda k, shape, scale: jax.random.normal(k, shape, jnp.float32) * scale
    L, D = DEPTH, D_MODEL
    return {
        'x': nrm(ks[0], (BATCH, SEQ, D), 1.0),
        'positions': jnp.broadcast_to(jnp.arange(SEQ, dtype=jnp.int32)[None, :], (BATCH, SEQ)),
        'w_in': nrm(ks[1], (L, D, IN_W), D ** -0.5),
        'b_fox_f': 1.0 + nrm(ks[2], (L, FOX_HEADS), 0.1),
        'b_mlstm_i': nrm(ks[3], (L, MLSTM_HEADS), 0.1),
        'b_mlstm_f': 3.0 + nrm(ks[4], (L, MLSTM_HEADS), 0.5),
        'conv_w': nrm(ks[5], (L, CONV_WIDTH, 2 * MLSTM_W), CONV_WIDTH ** -0.5),
        'g_fox': 1.0 + nrm(ks[6], (L, FOX_W), 0.1),
        'g_mlstm': 1.0 + nrm(ks[7], (L, MLSTM_W), 0.1),
        'g_moba': 1.0 + nrm(ks[8], (L, MOBA_W), 0.1),
        'w_out': nrm(ks[9], (L, MIX_W, D), MIX_W ** -0.5 * BETA),
        'ln1_g': 1.0 + nrm(ks[10], (L, D), 0.1),
        'ln1_b': nrm(ks[11], (L, D), 0.02),
        'w_grp': nrm(ks[12], (L, D, N_GROUPS), D ** -0.5),
        'b_grp': nrm(ks[13], (L, N_GROUPS), 0.01),
        'w_exp_router': nrm(ks[14], (L, D, N_GROUPS, EXPERTS_PER_GROUP), D ** -0.5),
        'b_exp_router': nrm(ks[15], (L, N_GROUPS, EXPERTS_PER_GROUP), 0.01),
        'w_gate': nrm(ks[16], (L, N_EXPERTS, D, D_EXPERT), D ** -0.5),
        'w_up': nrm(ks[17], (L, N_EXPERTS, D, D_EXPERT), D ** -0.5),
        'w_down': nrm(ks[18], (L, N_EXPERTS, D_EXPERT, D), D_EXPERT ** -0.5 * BETA),
        'ln2_g': 1.0 + nrm(ks[19], (L, D), 0.1),
        'ln2_b': nrm(ks[20], (L, D), 0.02),
    }


def reference(x, positions, w_in, b_fox_f, b_mlstm_i, b_mlstm_f, conv_w, g_fox, g_mlstm,
              g_moba, w_out, ln1_g, ln1_b, w_grp, b_grp, w_exp_router, b_exp_router,
              w_gate, w_up, w_down, ln2_g, ln2_b):
    for l in range(DEPTH):
        mix = token_mixer(x, positions, w_in[l], b_fox_f[l], b_mlstm_i[l], b_mlstm_f[l],
                          conv_w[l], g_fox[l], g_mlstm[l], g_moba[l], w_out[l])
        x = layer_norm(ALPHA * x + mix, ln1_g[l], ln1_b[l])
        ffn = hier_moe(x, w_grp[l], b_grp[l], w_exp_router[l], b_exp_router[l],
                       w_gate[l], w_up[l], w_down[l])
        x = layer_norm(ALPHA * x + ffn, ln2_g[l], ln2_b[l])
    return x
```

```cpp
#include <hip/hip_runtime.h>
#include <cstdio>
#include <cstdint>

#define LAS __attribute__((address_space(3)))
#define GAS __attribute__((address_space(1)))
typedef unsigned short bf16_t;
typedef short bf16x8 __attribute__((ext_vector_type(8)));
typedef short bf16x4 __attribute__((ext_vector_type(4)));
typedef float f32x4 __attribute__((ext_vector_type(4)));
typedef float f32x2 __attribute__((ext_vector_type(2)));
typedef unsigned u32x4 __attribute__((ext_vector_type(4)));
typedef unsigned u32x2 __attribute__((ext_vector_type(2)));

#ifndef N_LAUNCHES
#define N_LAUNCHES 1
#endif

constexpr int S = 16384, DM = 1024, INW = 3596, NL = 2;
constexpr int NZ = 3584;
constexpr int ZRW = 2560;
constexpr int ZR_FQ = 0, ZR_FK = 256, ZR_MQ = 512, ZR_MK = 1024, ZR_MO = 1536, ZR_BQ = 2048, ZR_BK = 2304;
constexpr int ZT_FV = 0, ZT_MV = 256, ZT_BV = 768;
constexpr int ZTP = S + 136;
constexpr int NE = 32, DE = 512, MAXT = 160, PROWS = MAXT * 256;
constexpr float ALPHA = 1.41421356237309515f;
constexpr float EPS = 1e-5f;
constexpr int NPH = 21;

constexpr size_t MiB = 1u << 20;
constexpr size_t WS_CTL = 0, CTL_BYTES = 1 * MiB;
constexpr size_t WS_WIN = 1 * MiB;
constexpr size_t WS_ROPE = 16 * MiB;
constexpr size_t WS_WOUT = 17 * MiB;
constexpr size_t WS_WGU = 21 * MiB;
constexpr size_t WS_WD = 85 * MiB;
constexpr size_t WS_ACTB = 117 * MiB;
constexpr size_t WS_Y = 149 * MiB;
constexpr size_t WS_X1 = 181 * MiB;
constexpr size_t WS_ZR = 245 * MiB;
constexpr size_t WS_ZT = 325 * MiB;
constexpr size_t WS_TMP = 359 * MiB;
constexpr size_t WS_SMALL = 481 * MiB;
constexpr size_t WS_END = 489 * MiB;
constexpr size_t T_QC = WS_TMP, T_KC = WS_TMP + 16 * MiB, T_U = WS_TMP + 32 * MiB, T_CST = WS_TMP + 64 * MiB,
                 T_MPO = WS_TMP + 80 * MiB, T_MPML = WS_TMP + 104 * MiB, T_QIDX = WS_TMP + 106 * MiB;
constexpr size_t T_H = WS_TMP, T_YE = WS_TMP + 40 * MiB;
constexpr size_t SM_FLF = WS_SMALL, SM_FCL = SM_FLF + 256 * 1024, SM_MLI = SM_FCL + 256 * 1024, SM_MLF = SM_MLI + 256 * 1024,
                 SM_MB = SM_MLF + 256 * 1024, SM_MA = SM_MB + 256 * 1024, SM_MPX = SM_MA + 256 * 1024,
                 SM_FTS = SM_MPX + 256 * 1024, SM_KMEAN = SM_FTS + 4096, SM_EID = SM_KMEAN + 65536, SM_SLOT = SM_EID + 131072,
                 SM_WT = SM_SLOT + 131072, SM_ELIST = SM_WT + 131072, SM_MLSC = SM_ELIST + 2 * MiB, SM_NLOC = SM_MLSC + 16384,
                 SM_NST = SM_NLOC + 262144, SM_MSEL = SM_NST + 262144, SM_CNTQ = SM_MSEL + 262144, SM_END = SM_CNTQ + 131072;
static_assert(SM_END <= WS_END, "small region");
static_assert(WS_ZT + (size_t)1024 * ZTP * 2 <= WS_TMP, "transposed z buffer");
constexpr int CW_BAR = 4096;
__host__ __device__ constexpr int CW_ECNT(int l) { return 8192 + 64 * l; }
__host__ __device__ constexpr int CW_KMAX(int l) { return 9216 + 16 * l; }
__host__ __device__ constexpr int CW_GUC(int l) { return 12288 + 4096 * l; }

constexpr int RING_BYTES = 131072;
constexpr int LDS_BYTES = 163840;
constexpr int LDS_MISC = LDS_BYTES - 64;
constexpr int LDS_TAB = LDS_MISC - 4096;

__device__ __forceinline__ unsigned f2bf(float f) { unsigned u = __builtin_bit_cast(unsigned, f); return (u + 0x7fffu + ((u >> 16) & 1u)) >> 16; }
typedef __bf16 bf16x2_t __attribute__((ext_vector_type(2)));
__device__ __forceinline__ unsigned pk2(float lo, float hi) { const f32x2 v = {lo, hi}; const bf16x2_t b = __builtin_convertvector(v, bf16x2_t); return __builtin_bit_cast(unsigned, b); }
__device__ __forceinline__ float bf2f(unsigned h) { return __builtin_bit_cast(float, h << 16); }
__device__ __forceinline__ float bflo(unsigned w) { return __builtin_bit_cast(float, w << 16); }
__device__ __forceinline__ float bfhi(unsigned w) { return __builtin_bit_cast(float, w & 0xffff0000u); }
typedef unsigned u32x2v __attribute__((ext_vector_type(2)));
template <int CTRL> __device__ __forceinline__ float dpp_f(float v) { return __builtin_bit_cast(float, __builtin_amdgcn_update_dpp(0, __builtin_bit_cast(int, v), CTRL, 0xf, 0xf, true)); }
#ifndef RED_MODE
#define RED_MODE 7
#endif
__device__ __forceinline__ float x32f(float v) { if (RED_MODE & 2) { unsigned a = __builtin_bit_cast(unsigned, v), b = a; asm volatile("s_nop 1\n\tv_permlane32_swap_b32 %0, %1" : "+v"(a), "+v"(b));
        return (__builtin_amdgcn_mbcnt_hi(~0u, __builtin_amdgcn_mbcnt_lo(~0u, 0u)) < 32u) ? __builtin_bit_cast(float, b) : __builtin_bit_cast(float, a); } return __shfl_xor(v, 32); }
__device__ __forceinline__ float x16f(float v) { if (RED_MODE & 4) { unsigned a = __builtin_bit_cast(unsigned, v), b = a; asm volatile("s_nop 1\n\tv_permlane16_swap_b32 %0, %1" : "+v"(a), "+v"(b));
        return ((__builtin_amdgcn_mbcnt_hi(~0u, __builtin_amdgcn_mbcnt_lo(~0u, 0u)) >> 4) & 1u) ? __builtin_bit_cast(float, a) : __builtin_bit_cast(float, b); } return __shfl_xor(v, 16); }
__device__ __forceinline__ float grp_sum(float v) { v += x32f(v); v += x16f(v); return v; }
__device__ __forceinline__ float grp_max(float v) { v = fmaxf(v, x32f(v)); v = fmaxf(v, x16f(v)); return v; }
__device__ __forceinline__ float row_sum16(float v) { v += dpp_f<0xB1>(v); v += dpp_f<0x4E>(v); v += dpp_f<0x141>(v); v += dpp_f<0x140>(v); return v; }
__device__ __forceinline__ float row_max16(float v) { v = fmaxf(v, dpp_f<0xB1>(v)); v = fmaxf(v, dpp_f<0x4E>(v)); v = fmaxf(v, dpp_f<0x141>(v)); v = fmaxf(v, dpp_f<0x140>(v)); return v; }
__device__ __forceinline__ float wave_sum(float v) {
    if (RED_MODE & 1) v = row_sum16(v); else { v += __shfl_xor(v, 1); v += __shfl_xor(v, 2); v += __shfl_xor(v, 4); v += __shfl_xor(v, 8); }
    return grp_sum(v); }
__device__ __forceinline__ float wave_max(float v) {
    if (RED_MODE & 1) v = row_max16(v); else { v = fmaxf(v, __shfl_xor(v, 1)); v = fmaxf(v, __shfl_xor(v, 2)); v = fmaxf(v, __shfl_xor(v, 4)); v = fmaxf(v, __shfl_xor(v, 8)); }
    return grp_max(v); }
__device__ __forceinline__ float log_sigmoid(float x) { return fminf(x, 0.f) - log1pf(__expf(-fabsf(x))); }
__device__ __forceinline__ float sigmoidf(float x) { return 1.f / (1.f + __expf(-x)); }
__device__ __forceinline__ float siluf(float x) { return x / (1.f + __expf(-x)); }
#define MFMA16(a, b, c) __builtin_amdgcn_mfma_f32_16x16x32_bf16((a), (b), (c), 0, 0, 0)
#define VM_WAIT() asm volatile("s_waitcnt vmcnt(0)" ::: "memory")

#define XB_TMO      128
#define XB_XCNT(j)  (256  + 64 * (j))
#define XB_XSUB(j)  (1280 + 64 * (j))
#define XB_XGEN(j)  (2304 + 64 * (j))
#define XB_TOP      3328
#define XB_TOPGEN   3392
#define XCD_BAR_WORDS 3456
#define XB_SPIN_CAP (1u << 24)
__device__ __forceinline__ unsigned xb_ld(unsigned* p)              { return __hip_atomic_load(p, __ATOMIC_RELAXED, __HIP_MEMORY_SCOPE_AGENT); }
__device__ __forceinline__ unsigned xb_add(unsigned* p, unsigned v) { return __hip_atomic_fetch_add(p, v, __ATOMIC_RELAXED, __HIP_MEMORY_SCOPE_AGENT); }
__device__ __forceinline__ unsigned xb_xcc_id() { return (unsigned)__builtin_amdgcn_s_getreg((3 << 11) | 20) & 0xFu; }
#define XB_SPIN(cond, bar) do { unsigned _sp = 0; while (cond) { __builtin_amdgcn_s_sleep(1); \
    if ((++_sp & 255u) == 0u) { if (xb_ld(&(bar)[XB_TMO])) break; if (_sp > XB_SPIN_CAP) { atomicAdd(&(bar)[XB_TMO], 1u); break; } } } } while (0)
struct XcdBarrier { unsigned* bar; unsigned x; volatile LAS unsigned* st; };
__device__ __forceinline__ XcdBarrier xcd_barrier_post(unsigned* bar, volatile LAS unsigned* st) {
    XcdBarrier b; b.bar = bar; b.x = xb_xcc_id(); b.st = st;
    if (threadIdx.x == 0) (void)xb_add(&bar[XB_XCNT(b.x)], 1u);
    return b;
}
__device__ __forceinline__ void xcd_barrier_complete(unsigned* bar, unsigned x, unsigned& nloc, unsigned& nx) {
    const unsigned G = gridDim.x * gridDim.y * gridDim.z;
    unsigned sum, cnt, mine, sp = 0u;
    for (;;) {
        sum = 0u; cnt = 0u; mine = 0u;
#pragma unroll
        for (unsigned j = 0; j < 16; ++j) { const unsigned c = xb_ld(&bar[XB_XCNT(j)]); sum += c; cnt += (c > 0u) ? 1u : 0u; mine = (j == x) ? c : mine; }
        if (sum == G) break;
        __builtin_amdgcn_s_sleep(1);
        if ((++sp & 255u) == 0u) { if (xb_ld(&bar[XB_TMO])) break; if (sp > XB_SPIN_CAP) { atomicAdd(&bar[XB_TMO], 1u); break; } }
    }
    nloc = mine > 0u ? mine : 1u; nx = cnt > 0u ? cnt : 1u;
}
__device__ __forceinline__ void xcd_barrier(const XcdBarrier& b, const bool thread0) {
    asm volatile("s_waitcnt vmcnt(0)" ::: "memory");
    __syncthreads();
    if (thread0) {
        unsigned* bar = b.bar;
        __builtin_amdgcn_s_waitcnt(0);
        unsigned nloc = b.st[0], nx = b.st[1];
        if (nloc == 0u) { xcd_barrier_complete(bar, b.x, nloc, nx); b.st[0] = nloc; b.st[1] = nx; }
        const unsigned old = xb_add(&bar[XB_XSUB(b.x)], 1u);
        const unsigned gen = old / nloc;
        if (old + 1u == (gen + 1u) * nloc) {
            __builtin_amdgcn_fence(__ATOMIC_RELEASE, "agent");
            asm volatile("s_waitcnt vmcnt(0)" ::: "memory");
            const unsigned og = xb_add(&bar[XB_TOP], 1u);
            const unsigned tg = og / nx;
            if (og + 1u == (tg + 1u) * nx) xb_add(&bar[XB_TOPGEN], 1u);
            else XB_SPIN(xb_ld(&bar[XB_TOPGEN]) == tg, bar);
            __builtin_amdgcn_fence(__ATOMIC_ACQUIRE, "agent");
            xb_add(&bar[XB_XGEN(b.x)], 1u);
            asm volatile("s_waitcnt vmcnt(0)" ::: "memory");
        } else {
            XB_SPIN(xb_ld(&bar[XB_XGEN(b.x)]) == gen, bar);
            __builtin_amdgcn_fence(__ATOMIC_ACQUIRE, "agent");
            asm volatile("s_waitcnt vmcnt(0)" ::: "memory");
        }
    }
    __syncthreads();
}
namespace pg8 {
constexpr int BM = 256, BK = 64, HALF = 128, HTB = HALF * BK * 2, STAGE_BYTES = 8 * HTB, NXCD = 8, WGM = 8;
__host__ __device__ __forceinline__ int lds_byte(int r, int c) { const int st = (r >> 4) * 2 + (c >> 5), rr = r & 15, cc = c & 31, ob = rr * 64 + cc * 2; return st * 1024 + (ob ^ (((ob >> 9) & 1) << 5)); }
__host__ __device__ __forceinline__ void stage_rc(int b, int& R, int& C) { const int st = b / 1024, sb = b % 1024, swz = sb ^ (((sb >> 9) & 1) << 5); R = (st >> 1) * 16 + swz / 64; C = (st & 1) * 32 + (swz % 64) / 2; }
__host__ __device__ __forceinline__ int perm32(int rho) { const int n = rho >> 4, i = rho & 15; return 8 * (i >> 2) + 4 * n + (i & 3); }

struct GUnit {
    const char* A;
    const char* B;
    int pm, pn, x0;
    const int* list;
    int l0, nl;
};

template <class Epi, class Sched, bool GATHER = false, bool HOOK = false>
__device__ __forceinline__ void gemm_phase(LAS unsigned char* lds, const int K, const Sched& S, const Epi& E, const int tid, LAS unsigned* rtab = nullptr) {
    const int wid = __builtin_amdgcn_readfirstlane(tid >> 6), lane = tid & 63, wr = wid >> 2, wc = wid & 3, fr = lane & 15, fq = lane >> 4;
    const int nt = K / BK;
    unsigned voffA[2], voffB[2];
#pragma unroll
    for (int i = 0; i < 2; ++i) { int R, C; stage_rc(tid * 16 + i * 8192, R, C); const int Rb = (R & ~31) + perm32(R & 31); voffA[i] = (unsigned)(R * K + C) * 2u; voffB[i] = (unsigned)(Rb * K + C) * 2u; }
    const size_t kstep = (size_t)(BK * 2);
    const size_t hstep = (size_t)HALF * K * 2;
    const unsigned ldsw = (unsigned)wid * 1024u;
    const int aoff = lds_byte(wr * 64 + fr, fq * 8), boff = lds_byte(wc * 32 + fr, fq * 8);
#define PG8_SA(b, h) (((b) * 2 + (h)) * HTB)
#define PG8_SB(b, h) ((4 + (b) * 2 + (h)) * HTB)
#define PG8_STAGE(bufoff, gbase, voff) do { _Pragma("unroll") for (int _i = 0; _i < 2; ++_i) \
        __builtin_amdgcn_global_load_lds((const unsigned*)((const char*)(gbase) + (voff)[_i]), (LAS unsigned*)(lds + (bufoff) + ldsw + _i * 8192), 16, 0, 0); } while (0)
#define PG8_STAGE_A(bufoff, gbase, voff) do { _Pragma("unroll") for (int _i = 0; _i < 2; ++_i) \
        __builtin_amdgcn_global_load_lds((const unsigned*)((const char*)(gbase) + (voff)[_i]), (LAS unsigned*)(lds + (bufoff) + ldsw + _i * 8192), 16, 0, HOOK ? 16 : 0); } while (0)
#define PG8_LDA(dst, b, h) do { _Pragma("unroll") for (int m = 0; m < 4; ++m) _Pragma("unroll") for (int k = 0; k < 2; ++k) dst[m][k] = *(const LAS bf16x8*)(lds + PG8_SA(b, h) + aoff + m * 2048 + k * 1024); } while (0)
#define PG8_LDB(dst, b, h) do { _Pragma("unroll") for (int n = 0; n < 2; ++n) _Pragma("unroll") for (int k = 0; k < 2; ++k) dst[n][k] = *(const LAS bf16x8*)(lds + PG8_SB(b, h) + boff + n * 2048 + k * 1024); } while (0)
#define PG8_MMA(ai, bj, At, Bt) do { __builtin_amdgcn_s_setprio(1); _Pragma("unroll") for (int m = 0; m < 4; ++m) _Pragma("unroll") for (int n = 0; n < 2; ++n) _Pragma("unroll") for (int k = 0; k < 2; ++k) \
        acc[ai][bj][m][n] = __builtin_amdgcn_mfma_f32_16x16x32_bf16(Bt[n][k], At[m][k], acc[ai][bj][m][n], 0, 0, 0); __builtin_amdgcn_s_setprio(0); } while (0)
#define PG8_WAIT_V(n) asm volatile("s_waitcnt vmcnt(" #n ")" ::: "memory")
#define PG8_WAIT_L(n) asm volatile("s_waitcnt lgkmcnt(" #n ")" ::: "memory")
#define PG8_BAR __builtin_amdgcn_s_barrier()
#define PG8_SCHED __builtin_amdgcn_sched_barrier(0)
#define PG8_STAGE_G(bufoff, gbase, vo) do { _Pragma("unroll") for (int _i = 0; _i < 2; ++_i) \
        __builtin_amdgcn_global_load_lds((const unsigned*)((const char*)(gbase) + (vo)[_i]), (LAS unsigned*)(lds + (bufoff) + ldsw + _i * 8192), 16, 0, 0); } while (0)
#define PG8_ROWTAB(u, slot) do { if (tid < 256) { int _x = (u).l0 + tid; _x = _x < (u).nl ? _x : (u).nl - 1; rtab[(slot) * 256 + tid] = (unsigned)(u).list[_x] * (unsigned)(K * 2); } } while (0)
#define PG8_LOADCV(slot) do { _Pragma("unroll") for (int _h = 0; _h < 2; ++_h) _Pragma("unroll") for (int _i = 0; _i < 2; ++_i) { int _R, _C; stage_rc(tid * 16 + _i * 8192, _R, _C); \
        cv[_h][_i] = rtab[(slot) * 256 + _h * HALF + _R] + (unsigned)(_C * 2); } } while (0)
    GUnit cur, nxt; int ui = 0;
    if (!S.next(0, cur)) return;
    unsigned cv[2][2]; int par = 0;
    if constexpr (GATHER) { PG8_ROWTAB(cur, 0); __syncthreads(); PG8_LOADCV(0); }
    f32x4 acc[2][2][4][2];
#pragma unroll
    for (int a = 0; a < 2; ++a)
#pragma unroll
        for (int b = 0; b < 2; ++b)
#pragma unroll
            for (int m = 0; m < 4; ++m)
#pragma unroll
                for (int n = 0; n < 2; ++n) acc[a][b][m][n] = (f32x4){0.f, 0.f, 0.f, 0.f};
    bf16x8 At[4][2], B0[2][2], B1[2][2];
    const char* cA = cur.A; const char* cB = cur.B;
    if constexpr (HOOK) S.a_ready(cur, wid, lane);
    PG8_STAGE(PG8_SB(0, 0), cB, voffB); PG8_STAGE(PG8_SB(0, 1), cB + hstep, voffB);
    if constexpr (GATHER) { PG8_STAGE_G(PG8_SA(0, 0), cA, cv[0]); PG8_STAGE_G(PG8_SA(0, 1), cA, cv[1]); } else { PG8_STAGE_A(PG8_SA(0, 0), cA, voffA); PG8_STAGE_A(PG8_SA(0, 1), cA + hstep, voffA); }
    if (wr == 1) PG8_BAR;
    PG8_WAIT_V(2); PG8_BAR;
    PG8_STAGE(PG8_SB(1, 0), cB + kstep, voffB); if constexpr (GATHER) PG8_STAGE_G(PG8_SA(1, 0), cA + kstep, cv[0]); else PG8_STAGE_A(PG8_SA(1, 0), cA + kstep, voffA); PG8_STAGE(PG8_SB(1, 1), cB + hstep + kstep, voffB);
    PG8_WAIT_V(6); PG8_BAR;
    for (;;) {
        const bool has_next = S.next(ui + 1, nxt);
        const char* nA = has_next ? nxt.A : cA; const char* nB = has_next ? nxt.B : cB;
        if constexpr (GATHER) { if (has_next) PG8_ROWTAB(nxt, par ^ 1); }
        for (int t = 0; t < nt; t += 2) {
            const bool last = (t == nt - 2);
            const char* a1 = cA + (size_t)(t + 1) * kstep;
            const char* a2 = last ? nA : cA + (size_t)(t + 2) * kstep; const char* b2 = last ? nB : cB + (size_t)(t + 2) * kstep;
            const char* a3 = a2 + kstep; const char* b3 = b2 + kstep;
            if constexpr (HOOK) { if (last && has_next) S.a_ready(nxt, wid, lane); }
            PG8_LDB(B0, 0, 0); PG8_LDB(B1, 0, 1); PG8_SCHED; PG8_LDA(At, 0, 0);
            if constexpr (GATHER) { PG8_STAGE_G(PG8_SA(1, 1), a1, cv[1]); if (last && has_next) PG8_LOADCV(par ^ 1); } else PG8_STAGE_A(PG8_SA(1, 1), a1 + hstep, voffA);
            PG8_WAIT_V(8); PG8_WAIT_L(0); PG8_BAR; PG8_MMA(0, 0, At, B0); PG8_MMA(0, 1, At, B1); PG8_BAR; PG8_SCHED;
            PG8_LDA(At, 0, 1); PG8_STAGE(PG8_SB(0, 0), b2, voffB); PG8_STAGE(PG8_SB(0, 1), b2 + hstep, voffB); if constexpr (GATHER) PG8_STAGE_G(PG8_SA(0, 0), a2, cv[0]); else PG8_STAGE_A(PG8_SA(0, 0), a2, voffA);
            PG8_WAIT_V(8); PG8_WAIT_L(0); PG8_BAR; PG8_MMA(1, 0, At, B0); PG8_MMA(1, 1, At, B1); PG8_BAR; PG8_SCHED;
            PG8_LDB(B0, 1, 0); PG8_LDB(B1, 1, 1); PG8_SCHED; PG8_LDA(At, 1, 0); if constexpr (GATHER) PG8_STAGE_G(PG8_SA(0, 1), a2, cv[1]); else PG8_STAGE_A(PG8_SA(0, 1), a2 + hstep, voffA);
            PG8_WAIT_V(8); PG8_WAIT_L(0); PG8_BAR; PG8_MMA(0, 0, At, B0); PG8_MMA(0, 1, At, B1); PG8_BAR; PG8_SCHED;
            PG8_LDA(At, 1, 1); PG8_STAGE(PG8_SB(1, 0), b3, voffB); PG8_STAGE(PG8_SB(1, 1), b3 + hstep, voffB); if constexpr (GATHER) PG8_STAGE_G(PG8_SA(1, 0), a3, cv[0]); else PG8_STAGE_A(PG8_SA(1, 0), a3, voffA);
            PG8_WAIT_V(8); PG8_WAIT_L(0); PG8_BAR; PG8_MMA(1, 0, At, B0); PG8_MMA(1, 1, At, B1); PG8_BAR; PG8_SCHED;
        }
        if (wr == 0) PG8_BAR;
        E(acc, cur, wr, wc, fr, fq);
        if (!has_next) break;
#pragma unroll
        for (int a = 0; a < 2; ++a)
#pragma unroll
            for (int b = 0; b < 2; ++b)
#pragma unroll
                for (int m = 0; m < 4; ++m)
#pragma unroll
                    for (int n = 0; n < 2; ++n) acc[a][b][m][n] = (f32x4){0.f, 0.f, 0.f, 0.f};
        cur = nxt; cA = nA; cB = nB; ++ui; par ^= 1;
        if (wr == 1) PG8_BAR;
    }
    PG8_WAIT_V(0);
    PG8_BAR;
#undef PG8_SA
#undef PG8_SB
#undef PG8_STAGE
#undef PG8_STAGE_A
#undef PG8_LDA
#undef PG8_LDB
#undef PG8_MMA
#undef PG8_WAIT_V
#undef PG8_WAIT_L
#undef PG8_BAR
#undef PG8_SCHED
#undef PG8_STAGE_G
#undef PG8_ROWTAB
#undef PG8_LOADCV
}
}
__device__ __forceinline__ int win_srccol(int n) {
    if (n < 256) return n;
    if (n < 512) return n;
    if (n < 1024) return 772 + (n - 512);
    if (n < 1536) return 1284 + (n - 1024);
    if (n < 2048) return 2316 + (n - 1536);
    if (n < 2304) return 2828 + (n - 2048);
    if (n < 2560) return 3084 + (n - 2304);
    if (n < 2816) return 512 + (n - 2560);
    if (n < 3328) return 1796 + (n - 2816);
    return 3340 + (n - 3328);
}
__device__ __forceinline__ void transpose_item(const float* cp, int ld, bf16_t* WT, int Kd, int k0, int n0, LAS float* scr, int lane) {
    float tmp[32];
#pragma unroll
    for (int i = 0; i < 32; ++i) tmp[i] = cp[(size_t)(k0 + 2 * i + (lane >> 5)) * ld];
#pragma unroll
    for (int i = 0; i < 32; ++i) scr[(2 * i + (lane >> 5)) * 33 + (lane & 31)] = tmp[i];
    asm volatile("s_waitcnt vmcnt(0) lgkmcnt(0)" ::: "memory");
    const int c = lane & 7;
#pragma unroll
    for (int j = 0; j < 4; ++j) { const int n = (lane >> 3) + 8 * j; const LAS float* s = scr + (8 * c) * 33 + n;
        u32x4 o; o.x = pk2(s[0 * 33], s[1 * 33]); o.y = pk2(s[2 * 33], s[3 * 33]); o.z = pk2(s[4 * 33], s[5 * 33]); o.w = pk2(s[6 * 33], s[7 * 33]);
        *(u32x4*)(WT + (size_t)(n0 + n) * Kd + k0 + 8 * c) = o; }
    asm volatile("s_waitcnt lgkmcnt(0)" ::: "memory");
}
__device__ __forceinline__ void load_w12(const float* w_in_l, LAS float* w12, int tid) {
    for (int idx = tid; idx < 12 * 1024; idx += 512) { const int c = idx >> 10, k = idx & 1023; const int col = c < 4 ? 768 + c : 2308 + (c - 4);
        w12[idx] = w_in_l[(size_t)k * INW + col]; }
}
__device__ __forceinline__ void gates_row(const f32x4 (&v)[4], const LAS float* w12, const float* bff, const float* bmi, const float* bmf, float* flf, float* mli, float* mlf, int t, int lane) {
    float d[12];
#pragma unroll
    for (int c = 0; c < 12; ++c) { float s = 0.f;
#pragma unroll
        for (int j = 0; j < 4; ++j) { const f32x4 w = *(const LAS f32x4*)(w12 + c * 1024 + 256 * j + 4 * lane); s += (v[j].x * w.x + v[j].y * w.y) + (v[j].z * w.z + v[j].w * w.w); }
        d[c] = wave_sum(s); }
    if (lane < 4) {
        float a = d[0], b = d[4], c = d[8];
#pragma unroll
        for (int h = 1; h < 4; ++h) { if (lane == h) { a = d[h]; b = d[4 + h]; c = d[8 + h]; } }
        flf[lane * S + t] = log_sigmoid(a + bff[lane]);
        mli[lane * S + t] = b + bmi[lane];
        mlf[lane * S + t] = log_sigmoid(c + bmf[lane]);
    }
}
__device__ __forceinline__ void ln_row(f32x4 (&v)[4], const float* gam, const float* bet, int lane) {
    float s = 0.f;
#pragma unroll
    for (int j = 0; j < 4; ++j) s += (v[j].x + v[j].y) + (v[j].z + v[j].w);
    const float mean = wave_sum(s) * (1.f / DM); float s2 = 0.f;
#pragma unroll
    for (int j = 0; j < 4; ++j) { v[j] = v[j] - mean; s2 += (v[j].x * v[j].x + v[j].y * v[j].y) + (v[j].z * v[j].z + v[j].w * v[j].w); }
    const float rstd = rsqrtf(wave_sum(s2) * (1.f / DM) + EPS);
#pragma unroll
    for (int j = 0; j < 4; ++j) { const f32x4 g = *(const f32x4*)(gam + 256 * j + 4 * lane), b = *(const f32x4*)(bet + 256 * j + 4 * lane); v[j] = v[j] * rstd * g + b; }
}
__device__ __forceinline__ void store_row_bf16(const f32x4 (&v)[4], bf16_t* orow, int lane) {
#pragma unroll
    for (int j = 0; j < 4; ++j) { u32x2 o; o.x = pk2(v[j].x, v[j].y); o.y = pk2(v[j].z, v[j].w); *(u32x2*)(orow + 256 * j + 4 * lane) = o; }
}

__device__ __forceinline__ void p0_prologue(const float* x, const int* pos, const float* w_in, const float* w_out, const float* bff, const float* bmi, const float* bmf,
                                            unsigned char* ws, LAS unsigned char* lds, int tid, int lane, int wave, int bid, int G) {
    LAS float* scr = (LAS float*)(lds + wave * 16384);
    const int gw = bid * 8 + wave, NGW = G * 8;
    constexpr int I_IN = 16 * (NZ / 32), I_OUT = 16 * 32;
    for (int it = gw; it < NL * (I_IN + I_OUT); it += NGW) {
        const int l = it / (I_IN + I_OUT); int r = it % (I_IN + I_OUT);
        if (r < I_IN) { const int kb = r / (NZ / 32), nb = r % (NZ / 32); const int n0 = nb * 32;
            const float* cp = w_in + (size_t)l * DM * INW + win_srccol(n0 + (lane & 31));
            transpose_item(cp, INW, (bf16_t*)(ws + WS_WIN) + (size_t)l * NZ * DM, DM, kb * 64, n0, scr, lane);
        } else { r -= I_IN; const int kb = r / 32, nb = r % 32; const int n0 = nb * 32;
            const float* cp = w_out + (size_t)l * DM * DM + n0 + (lane & 31);
            transpose_item(cp, DM, (bf16_t*)(ws + WS_WOUT) + (size_t)l * DM * DM, DM, kb * 64, n0, scr, lane); }
    }
    {
        const double inv[8] = {1.0, 0.19392274474868576, 0.03760603093086393, 0.007292664737217109, 0.001414213562373095, 0.0002742481756762073, 5.318295896944988e-05, 1.031338537721246e-05};
        float* rt = (float*)(ws + WS_ROPE);
        for (int idx = bid * 512 + tid; idx < S * 8; idx += G * 512) { const int t = idx >> 3, i = idx & 7; double iv = inv[0];
#pragma unroll
            for (int q = 1; q < 8; ++q) iv = (i == q) ? inv[q] : iv;
            const double ang = (double)pos[t] * iv; rt[2 * idx] = (float)cos(ang); rt[2 * idx + 1] = (float)sin(ang); }
    }
    __syncthreads();
    LAS float* w12 = (LAS float*)lds;
    load_w12(w_in, w12, tid);
    __syncthreads();
    float* flf = (float*)(ws + SM_FLF); float* mli = (float*)(ws + SM_MLI); float* mlf = (float*)(ws + SM_MLF);
    bf16_t* xb = (bf16_t*)(ws + WS_ACTB);
#pragma unroll 2
    for (int t = gw; t < S; t += NGW) {
        f32x4 v[4];
#pragma unroll
        for (int j = 0; j < 4; ++j) v[j] = *(const f32x4*)(x + (size_t)t * DM + 256 * j + 4 * lane);
        store_row_bf16(v, xb + (size_t)t * DM, lane);
        gates_row(v, w12, bff, bmi, bmf, flf, mli, mlf, t, lane);
    }
    __syncthreads();
}

__device__ __forceinline__ void moe_weights(const float* w_gate_l, const float* w_up_l, const float* w_down_l, unsigned char* ws, LAS unsigned char* lds, int lane, int wave, int gw, int NGW, int it0, int it1) {
    LAS float* scr = (LAS float*)(lds + wave * 16384);
    constexpr int I_GU = 16 * 32, I_D = 8 * 32;
    for (int it = it0 + gw; it < it1; it += NGW) {
        const int e = it / (I_GU + I_D); int r = it % (I_GU + I_D);
        if (r < I_GU) { const int kb = r / 32, nb = r % 32, n0 = nb * 32; const int n = n0 + (lane & 31); const int a = n >> 3, b = n & 7; const int hid = 4 * a + (b & 3);
            const float* cp = ((b >> 2) ? w_up_l : w_gate_l) + (size_t)e * DM * DE + hid;
            transpose_item(cp, DE, (bf16_t*)(ws + WS_WGU) + (size_t)e * DM * DM, DM, kb * 64, n0, scr, lane);
        } else { r -= I_GU; const int kb = r / 32, nb = r % 32, n0 = nb * 32;
            const float* cp = w_down_l + (size_t)e * DE * DM + n0 + (lane & 31);
            transpose_item(cp, DM, (bf16_t*)(ws + WS_WD) + (size_t)e * DM * DE, DE, kb * 64, n0, scr, lane); }
    }
}
constexpr int MOE_ITEMS = NE * (16 * 32 + 8 * 32);
constexpr int MOE_FILL = 6144;
__device__ __forceinline__ void mix1_unit(int u, unsigned char* ws, unsigned* ctl_kmax, LAS unsigned char* lds, int tid, int lane, int wave) {
    const int blk = u >> 2, h = u & 3, t0 = blk * 256;
    bf16_t* ZR = (bf16_t*)(ws + WS_ZR);
    const float* rope = (const float*)(ws + WS_ROPE);
    LAS float* kr = (LAS float*)lds;
    LAS float* part = (LAS float*)(lds + 16384);
    LAS float* sq = (LAS float*)(lds + 16384 + 2048);
    {
        const int tl = tid & 255, which = tid >> 8; const int t = t0 + tl;
        bf16_t* p = ZR + (size_t)t * ZRW + (which ? ZR_BK : ZR_BQ) + h * 64;
        const u32x4 w0 = *(const u32x4*)p, w1 = *(const u32x4*)(p + 8);
        float u1[8], u2[8];
        u1[0] = bflo(w0.x); u1[1] = bfhi(w0.x); u1[2] = bflo(w0.y); u1[3] = bfhi(w0.y); u1[4] = bflo(w0.z); u1[5] = bfhi(w0.z); u1[6] = bflo(w0.w); u1[7] = bfhi(w0.w);
        u2[0] = bflo(w1.x); u2[1] = bfhi(w1.x); u2[2] = bflo(w1.y); u2[3] = bfhi(w1.y); u2[4] = bflo(w1.z); u2[5] = bfhi(w1.z); u2[6] = bflo(w1.w); u2[7] = bfhi(w1.w);
        float o1[8], o2[8];
#pragma unroll
        for (int i = 0; i < 8; ++i) { const f32x2 cs = *(const f32x2*)(rope + ((size_t)t * 8 + i) * 2); o1[i] = u1[i] * cs.x - u2[i] * cs.y; o2[i] = u1[i] * cs.y + u2[i] * cs.x; }
        u32x4 r0, r1;
        r0.x = pk2(o1[0], o1[1]); r0.y = pk2(o1[2], o1[3]); r0.z = pk2(o1[4], o1[5]); r0.w = pk2(o1[6], o1[7]);
        r1.x = pk2(o2[0], o2[1]); r1.y = pk2(o2[2], o2[3]); r1.z = pk2(o2[4], o2[5]); r1.w = pk2(o2[6], o2[7]);
        *(u32x4*)p = r0; *(u32x4*)(p + 8) = r1;
        if (which) {
            LAS float* d = kr + tl * 16;
            d[0] = bflo(r0.x); d[1] = bfhi(r0.x); d[2] = bflo(r0.y); d[3] = bfhi(r0.y); d[4] = bflo(r0.z); d[5] = bfhi(r0.z); d[6] = bflo(r0.w); d[7] = bfhi(r0.w);
            d[8] = bflo(r1.x); d[9] = bfhi(r1.x); d[10] = bflo(r1.y); d[11] = bfhi(r1.y); d[12] = bflo(r1.z); d[13] = bfhi(r1.z); d[14] = bflo(r1.w); d[15] = bfhi(r1.w);
        }
    }
    {
        const int tl = tid & 255, half = tid >> 8;
        const bf16_t* p = ZR + (size_t)(t0 + tl) * ZRW + ZR_FK + h * 64 + half * 32;
        float s = 0.f;
#pragma unroll
        for (int j = 0; j < 4; ++j) { const u32x4 w = *(const u32x4*)(p + 8 * j);
            float a;
            a = bflo(w.x); s += a * a; a = bfhi(w.x); s += a * a; a = bflo(w.y); s += a * a; a = bfhi(w.y); s += a * a;
            a = bflo(w.z); s += a * a; a = bfhi(w.z); s += a * a; a = bflo(w.w); s += a * a; a = bfhi(w.w); s += a * a; }
        sq[tid] = s;
    }
    __syncthreads();
    {
        const int d = tid & 63, pp = tid >> 6; float s = 0.f;
        if (d < 16) { for (int i = 0; i < 32; ++i) s += kr[(pp * 32 + i) * 16 + d]; }
        else { const bf16_t* p = ZR + (size_t)(t0 + pp * 32) * ZRW + ZR_BK + h * 64 + d; for (int i = 0; i < 32; ++i) s += bf2f(p[(size_t)i * ZRW]); }
        part[pp * 64 + d] = s;
    }
    if (wave < 4) {
        const float* flf = (const float*)(ws + SM_FLF) + (size_t)h * S + t0 + wave * 64;
        float v = flf[lane];
#pragma unroll
        for (int o = 1; o < 64; o <<= 1) { const float n = __shfl_up(v, o); if (lane >= o) v += n; }
        ((float*)(ws + SM_FCL))[(size_t)h * S + t0 + wave * 64 + lane] = v;
        if (lane == 63) ((float*)(ws + SM_FTS))[h * 256 + blk * 4 + wave] = v;
    } else {
        const int i = tid - 256; float m = sq[i] + sq[i + 256];
        m = wave_max(m);
        if (lane == 0) atomicMax(ctl_kmax + h, __builtin_bit_cast(unsigned, m));
    }
    __syncthreads();
    if (tid < 64) { float s = 0.f;
#pragma unroll
        for (int pp = 0; pp < 8; ++pp) s += part[pp * 64 + tid];
        ((float*)(ws + SM_KMEAN))[((size_t)h * 64 + blk) * 64 + tid] = s * (1.f / 256.f); }
    __syncthreads();
}
struct RowState { f32x4 O[4]; float m, l; };
constexpr float LOG2E = 1.4426950408889634f, SC2 = 0.125f * LOG2E;

struct KVFrag { bf16x8 k[4]; u32x2 v[8]; };
__device__ __forceinline__ void kv_fetch(KVFrag& f, const bf16_t* krow, const bf16_t* vT, int kb, int lane) {
    const int qi = lane & 15, g = lane >> 4;
    const bf16_t* k0p = krow + (size_t)(kb + qi) * ZRW + 8 * g;
    const bf16_t* k1p = k0p + (size_t)16 * ZRW;
    f.k[0] = *(const bf16x8*)k0p; f.k[1] = *(const bf16x8*)(k0p + 32); f.k[2] = *(const bf16x8*)k1p; f.k[3] = *(const bf16x8*)(k1p + 32);
#pragma unroll
    for (int dt = 0; dt < 4; ++dt) { const bf16_t* vp = vT + (size_t)(16 * dt + qi) * ZTP + kb + 4 * g; f.v[2 * dt] = *(const u32x2*)vp; f.v[2 * dt + 1] = *(const u32x2*)(vp + 16); }
}
__device__ __forceinline__ void attn_compute32(RowState& st, const bf16x8 (&Qf)[2], const KVFrag& f, const f32x4 b0, const f32x4 b1) {
    f32x4 s0 = {0.f, 0.f, 0.f, 0.f}, s1 = {0.f, 0.f, 0.f, 0.f};
    s0 = MFMA16(f.k[0], Qf[0], s0); s0 = MFMA16(f.k[1], Qf[1], s0);
    s1 = MFMA16(f.k[2], Qf[0], s1); s1 = MFMA16(f.k[3], Qf[1], s1);
    float mx = -INFINITY;
#pragma unroll
    for (int r = 0; r < 4; ++r) { s0[r] = s0[r] * SC2 + b0[r]; s1[r] = s1[r] * SC2 + b1[r]; mx = fmaxf(mx, fmaxf(s0[r], s1[r])); }
    mx = grp_max(mx);
    float ps = 0.f; float p0[4], p1[4];
    if (__all(mx <= st.m)) {
#pragma unroll
        for (int r = 0; r < 4; ++r) { p0[r] = __builtin_amdgcn_exp2f(s0[r] - st.m); p1[r] = __builtin_amdgcn_exp2f(s1[r] - st.m); ps += p0[r] + p1[r]; }
        st.l += ps;
    } else {
        const float mn = fmaxf(st.m, mx);
        const float msafe = (mn == -INFINITY) ? 0.f : mn;
        const float alpha = __builtin_amdgcn_exp2f(st.m - msafe);
#pragma unroll
        for (int r = 0; r < 4; ++r) { p0[r] = __builtin_amdgcn_exp2f(s0[r] - msafe); p1[r] = __builtin_amdgcn_exp2f(s1[r] - msafe); ps += p0[r] + p1[r]; }
        st.l = st.l * alpha + ps; st.m = mn;
#pragma unroll
        for (int dt = 0; dt < 4; ++dt) st.O[dt] = st.O[dt] * alpha;
    }
    u32x4 pw; pw.x = pk2(p0[0], p0[1]); pw.y = pk2(p0[2], p0[3]); pw.z = pk2(p1[0], p1[1]); pw.w = pk2(p1[2], p1[3]);
    const bf16x8 pb = __builtin_bit_cast(bf16x8, pw);
#pragma unroll
    for (int dt = 0; dt < 4; ++dt) { u32x4 vw; vw.x = f.v[2 * dt].x; vw.y = f.v[2 * dt].y; vw.z = f.v[2 * dt + 1].x; vw.w = f.v[2 * dt + 1].y;
        st.O[dt] = MFMA16(__builtin_bit_cast(bf16x8, vw), pb, st.O[dt]); }
}
__device__ __forceinline__ void attn_finish(RowState& st, const float* gain, bf16_t* yrow, int lane) {
    const int g = lane >> 4;
    const float inv = 1.f / st.l; float ss = 0.f;
#pragma unroll
    for (int dt = 0; dt < 4; ++dt) { st.O[dt] = st.O[dt] * inv; ss += (st.O[dt].x * st.O[dt].x + st.O[dt].y * st.O[dt].y) + (st.O[dt].z * st.O[dt].z + st.O[dt].w * st.O[dt].w); }
    ss = grp_sum(ss);
    const float rs = rsqrtf(ss * (1.f / 64.f) + EPS);
#pragma unroll
    for (int dt = 0; dt < 4; ++dt) { const f32x4 gg = *(const f32x4*)(gain + 16 * dt + 4 * g); const f32x4 o = st.O[dt] * rs * gg;
        u32x2 w; w.x = pk2(o.x, o.y); w.y = pk2(o.z, o.w); *(u32x2*)(yrow + 16 * dt + 4 * g) = w; }
}

constexpr int KS_PITCH = 72, VS_PITCH = 264, KS_BYTES = 256 * KS_PITCH * 2, VS_BYTES = 64 * VS_PITCH * 2;
__device__ __forceinline__ void stage_kv_block(const bf16_t* krow  , const bf16_t* vT  , int key0, LAS unsigned char* lds, int tid) {
    LAS unsigned char* Ks = lds; LAS unsigned char* Vs = lds + KS_BYTES;
#pragma unroll
    for (int i = 0; i < 4; ++i) { const int c = tid + 512 * i; const int row = c >> 3, part = c & 7;
        const u32x4 v = *(const u32x4*)(krow + (size_t)(key0 + row) * ZRW + part * 8);
        *(LAS u32x4*)(Ks + row * (KS_PITCH * 2) + part * 16) = v; }
#pragma unroll
    for (int i = 0; i < 4; ++i) { const int c = tid + 512 * i; const int row = c >> 5, part = c & 31;
        const u32x4 v = *(const u32x4*)(vT + (size_t)row * ZTP + key0 + part * 8);
        *(LAS u32x4*)(Vs + row * (VS_PITCH * 2) + part * 16) = v; }
}
template <int VPB>
__device__ __forceinline__ void attn_step32_ldsp(RowState& st, const bf16x8 (&Qf)[2], LAS unsigned char* Ks, LAS unsigned char* Vs, int kb, const f32x4 b0, const f32x4 b1, int lane) {
    const int qi = lane & 15, g = lane >> 4;
    f32x4 s0 = {0.f, 0.f, 0.f, 0.f}, s1 = {0.f, 0.f, 0.f, 0.f};
    const LAS unsigned char* k0p = Ks + (kb + qi) * (KS_PITCH * 2) + 16 * g;
    const LAS unsigned char* k1p = k0p + 16 * (KS_PITCH * 2);
    s0 = MFMA16(*(const LAS bf16x8*)k0p, Qf[0], s0); s0 = MFMA16(*(const LAS bf16x8*)(k0p + 64), Qf[1], s0);
    s1 = MFMA16(*(const LAS bf16x8*)k1p, Qf[0], s1); s1 = MFMA16(*(const LAS bf16x8*)(k1p + 64), Qf[1], s1);
    float mx = -INFINITY;
#pragma unroll
    for (int r = 0; r < 4; ++r) { s0[r] = s0[r] * SC2 + b0[r]; s1[r] = s1[r] * SC2 + b1[r]; mx = fmaxf(mx, fmaxf(s0[r], s1[r])); }
    mx = grp_max(mx);
    float ps = 0.f; float p0[4], p1[4];
    if (__all(mx <= st.m)) {
#pragma unroll
        for (int r = 0; r < 4; ++r) { p0[r] = __builtin_amdgcn_exp2f(s0[r] - st.m); p1[r] = __builtin_amdgcn_exp2f(s1[r] - st.m); ps += p0[r] + p1[r]; }
        st.l += ps;
    } else {
        const float mn = fmaxf(st.m, mx);
        const float msafe = (mn == -INFINITY) ? 0.f : mn;
        const float alpha = __builtin_amdgcn_exp2f(st.m - msafe);
#pragma unroll
        for (int r = 0; r < 4; ++r) { p0[r] = __builtin_amdgcn_exp2f(s0[r] - msafe); p1[r] = __builtin_amdgcn_exp2f(s1[r] - msafe); ps += p0[r] + p1[r]; }
        st.l = st.l * alpha + ps; st.m = mn;
#pragma unroll
        for (int dt = 0; dt < 4; ++dt) st.O[dt] = st.O[dt] * alpha;
    }
    u32x4 pw; pw.x = pk2(p0[0], p0[1]); pw.y = pk2(p0[2], p0[3]); pw.z = pk2(p1[0], p1[1]); pw.w = pk2(p1[2], p1[3]);
    const bf16x8 pb = __builtin_bit_cast(bf16x8, pw);
#pragma unroll
    for (int dt = 0; dt < 4; ++dt) { const LAS unsigned char* vp = Vs + (16 * dt + qi) * VPB + (kb + 4 * g) * 2;
        u32x4 vw; const u32x2 lo = *(const LAS u32x2*)vp, hi = *(const LAS u32x2*)(vp + 32); vw.x = lo.x; vw.y = lo.y; vw.z = hi.x; vw.w = hi.y;
        st.O[dt] = MFMA16(__builtin_bit_cast(bf16x8, vw), pb, st.O[dt]); }
}

__device__ __forceinline__ void attn_step32_lds(RowState& st, const bf16x8 (&Qf)[2], LAS unsigned char* lds, int kb, const f32x4 b0, const f32x4 b1, int lane) {
    attn_step32_ldsp<VS_PITCH * 2>(st, Qf, lds, lds + KS_BYTES, kb, b0, b1, lane);
}

constexpr int FW_KEYS = 384, FW_VPB = (FW_KEYS + 8) * 2, FW_KBYTES = FW_KEYS * KS_PITCH * 2, FW_VBYTES = 64 * FW_VPB;
__device__ __forceinline__ void fox_unit(int h, int qt, unsigned char* ws, float kmaxn, const float* g_fox, LAS unsigned char* lds, int tid, int lane, int wave, int cap = 1 << 30, bf16_t* ydst = nullptr) {
    const int qi = lane & 15, g = lane >> 4;
    const int Q0 = qt * 128, q0 = Q0 + wave * 16, q = q0 + qi;
    const bf16_t* ZR = (const bf16_t*)(ws + WS_ZR); const bf16_t* ZT = (const bf16_t*)(ws + WS_ZT);
    const float* clh = (const float*)(ws + SM_FCL) + (size_t)h * S; const float* tsum = (const float*)(ws + SM_FTS) + h * 256;
    const bf16_t* krow = ZR + ZR_FK + h * 64; const bf16_t* vT = ZT + (size_t)(ZT_FV + h * 64) * ZTP;
    LAS unsigned char* Kw = lds; LAS unsigned char* Vw = lds + FW_KBYTES; LAS float* clw = (LAS float*)(lds + FW_KBYTES + FW_VBYTES);
    const int kw0 = Q0 >= 256 ? Q0 - 256 : 0, nk = Q0 + 128 - kw0;
    __syncthreads();
    for (int c = tid; c < nk * 8; c += 512) { const int row = c >> 3, part = c & 7;
        *(LAS u32x4*)(Kw + row * (KS_PITCH * 2) + part * 16) = *(const u32x4*)(krow + (size_t)(kw0 + row) * ZRW + part * 8); }
    { const int cpr = nk >> 3;
      for (int c = tid; c < 64 * cpr; c += 512) { const int row = c / cpr, part = c - row * cpr;
        *(LAS u32x4*)(Vw + row * FW_VPB + part * 16) = *(const u32x4*)(vT + (size_t)row * ZTP + kw0 + part * 8); } }
    for (int c = tid; c < nk; c += 512) clw[c] = clh[kw0 + c] * LOG2E;
    const bf16_t* qrow = ZR + (size_t)q * ZRW + ZR_FQ + h * 64;
    bf16x8 Qf[2]; Qf[0] = *(const bf16x8*)(qrow + 8 * g); Qf[1] = *(const bf16x8*)(qrow + 32 + 8 * g);
    float qs = 0.f;
#pragma unroll
    for (int k = 0; k < 2; ++k)
#pragma unroll
        for (int e = 0; e < 8; ++e) { const float v = bf2f((unsigned short)Qf[k][e]); qs += v * v; }
    const float qn = sqrtf(grp_sum(qs));
    const float cq = clh[q] * LOG2E;
    RowState st;
#pragma unroll
    for (int dt = 0; dt < 4; ++dt) st.O[dt] = (f32x4){0.f, 0.f, 0.f, 0.f};
    st.m = -INFINITY; st.l = 0.f;
    __syncthreads();
    float dT = 0.f; int ktile = q0 >> 6;
    int kb = q0 & ~31;
    bool more = true;
    for (; kb >= kw0; kb -= 32) {
        const int kt = kb >> 6;
        if (kt != ktile) { dT += tsum[kt] * LOG2E; ktile = kt; }
        const float bq = cq + dT; const int kl = kb - kw0;
        const f32x4 c0 = *(const LAS f32x4*)(clw + kl + 4 * g), c1 = *(const LAS f32x4*)(clw + kl + 16 + 4 * g);
        f32x4 b0, b1;
#pragma unroll
        for (int r = 0; r < 4; ++r) { b0[r] = (kb + 4 * g + r <= q) ? bq - c0[r] : -INFINITY; b1[r] = (kb + 16 + 4 * g + r <= q) ? bq - c1[r] : -INFINITY; }
        attn_step32_ldsp<FW_VPB>(st, Qf, Kw, Vw, kl, b0, b1, lane);
        if (kb == 0) { more = false; break; }
        const float bound = qn * kmaxn * SC2 + (bq - clw[kl]);
        if (__all(bound < st.m - 40.f * LOG2E)) { more = false; break; }
        if (--cap <= 0) { more = false; break; }
    }
    if (more) {
        KVFrag cur, nxt;
        kv_fetch(cur, krow, vT, kb, lane);
        for (; kb >= 0; kb -= 32) {
            if (kb >= 32) kv_fetch(nxt, krow, vT, kb - 32, lane);
            const int kt = kb >> 6;
            if (kt != ktile) { dT += tsum[kt] * LOG2E; ktile = kt; }
            const float bq = cq + dT;
            const f32x4 c0 = *(const f32x4*)(clh + kb + 4 * g), c1 = *(const f32x4*)(clh + kb + 16 + 4 * g);
            f32x4 b0, b1;
#pragma unroll
            for (int r = 0; r < 4; ++r) { b0[r] = bq - c0[r] * LOG2E; b1[r] = bq - c1[r] * LOG2E; }
            attn_compute32(st, Qf, cur, b0, b1);
            if (kb == 0) break;
            const float bound = qn * kmaxn * SC2 + (bq - clh[kb] * LOG2E);
            if (__all(bound < st.m - 40.f * LOG2E)) break;
            cur = nxt;
        }
    }
    st.l = grp_sum(st.l);
    attn_finish(st, g_fox + h * 64, (ydst ? ydst : (bf16_t*)(ws + WS_Y)) + (size_t)q * DM + h * 64, lane);
}

__device__ __forceinline__ void moba_gate_unit(int h, int qt, unsigned char* ws, LAS unsigned char* lds, int tid, int lane, int wave) {
    const int own = qt >> 1;
    unsigned* msel = (unsigned*)(ws + SM_MSEL) + (size_t)h * S;
    int* cntq = (int*)(ws + SM_CNTQ) + (size_t)h * 64 * 128;
    const int tq0 = qt * 128 + wave * 16;
    if (own == 0) { if (lane < 16) msel[tq0 + lane] = 0u; if (tid < 64) cntq[tid * 128 + qt] = 0; return; }
    LAS int* hist = (LAS int*)lds;
    __syncthreads();
    if (tid < 64) hist[tid] = 0;
    __syncthreads();
    const int qi = lane & 15, g = lane >> 4;
    const bf16_t* qrow = (const bf16_t*)(ws + WS_ZR) + (size_t)(tq0 + qi) * ZRW + ZR_BQ + h * 64;
    bf16x8 Qf[2]; Qf[0] = *(const bf16x8*)(qrow + 8 * g); Qf[1] = *(const bf16x8*)(qrow + 32 + 8 * g);
    const float* kmean = (const float*)(ws + SM_KMEAN) + (size_t)h * 64 * 64;
    float v[16];
#pragma unroll
    for (int tile = 0; tile < 4; ++tile) {
        f32x4 acc = {0.f, 0.f, 0.f, 0.f};
#pragma unroll
        for (int ks = 0; ks < 2; ++ks) {
            const float* kp = kmean + (size_t)(16 * tile + qi) * 64 + 32 * ks + 8 * g;
            const f32x4 a0 = *(const f32x4*)kp, a1 = *(const f32x4*)(kp + 4);
            u32x4 hi, lo;
            hi.x = pk2(a0.x, a0.y); hi.y = pk2(a0.z, a0.w); hi.z = pk2(a1.x, a1.y); hi.w = pk2(a1.z, a1.w);
            lo.x = pk2(a0.x - bflo(hi.x), a0.y - bfhi(hi.x)); lo.y = pk2(a0.z - bflo(hi.y), a0.w - bfhi(hi.y));
            lo.z = pk2(a1.x - bflo(hi.z), a1.y - bfhi(hi.z)); lo.w = pk2(a1.z - bflo(hi.w), a1.w - bfhi(hi.w));
            acc = MFMA16(__builtin_bit_cast(bf16x8, hi), Qf[ks], acc);
            acc = MFMA16(__builtin_bit_cast(bf16x8, lo), Qf[ks], acc);
        }
#pragma unroll
        for (int r = 0; r < 4; ++r) v[4 * tile + r] = (16 * tile + 4 * g + r < own) ? acc[r] : -INFINITY;
    }
    const int nv = own < 3 ? own : 3;
    unsigned sel = 0u;
#pragma unroll
    for (int k = 0; k < 3; ++k) {
        float lm = v[0]; int li = 4 * g;
#pragma unroll
        for (int e = 1; e < 16; ++e) { const int jj = 16 * (e >> 2) + 4 * g + (e & 3); if (v[e] > lm) { lm = v[e]; li = jj; } }
        const float gm = grp_max(lm);
        int cand = (lm == gm) ? li : 255;
        cand = min(cand, __shfl_xor(cand, 16)); cand = min(cand, __shfl_xor(cand, 32));
        sel |= (unsigned)cand << (8 * k);
#pragma unroll
        for (int e = 0; e < 16; ++e) { const int jj = 16 * (e >> 2) + 4 * g + (e & 3); if (jj == cand) v[e] = -INFINITY; }
    }
    if (g < nv) { const int j = (int)((sel >> (8 * g)) & 0xff);
        const int pos = __hip_atomic_fetch_add(hist + j, 1, __ATOMIC_RELAXED, __HIP_MEMORY_SCOPE_WORKGROUP);
        ((unsigned short*)(ws + T_QIDX))[(((size_t)h * 64 + j) * 128 + qt) * 128 + pos] = (unsigned short)((wave * 16 + qi) | (g << 7)); }
    if (g == 0) msel[tq0 + qi] = (sel & 0xffffffu) | ((unsigned)nv << 24);
    __syncthreads();
    if (tid < 64) cntq[tid * 128 + qt] = hist[tid];
}

__device__ __forceinline__ void moba_part_unit(int h, int j, int ch, int tot, unsigned char* ws, LAS unsigned char* lds, LAS unsigned char* ltab, int tid, int lane, int wave, int dbg = 0) {
    LAS int* pfx = (LAS int*)(ltab + 2112);
    LAS unsigned* slice = (LAS unsigned*)(ltab + 2640);
    LAS int* wtot = (LAS int*)(ltab + 3664);
    const unsigned* msel = (const unsigned*)(ws + SM_MSEL) + (size_t)h * S;
    const int* cntq = (const int*)(ws + SM_CNTQ) + ((size_t)h * 64 + j) * 128;
    const bf16_t* ZR = (const bf16_t*)(ws + WS_ZR); const bf16_t* ZT = (const bf16_t*)(ws + WS_ZT);
    __syncthreads();
    stage_kv_block(ZR + ZR_BK + h * 64, ZT + (size_t)(ZT_BV + h * 64) * ZTP, j * 256, lds, tid);
    if (wave == 0) {
        int v0 = cntq[lane], v1 = cntq[64 + lane];
#pragma unroll
        for (int o = 1; o < 64; o <<= 1) { const int n0 = __shfl_up(v0, o), n1 = __shfl_up(v1, o); if (lane >= o) { v0 += n0; v1 += n1; } }
        v1 += __shfl(v0, 63);
        if (lane == 0) pfx[0] = 0;
        pfx[1 + lane] = v0; pfx[65 + lane] = v1;
    }
    __syncthreads();
    const int lo_pos = 256 * ch, hi_pos = (lo_pos + 256 < tot) ? lo_pos + 256 : tot;
    if (tid < hi_pos - lo_pos) {
        const int pos = lo_pos + tid;
        int a = 0, b = 127; while (a < b) { const int mid = (a + b + 1) >> 1; if (pfx[mid] <= pos) a = mid; else b = mid - 1; }
        const unsigned w = ((const unsigned short*)(ws + T_QIDX))[(((size_t)h * 64 + j) * 128 + a) * 128 + (pos - pfx[a])];
        slice[tid] = (unsigned)(a * 128 + (w & 127u)) | ((w >> 7) << 14);
    }
    __syncthreads();
    const int n = hi_pos - lo_pos;
    const int qi = lane & 15, g = lane >> 4;
    const int pA = wave * 16, pB = 128 + wave * 16;
    if (pA >= n) return;
    const bool hasB = pB < n;
    const bool vA = pA + qi < n, vB = pB + qi < n;
    const unsigned eA = slice[vA ? pA + qi : n - 1], eB = slice[vB ? pB + qi : n - 1];
    const int tA = eA & 0x3fff, rA = eA >> 14, tB = eB & 0x3fff, rB = eB >> 14;
    const bf16_t* qrA = ZR + (size_t)tA * ZRW + ZR_BQ + h * 64; const bf16_t* qrB = ZR + (size_t)tB * ZRW + ZR_BQ + h * 64;
    bf16x8 QA[2], QB[2]; QA[0] = *(const bf16x8*)(qrA + 8 * g); QA[1] = *(const bf16x8*)(qrA + 32 + 8 * g); QB[0] = *(const bf16x8*)(qrB + 8 * g); QB[1] = *(const bf16x8*)(qrB + 32 + 8 * g);
    RowState sA, sB;
#pragma unroll
    for (int dt = 0; dt < 4; ++dt) { sA.O[dt] = (f32x4){0.f, 0.f, 0.f, 0.f}; sB.O[dt] = (f32x4){0.f, 0.f, 0.f, 0.f}; }
    sA.m = -INFINITY; sA.l = 0.f; sB.m = -INFINITY; sB.l = 0.f;
    const f32x4 z = {0.f, 0.f, 0.f, 0.f};
    if (dbg & 1) { sA.l = 1.f; sB.l = 1.f; sA.m = 0.f; sB.m = 0.f; }
    else if (hasB) {
#pragma unroll 4
        for (int kb = 0; kb < 256; kb += 32) { attn_step32_lds(sA, QA, lds, kb, z, z, lane); attn_step32_lds(sB, QB, lds, kb, z, z, lane); } }
    else {
#pragma unroll 4
        for (int kb = 0; kb < 256; kb += 32) attn_step32_lds(sA, QA, lds, kb, z, z, lane); }
    if (dbg & 2) return;
    sA.l = grp_sum(sA.l);
    if (vA) {
        const float inv = 1.f / sA.l;
        bf16_t* po = (bf16_t*)(ws + T_MPO) + (((size_t)h * S + tA) * 3 + rA) * 64;
#pragma unroll
        for (int dt = 0; dt < 4; ++dt) { const f32x4 o = sA.O[dt] * inv; u32x2 w; w.x = pk2(o.x, o.y); w.y = pk2(o.z, o.w); *(u32x2*)(po + 16 * dt + 4 * g) = w; }
        if (g == 0) { float* pm = (float*)(ws + T_MPML) + (((size_t)h * S + tA) * 3 + rA) * 2; pm[0] = sA.m; pm[1] = sA.l; }
    }
    if (hasB) {
        sB.l = grp_sum(sB.l);
        if (vB) {
            const float inv = 1.f / sB.l;
            bf16_t* po = (bf16_t*)(ws + T_MPO) + (((size_t)h * S + tB) * 3 + rB) * 64;
#pragma unroll
            for (int dt = 0; dt < 4; ++dt) { const f32x4 o = sB.O[dt] * inv; u32x2 w; w.x = pk2(o.x, o.y); w.y = pk2(o.z, o.w); *(u32x2*)(po + 16 * dt + 4 * g) = w; }
            if (g == 0) { float* pm = (float*)(ws + T_MPML) + (((size_t)h * S + tB) * 3 + rB) * 2; pm[0] = sB.m; pm[1] = sB.l; }
        }
    }
}

__device__ __forceinline__ void moba_own_unit(int h, int ob, unsigned char* ws, const float* g_moba, LAS unsigned char* lds, int tid, int lane, int wave) {
    const int qi = lane & 15, g = lane >> 4;
    const bf16_t* ZR = (const bf16_t*)(ws + WS_ZR); const bf16_t* ZT = (const bf16_t*)(ws + WS_ZT);
    __syncthreads();
    stage_kv_block(ZR + ZR_BK + h * 64, ZT + (size_t)(ZT_BV + h * 64) * ZTP, ob * 256, lds, tid);
    __syncthreads();
    const int nv = ob < 3 ? ob : 3;
    for (int pass = 0; pass < 2; ++pass) {
        const int ql0 = pass * 128 + wave * 16, ql = ql0 + qi, q = ob * 256 + ql;
        const bf16_t* qrow = ZR + (size_t)q * ZRW + ZR_BQ + h * 64;
        bf16x8 Qf[2]; Qf[0] = *(const bf16x8*)(qrow + 8 * g); Qf[1] = *(const bf16x8*)(qrow + 32 + 8 * g);
        RowState st;
#pragma unroll
        for (int dt = 0; dt < 4; ++dt) st.O[dt] = (f32x4){0.f, 0.f, 0.f, 0.f};
        st.m = -INFINITY; st.l = 0.f;
        for (int kb = ql0 & ~31; kb >= 0; kb -= 32) {
            f32x4 b0, b1;
#pragma unroll
            for (int r = 0; r < 4; ++r) { b0[r] = (kb + 4 * g + r <= ql) ? 0.f : -INFINITY; b1[r] = (kb + 16 + 4 * g + r <= ql) ? 0.f : -INFINITY; }
            attn_step32_lds(st, Qf, lds, kb, b0, b1, lane);
        }
        st.l = grp_sum(st.l);
        for (int rk = 0; rk < nv; ++rk) {
            const float* pm = (const float*)(ws + T_MPML) + (((size_t)h * S + q) * 3 + rk) * 2;
            const float mk = pm[0], lk = pm[1];
            const float M = fmaxf(st.m, mk);
            const float a = __builtin_amdgcn_exp2f(st.m - M), b = lk * __builtin_amdgcn_exp2f(mk - M);
            const bf16_t* po = (const bf16_t*)(ws + T_MPO) + (((size_t)h * S + q) * 3 + rk) * 64;
#pragma unroll
            for (int dt = 0; dt < 4; ++dt) { const u32x2 w = *(const u32x2*)(po + 16 * dt + 4 * g);
                const f32x4 ok = {bflo(w.x), bfhi(w.x), bflo(w.y), bfhi(w.y)};
                st.O[dt] = st.O[dt] * a + ok * b; }
            st.l = st.l * a + b; st.m = M;
        }
        attn_finish(st, g_moba + h * 64, (bf16_t*)(ws + WS_Y) + (size_t)q * DM + 768 + h * 64, lane);
    }
}
constexpr int KT_PITCH = 136;

__device__ __forceinline__ void mlstm_local_unit(int h, int c, unsigned char* ws, const float* conv_w_l, LAS unsigned char* lds, int tid, int lane, int wave) {
    const int t0 = c * 128;
    LAS float* sws = (LAS float*)lds;
    LAS bf16_t* kT = (LAS bf16_t*)(lds + 1024);
    __syncthreads();
    if (wave == 0) {
        const float* mlf = (const float*)(ws + SM_MLF) + (size_t)h * S + t0; const float* mli = (const float*)(ws + SM_MLI) + (size_t)h * S + t0;
        float v0 = mlf[lane], v1 = mlf[64 + lane];
#pragma unroll
        for (int o = 1; o < 64; o <<= 1) { const float n0 = __shfl_up(v0, o), n1 = __shfl_up(v1, o); if (lane >= o) { v0 += n0; v1 += n1; } }
        const float tot0 = __shfl(v0, 63); v1 += tot0;
        const float blast = __shfl(v1, 63);
        const float li0 = mli[lane], li1 = mli[64 + lane];
        const float g0 = blast - v0 + li0, g1 = blast - v1 + li1;
        const float mloc = wave_max(fmaxf(g0, g1));
        sws[lane] = __expf(g0 - mloc); sws[64 + lane] = __expf(g1 - mloc);
        const float a0 = li0 - v0, a1 = li1 - v1;
        float p0 = a0, p1 = a1;
#pragma unroll
        for (int o = 1; o < 64; o <<= 1) { const float n0 = __shfl_up(p0, o), n1 = __shfl_up(p1, o); if (lane >= o) { p0 = fmaxf(p0, n0); p1 = fmaxf(p1, n1); } }
        p1 = fmaxf(p1, __shfl(p0, 63));
        float* mb = (float*)(ws + SM_MB) + (size_t)h * S + t0; float* ma = (float*)(ws + SM_MA) + (size_t)h * S + t0; float* mpx = (float*)(ws + SM_MPX) + (size_t)h * S + t0;
        mb[lane] = v0; mb[64 + lane] = v1; ma[lane] = a0; ma[64 + lane] = a1; mpx[lane] = p0; mpx[64 + lane] = p1;
        if (lane == 0) { float* sc = (float*)(ws + SM_MLSC); sc[h * 128 + c] = blast; sc[512 + h * 128 + c] = mloc; }
    }
    __syncthreads();
    {
        const bf16_t* ZR = (const bf16_t*)(ws + WS_ZR);
        bf16_t* QC = (bf16_t*)(ws + T_QC); bf16_t* KC = (bf16_t*)(ws + T_KC);
        const int r = tid & 31, which = r >> 4, cg = r & 15, tb = tid >> 5;
        const int ch = h * 128 + 8 * cg;
        float cw[4][8];
#pragma unroll
        for (int j = 0; j < 4; ++j) { const f32x4 c0 = *(const f32x4*)(conv_w_l + (size_t)j * 1024 + which * 512 + ch), c1 = *(const f32x4*)(conv_w_l + (size_t)j * 1024 + which * 512 + ch + 4);
            cw[j][0] = c0.x; cw[j][1] = c0.y; cw[j][2] = c0.z; cw[j][3] = c0.w; cw[j][4] = c1.x; cw[j][5] = c1.y; cw[j][6] = c1.z; cw[j][7] = c1.w; }
        const bf16_t* src = ZR + (which ? ZR_MK : ZR_MQ) + ch;
        u32x4 rw[11];
#pragma unroll
        for (int q = 0; q < 11; ++q) { const int tt = t0 + 8 * tb - 3 + q; rw[q] = (tt >= 0) ? *(const u32x4*)(src + (size_t)tt * ZRW) : (u32x4){0u, 0u, 0u, 0u}; }
        const float sc = which ? 0.08838834764831845f : 1.f;
#pragma unroll
        for (int q = 0; q < 8; ++q) {
            const int sl = 8 * tb + q;
            float acc[8];
#pragma unroll
            for (int e = 0; e < 8; ++e) acc[e] = 0.f;
#pragma unroll
            for (int j = 0; j < 4; ++j) { const u32x4 w = rw[q + j];
                acc[0] += bflo(w.x) * cw[j][0]; acc[1] += bfhi(w.x) * cw[j][1]; acc[2] += bflo(w.y) * cw[j][2]; acc[3] += bfhi(w.y) * cw[j][3];
                acc[4] += bflo(w.z) * cw[j][4]; acc[5] += bfhi(w.z) * cw[j][5]; acc[6] += bflo(w.w) * cw[j][6]; acc[7] += bfhi(w.w) * cw[j][7]; }
#pragma unroll
            for (int e = 0; e < 8; ++e) acc[e] = siluf(acc[e]) * sc;
            u32x4 o; o.x = pk2(acc[0], acc[1]); o.y = pk2(acc[2], acc[3]); o.z = pk2(acc[4], acc[5]); o.w = pk2(acc[6], acc[7]);
            *(u32x4*)((which ? KC : QC) + (size_t)(t0 + sl) * 512 + ch) = o;
            if (which) { const float w = sws[sl];
#pragma unroll
                for (int e = 0; e < 8; ++e) kT[(8 * cg + e) * KT_PITCH + sl] = (bf16_t)f2bf(acc[e] * w); }
        }
    }
    __syncthreads();
    {
        const int i = lane & 15, g = lane >> 4;
        const bf16_t* vT = (const bf16_t*)(ws + WS_ZT) + (size_t)(ZT_MV + h * 128 + 16 * wave + i) * ZTP + t0;
        f32x4 acc[8];
#pragma unroll
        for (int n = 0; n < 8; ++n) acc[n] = (f32x4){0.f, 0.f, 0.f, 0.f};
#pragma unroll
        for (int ks = 0; ks < 4; ++ks) {
            const bf16x8 a = *(const bf16x8*)(vT + 32 * ks + 8 * g);
#pragma unroll
            for (int n = 0; n < 8; ++n) { const bf16x8 b = *(const LAS bf16x8*)(kT + (16 * n + i) * KT_PITCH + 32 * ks + 8 * g); acc[n] = MFMA16(a, b, acc[n]); }
        }
        float* U = (float*)(ws + T_U) + ((size_t)(h * 128 + c) * 128) * 128;
#pragma unroll
        for (int n = 0; n < 8; ++n)
#pragma unroll
            for (int r = 0; r < 4; ++r) U[(size_t)(16 * wave + 4 * g + r) * 128 + 16 * n + i] = acc[n][r];
    }
    {
        const int i = lane & 15, g = lane >> 4;
        const bf16x8 ones = {(short)0x3f80, (short)0x3f80, (short)0x3f80, (short)0x3f80, (short)0x3f80, (short)0x3f80, (short)0x3f80, (short)0x3f80};
        f32x4 acc = {0.f, 0.f, 0.f, 0.f};
#pragma unroll
        for (int ks = 0; ks < 4; ++ks) { const bf16x8 b = *(const LAS bf16x8*)(kT + (16 * wave + i) * KT_PITCH + 32 * ks + 8 * g); acc = MFMA16(ones, b, acc); }
        if (g == 0) ((float*)(ws + SM_NLOC))[(size_t)(h * 128 + c) * 128 + 16 * wave + i] = acc[0];
    }
}

__device__ __forceinline__ void mlstm_scan(unsigned char* ws, LAS unsigned char* lds, int tid, int lane, int wave, int bid) {
    if (bid >= 256) return;
    const int h = bid >> 6;
    LAS float* dec = (LAS float*)lds; LAS float* scl = dec + 128;
    __syncthreads();
    if (wave == 0) {
        const float* sc = (const float*)(ws + SM_MLSC);
        const float bl0 = sc[h * 128 + lane], bl1 = sc[h * 128 + 64 + lane], ml0 = sc[512 + h * 128 + lane], ml1 = sc[512 + h * 128 + 64 + lane];
        float m = 0.f, mA = 0.f, mB = 0.f;
#pragma unroll 8
        for (int c = 0; c < 64; ++c) { if (lane == c) mA = m; m = fmaxf(__shfl(bl0, c) + m, __shfl(ml0, c)); }
#pragma unroll 8
        for (int c = 0; c < 64; ++c) { if (lane == c) mB = m; m = fmaxf(__shfl(bl1, c) + m, __shfl(ml1, c)); }
        const float mA1 = fmaxf(bl0 + mA, ml0), mB1 = fmaxf(bl1 + mB, ml1);
        dec[lane] = __expf(bl0 + mA - mA1); scl[lane] = __expf(ml0 - mA1); dec[64 + lane] = __expf(bl1 + mB - mB1); scl[64 + lane] = __expf(ml1 - mB1);
        if ((bid & 63) == 0) { float* mst = (float*)(ws + SM_MLSC) + 1024 + h * 128; mst[lane] = mA; mst[64 + lane] = mB; }
    }
    __syncthreads();
    if (tid < 256) {
        const int el = (bid & 63) * 256 + tid;
        const float* U = (const float*)(ws + T_U) + (size_t)h * 128 * 16384 + el;
        bf16_t* CS = (bf16_t*)(ws + T_CST) + (size_t)h * 128 * 16384 + el;
        float C = 0.f;
        for (int c0 = 0; c0 < 128; c0 += 32) { float u[32];
#pragma unroll
            for (int q = 0; q < 32; ++q) u[q] = U[(size_t)(c0 + q) * 16384];
#pragma unroll
            for (int q = 0; q < 32; ++q) { CS[(size_t)(c0 + q) * 16384] = (bf16_t)f2bf(C); C = dec[c0 + q] * C + scl[c0 + q] * u[q]; } }
    } else if (tid < 258) {
        const int el = (bid & 63) * 2 + (tid - 256);
        const float* NL_ = (const float*)(ws + SM_NLOC) + (size_t)h * 128 * 128 + el;
        float* NS = (float*)(ws + SM_NST) + (size_t)h * 128 * 128 + el;
        float n = 0.f;
        for (int c0 = 0; c0 < 128; c0 += 32) { float u[32];
#pragma unroll
            for (int q = 0; q < 32; ++q) u[q] = NL_[(c0 + q) * 128];
#pragma unroll
            for (int q = 0; q < 32; ++q) { NS[(c0 + q) * 128] = n; n = dec[c0 + q] * n + scl[c0 + q] * u[q]; } }
    }
}

constexpr int ML_PITCHB = 272, ML_MAT = 128 * ML_PITCHB;
__device__ __forceinline__ void mlstm_out_unit(int h, int c, unsigned char* ws, const float* g_mlstm, LAS unsigned char* lds, int tid, int lane, int wave) {
    const int i = lane & 15, g = lane >> 4;
    const int t0 = c * 128, tl = 16 * wave + i, t = t0 + tl;
    const bf16_t* QC = (const bf16_t*)(ws + T_QC); const bf16_t* KC = (const bf16_t*)(ws + T_KC);
    const bf16_t* ZT = (const bf16_t*)(ws + WS_ZT); const bf16_t* ZR = (const bf16_t*)(ws + WS_ZR);
    LAS unsigned char* Cs = lds; LAS unsigned char* Ks = lds + ML_MAT; LAS unsigned char* Vs = lds + 2 * ML_MAT;
    __syncthreads();
    {
        const bf16_t* CS = (const bf16_t*)(ws + T_CST) + ((size_t)(h * 128 + c) * 128) * 128;
        const bf16_t* kc = KC + (size_t)t0 * 512 + h * 128;
        const bf16_t* vt = ZT + (size_t)(ZT_MV + h * 128) * ZTP + t0;
#pragma unroll
        for (int q = 0; q < 4; ++q) { const int cc = tid + 512 * q; const int row = cc >> 4, part = cc & 15;
            const u32x4 a = *(const u32x4*)(CS + (size_t)row * 128 + part * 8);
            const u32x4 b = *(const u32x4*)(kc + (size_t)row * 512 + part * 8);
            const u32x4 d = *(const u32x4*)(vt + (size_t)row * ZTP + part * 8);
            *(LAS u32x4*)(Cs + row * ML_PITCHB + part * 16) = a; *(LAS u32x4*)(Ks + row * ML_PITCHB + part * 16) = b; *(LAS u32x4*)(Vs + row * ML_PITCHB + part * 16) = d; }
    }
    const float* ma = (const float*)(ws + SM_MA) + (size_t)h * S + t0;
    const float mc = ((const float*)(ws + SM_MLSC))[1024 + h * 128 + c];
    const float bt = ((const float*)(ws + SM_MB))[(size_t)h * S + t];
    const float Mx = fmaxf(mc, ((const float*)(ws + SM_MPX))[(size_t)h * S + t]);
    const float w_inter = __expf(mc - Mx);
    bf16x8 Qf[4];
#pragma unroll
    for (int ks = 0; ks < 4; ++ks) Qf[ks] = *(const bf16x8*)(QC + (size_t)t * 512 + h * 128 + 32 * ks + 8 * g);
    float qn = 0.f;
    {
        const float* ns = (const float*)(ws + SM_NST) + (size_t)(h * 128 + c) * 128;
#pragma unroll
        for (int ks = 0; ks < 4; ++ks) { const f32x4 n0 = *(const f32x4*)(ns + 32 * ks + 8 * g), n1 = *(const f32x4*)(ns + 32 * ks + 8 * g + 4);
            qn += bf2f((unsigned short)Qf[ks][0]) * n0.x + bf2f((unsigned short)Qf[ks][1]) * n0.y + bf2f((unsigned short)Qf[ks][2]) * n0.z + bf2f((unsigned short)Qf[ks][3]) * n0.w
                + bf2f((unsigned short)Qf[ks][4]) * n1.x + bf2f((unsigned short)Qf[ks][5]) * n1.y + bf2f((unsigned short)Qf[ks][6]) * n1.z + bf2f((unsigned short)Qf[ks][7]) * n1.w; }
        qn = grp_sum(qn);
    }
    u32x2 mow[8];
    {
        const bf16_t* mo = ZR + (size_t)t * ZRW + ZR_MO + h * 128;
#pragma unroll
        for (int dt = 0; dt < 8; ++dt) mow[dt] = *(const u32x2*)(mo + 16 * dt + 4 * g);
    }
    __syncthreads();
    f32x4 On[8];
#pragma unroll
    for (int dt = 0; dt < 8; ++dt) On[dt] = (f32x4){0.f, 0.f, 0.f, 0.f};
#pragma unroll
    for (int ks = 0; ks < 4; ++ks)
#pragma unroll
        for (int dt = 0; dt < 8; ++dt) { const bf16x8 a = *(const LAS bf16x8*)(Cs + (16 * dt + i) * ML_PITCHB + (32 * ks + 8 * g) * 2); On[dt] = MFMA16(a, Qf[ks], On[dt]); }
#pragma unroll
    for (int dt = 0; dt < 8; ++dt) On[dt] = On[dt] * w_inter;
    float den = 0.f;
    for (int sp = 0; sp <= (wave >> 1); ++sp) {
        f32x4 s0 = {0.f, 0.f, 0.f, 0.f}, s1 = {0.f, 0.f, 0.f, 0.f};
        const LAS unsigned char* k0p = Ks + (32 * sp + i) * ML_PITCHB + 16 * g;
        const LAS unsigned char* k1p = k0p + 16 * ML_PITCHB;
#pragma unroll
        for (int ks = 0; ks < 4; ++ks) { s0 = MFMA16(*(const LAS bf16x8*)(k0p + 64 * ks), Qf[ks], s0); s1 = MFMA16(*(const LAS bf16x8*)(k1p + 64 * ks), Qf[ks], s1); }
        const f32x4 a0 = *(const f32x4*)(ma + 32 * sp + 4 * g), a1 = *(const f32x4*)(ma + 32 * sp + 16 + 4 * g);
        float p0[4], p1[4];
#pragma unroll
        for (int r = 0; r < 4; ++r) {
            const int sl0 = 32 * sp + 4 * g + r, sl1 = sl0 + 16;
            p0[r] = (sl0 <= tl) ? s0[r] * __expf(a0[r] - Mx) : 0.f;
            p1[r] = (sl1 <= tl) ? s1[r] * __expf(a1[r] - Mx) : 0.f;
            den += p0[r] + p1[r];
        }
        u32x4 pw; pw.x = pk2(p0[0], p0[1]); pw.y = pk2(p0[2], p0[3]); pw.z = pk2(p1[0], p1[1]); pw.w = pk2(p1[2], p1[3]);
        const bf16x8 pb = __builtin_bit_cast(bf16x8, pw);
#pragma unroll
        for (int dt = 0; dt < 8; ++dt) { const LAS unsigned char* vp = Vs + (16 * dt + i) * ML_PITCHB + (32 * sp + 4 * g) * 2;
            u32x4 vw; const u32x2 lo = *(const LAS u32x2*)vp, hi = *(const LAS u32x2*)(vp + 32); vw.x = lo.x; vw.y = lo.y; vw.z = hi.x; vw.w = hi.y;
            On[dt] = MFMA16(__builtin_bit_cast(bf16x8, vw), pb, On[dt]); }
    }
    den = grp_sum(den) + w_inter * qn;
    const float dn = fmaxf(fabsf(den), __expf(-(bt + Mx)));
    const float inv = 1.f / dn;
    float ss = 0.f;
#pragma unroll
    for (int dt = 0; dt < 8; ++dt) { const u32x2 w = mow[dt];
        const f32x4 og = {sigmoidf(bflo(w.x)), sigmoidf(bfhi(w.x)), sigmoidf(bflo(w.y)), sigmoidf(bfhi(w.y))};
        On[dt] = On[dt] * inv * og;
        ss += (On[dt].x * On[dt].x + On[dt].y * On[dt].y) + (On[dt].z * On[dt].z + On[dt].w * On[dt].w); }
    ss = grp_sum(ss);
    const float rs = rsqrtf(ss * (1.f / 128.f) + EPS);
    bf16_t* yrow = (bf16_t*)(ws + WS_Y) + (size_t)t * DM + 256 + h * 128;
#pragma unroll
    for (int dt = 0; dt < 8; ++dt) { const f32x4 gg = *(const f32x4*)(g_mlstm + h * 128 + 16 * dt + 4 * g); const f32x4 o = On[dt] * rs * gg;
        u32x2 w; w.x = pk2(o.x, o.y); w.y = pk2(o.z, o.w); *(u32x2*)(yrow + 16 * dt + 4 * g) = w; }
}
struct SchedDenseIn {
    const char* X; const char* W; int G, c;
    __device__ __forceinline__ bool next(int i, pg8::GUnit& u) const {
        constexpr int nM = 64, nN = 14, nwg = nM * nN;
        const long L = (long)i * G + c; if (L >= nwg) return false;
        int wgid = (int)L; { const int q = nwg / pg8::NXCD, r = nwg % pg8::NXCD, xcd = wgid % pg8::NXCD, off = wgid / pg8::NXCD; wgid = (xcd < r ? xcd * (q + 1) : r * (q + 1) + (xcd - r) * q) + off; }
        const int nig = pg8::WGM * nN, gid = wgid / nig, fm = gid * pg8::WGM, gsz = (nM - fm) < pg8::WGM ? (nM - fm) : pg8::WGM;
        const int pm = fm + ((wgid % nig) % gsz), pn = (wgid % nig) / gsz;
        u.pm = pm; u.pn = pn; u.x0 = 0;
        if (pn < 10) { u.A = X + (size_t)pm * 256 * DM * 2; u.B = W + (size_t)pn * 256 * DM * 2; }
        else { u.A = W + (size_t)pn * 256 * DM * 2; u.B = X + (size_t)pm * 256 * DM * 2; }
        return true;
    }
};
struct EpiZ {
    bf16_t* ZR; bf16_t* ZT;
    __device__ __forceinline__ void operator()(const f32x4 (&acc)[2][2][4][2], const pg8::GUnit& u, int wr, int wc, int fr, int fq) const {
        const bool sw = u.pn >= 10;
        bf16_t* base; size_t pitch;
        if (!sw) { base = ZR + (size_t)(256 * u.pm) * ZRW + 256 * u.pn; pitch = ZRW; }
        else { base = ZT + (size_t)(256 * (u.pn - 10)) * ZTP + 256 * u.pm; pitch = ZTP; }
#pragma unroll
        for (int ai = 0; ai < 2; ++ai)
#pragma unroll
            for (int m = 0; m < 4; ++m) { bf16_t* rowp = base + (size_t)(ai * 128 + wr * 64 + m * 16 + fr) * pitch + wc * 32 + 8 * fq;
#pragma unroll
                for (int bj = 0; bj < 2; ++bj) { const f32x4 v0 = acc[ai][bj][m][0], v1 = acc[ai][bj][m][1];
                    u32x4 w; w.x = pk2(v0[0], v0[1]); w.y = pk2(v0[2], v0[3]); w.z = pk2(v1[0], v1[1]); w.w = pk2(v1[2], v1[3]);
                    *(u32x4*)(rowp + bj * 128) = w; } }
    }
};
struct SchedDense4 {
    const char* X; const char* W; int K; int G, c;
    __device__ __forceinline__ bool next(int i, pg8::GUnit& u) const {
        const int L = i * G + c; if (L >= 256) return false;
        const int pm = L >> 2, pn = L & 3;
        u.pm = pm; u.pn = pn; u.x0 = 0;
        u.A = X + (size_t)pm * 256 * K * 2; u.B = W + (size_t)pn * 256 * K * 2;
        return true;
    }
};
template <bool XBF16> struct EpiPre1 {
    const void* xin; bf16_t* out;
    __device__ __forceinline__ void operator()(const f32x4 (&acc)[2][2][4][2], const pg8::GUnit& u, int wr, int wc, int fr, int fq) const {
#pragma unroll
        for (int ai = 0; ai < 2; ++ai)
#pragma unroll
            for (int m = 0; m < 4; ++m) { const size_t off = (size_t)(256 * u.pm + ai * 128 + wr * 64 + m * 16 + fr) * DM + 256 * u.pn + wc * 32 + 8 * fq;
#pragma unroll
                for (int bj = 0; bj < 2; ++bj) {
                    f32x4 x0, x1;
                    if (XBF16) { const u32x4 xw = *(const u32x4*)((const bf16_t*)xin + off + bj * 128); x0 = (f32x4){bflo(xw.x), bfhi(xw.x), bflo(xw.y), bfhi(xw.y)}; x1 = (f32x4){bflo(xw.z), bfhi(xw.z), bflo(xw.w), bfhi(xw.w)}; }
                    else { x0 = *(const f32x4*)((const float*)xin + off + bj * 128); x1 = *(const f32x4*)((const float*)xin + off + bj * 128 + 4); }
                    const f32x4 v0 = x0 * ALPHA + acc[ai][bj][m][0], v1 = x1 * ALPHA + acc[ai][bj][m][1];
                    u32x4 w; w.x = pk2(v0[0], v0[1]); w.y = pk2(v0[2], v0[3]); w.z = pk2(v1[0], v1[1]); w.w = pk2(v1[2], v1[3]);
                    *(u32x4*)(out + off + bj * 128) = w; } }
    }
};
__device__ __forceinline__ void moe_table(const unsigned* ecnt, LAS int* tab, int tid) {
    __syncthreads();
    if (tid < 64) {
        const int e = tid; const unsigned cnt_e = e < NE ? xb_ld((unsigned*)ecnt + e) : 0u; const int n = (int)((cnt_e + 255u) >> 8);
        if (e < NE) tab[216 + e] = (int)cnt_e;
        int inc = n;
#pragma unroll
        for (int o = 1; o < 32; o <<= 1) { const int v = __shfl_up(inc, o); if (e >= o) inc += v; }
        const int exc = inc - n;
        if (e < NE) { tab[1 + e] = exc; for (int j = 0; j < n; ++j) tab[40 + exc + j] = e; }
        if (e == NE - 1) { tab[1 + NE] = inc; tab[0] = inc; }
    }
    __syncthreads();
}
struct SchedMoE {
    const char* Abase; const char* Wbase; const LAS int* tab; size_t wstride; int K; int G, c; int maxr; const int* elist; unsigned* guc; unsigned* tmo;
    __device__ __forceinline__ int unit_of(int i, int U) const {
        if (elist) return i * G + c;
        const int r = U % G; if (r == 0) return i * G + c;
        const int nl = G - r;
        if (c >= r) return i < 2 ? i * nl + (c - r) : 2 * nl + (i - 2) * G + c;
        return 2 * nl + i * G + c;
    }
    __device__ __forceinline__ void a_ready(const pg8::GUnit& u, int wid, int lane) const {
        if (wid == 0) {
            unsigned polls = 0;
            while ((unsigned)__builtin_amdgcn_readfirstlane(__hip_atomic_load(guc + 16 * u.pm, __ATOMIC_RELAXED, __HIP_MEMORY_SCOPE_AGENT)) < 32u) {
                if ((++polls & 255u) == 0u) { if (__builtin_amdgcn_readfirstlane(__hip_atomic_load(tmo, __ATOMIC_RELAXED, __HIP_MEMORY_SCOPE_AGENT)) != 0u) break;
                    if (polls > (1u << 22)) { if (lane == 0) atomicAdd(tmo, 1u); break; } }
                __builtin_amdgcn_s_sleep(2); }
            asm volatile("s_waitcnt vmcnt(0)" ::: "memory");
        }
        asm volatile("" ::: "memory"); __builtin_amdgcn_s_barrier(); asm volatile("" ::: "memory");
    }
    __device__ __forceinline__ bool next(int i, pg8::GUnit& u) const {
        if (i >= maxr) return false;
        const int T = __builtin_amdgcn_readfirstlane(tab[0]); const int L = unit_of(i, 4 * T); if (L >= 4 * T) return false;
        const int tile = L >> 2, pn = L & 3; const int e = __builtin_amdgcn_readfirstlane(tab[40 + tile]);
        u.pm = tile; u.pn = pn; u.x0 = e;
        u.B = Wbase + (size_t)e * wstride + (size_t)pn * 256 * K * 2;
        if (elist) { u.A = Abase; u.list = elist + (size_t)e * S; u.l0 = 256 * (tile - __builtin_amdgcn_readfirstlane(tab[1 + e])); u.nl = __builtin_amdgcn_readfirstlane(tab[216 + e]); }
        else { u.A = Abase + (size_t)tile * 256 * K * 2; u.list = nullptr; u.l0 = 0; u.nl = 0; }
        return true;
    }
};
struct EpiGU {
    bf16_t* H; unsigned* guc;
    __device__ __forceinline__ void operator()(const f32x4 (&acc)[2][2][4][2], const pg8::GUnit& u, int wr, int wc, int fr, int fq) const {
#pragma unroll
        for (int ai = 0; ai < 2; ++ai)
#pragma unroll
            for (int m = 0; m < 4; ++m) { bf16_t* rowp = H + (size_t)(256 * u.pm + ai * 128 + wr * 64 + m * 16 + fr) * DE + (256 * u.pn + wc * 32 + 8 * fq) / 2;
#pragma unroll
                for (int bj = 0; bj < 2; ++bj) { const f32x4 gt = acc[ai][bj][m][0], up = acc[ai][bj][m][1];
                    const unsigned long long w = (unsigned long long)pk2(siluf(gt[0]) * up[0], siluf(gt[1]) * up[1]) | ((unsigned long long)pk2(siluf(gt[2]) * up[2], siluf(gt[3]) * up[3]) << 32);
                    __hip_atomic_store((unsigned long long*)(rowp + bj * 64), w, __ATOMIC_RELAXED, __HIP_MEMORY_SCOPE_AGENT); } }
        asm volatile("s_waitcnt vmcnt(0)" ::: "memory");
        if (fr == 0 && fq == 0) (void)__hip_atomic_fetch_add(guc + 16 * u.pm, 1u, __ATOMIC_RELAXED, __HIP_MEMORY_SCOPE_AGENT);
    }
};
struct EpiY {
    bf16_t* Y;
    __device__ __forceinline__ void operator()(const f32x4 (&acc)[2][2][4][2], const pg8::GUnit& u, int wr, int wc, int fr, int fq) const {
#pragma unroll
        for (int ai = 0; ai < 2; ++ai)
#pragma unroll
            for (int m = 0; m < 4; ++m) { bf16_t* rowp = Y + (size_t)(256 * u.pm + ai * 128 + wr * 64 + m * 16 + fr) * DM + 256 * u.pn + wc * 32 + 8 * fq;
#pragma unroll
                for (int bj = 0; bj < 2; ++bj) { const f32x4 v0 = acc[ai][bj][m][0], v1 = acc[ai][bj][m][1];
                    u32x4 w; w.x = pk2(v0[0], v0[1]); w.y = pk2(v0[2], v0[3]); w.z = pk2(v1[0], v1[1]); w.w = pk2(v1[2], v1[3]);
                    *(u32x4*)(rowp + bj * 128) = w; } }
    }
};

constexpr int R6_WG = 0, R6_WE = 16384, R6_G = 16384 + 131072, R6_B = R6_G + 4096, R6_END = R6_B + 4096;
static_assert(R6_END <= LDS_TAB, "router weights fit under the table region");
__device__ __forceinline__ void ln1_router_load(const float* g1, const float* b1, const float* w_grp, const float* w_er, LAS unsigned char* lds, int tid) {
    LAS float* wgT = (LAS float*)(lds + R6_WG); LAS float* weT = (LAS float*)(lds + R6_WE); LAS float* gg = (LAS float*)(lds + R6_G); LAS float* bb = (LAS float*)(lds + R6_B);
    for (int i = tid; i < 1024; i += 512) { const f32x4 w = *(const f32x4*)(w_grp + 4 * i); wgT[i] = w.x; wgT[1024 + i] = w.y; wgT[2048 + i] = w.z; wgT[3072 + i] = w.w; gg[i] = g1[i]; bb[i] = b1[i]; }
    for (int i = tid; i < 1024 * 8; i += 512) { const int k = i >> 3, c4 = (i & 7) * 4; const f32x4 w = *(const f32x4*)(w_er + (size_t)k * 32 + c4);
        weT[(c4 + 0) * 1024 + k] = w.x; weT[(c4 + 1) * 1024 + k] = w.y; weT[(c4 + 2) * 1024 + k] = w.z; weT[(c4 + 3) * 1024 + k] = w.w; }
}
__device__ __forceinline__ void ln1_router_row(int t, unsigned char* ws, const LAS unsigned char* lds, const float* b_grp, const float* b_er, unsigned* ecnt, int lane) {
    const LAS float* wgT = (const LAS float*)(lds + R6_WG); const LAS float* weT = (const LAS float*)(lds + R6_WE); const LAS float* gg = (const LAS float*)(lds + R6_G); const LAS float* bb = (const LAS float*)(lds + R6_B);
    const bf16_t* p1 = (const bf16_t*)(ws + WS_ZT) + (size_t)t * DM;
    f32x4 v[4];
#pragma unroll
    for (int j = 0; j < 4; ++j) { const u32x2 w = *(const u32x2*)(p1 + 256 * j + 4 * lane); v[j] = (f32x4){bflo(w.x), bfhi(w.x), bflo(w.y), bfhi(w.y)}; }
    {
        float s = 0.f;
#pragma unroll
        for (int j = 0; j < 4; ++j) s += (v[j].x + v[j].y) + (v[j].z + v[j].w);
        const float mean = wave_sum(s) * (1.f / DM); float s2 = 0.f;
#pragma unroll
        for (int j = 0; j < 4; ++j) { v[j] = v[j] - mean; s2 += (v[j].x * v[j].x + v[j].y * v[j].y) + (v[j].z * v[j].z + v[j].w * v[j].w); }
        const float rstd = rsqrtf(wave_sum(s2) * (1.f / DM) + EPS);
#pragma unroll
        for (int j = 0; j < 4; ++j) { const f32x4 g = *(const LAS f32x4*)(gg + 256 * j + 4 * lane), b = *(const LAS f32x4*)(bb + 256 * j + 4 * lane); v[j] = v[j] * rstd * g + b; }
    }
    store_row_bf16(v, (bf16_t*)(ws + WS_ACTB) + (size_t)t * DM, lane);
    float gl[4];
#pragma unroll
    for (int q = 0; q < 4; ++q) { float s = 0.f;
#pragma unroll
        for (int j = 0; j < 4; ++j) { const f32x4 w = *(const LAS f32x4*)(wgT + q * 1024 + 256 * j + 4 * lane); s += (v[j].x * w.x + v[j].y * w.y) + (v[j].z * w.z + v[j].w * w.w); }
        gl[q] = wave_sum(s) + b_grp[q]; }
    int gs = 0; float gm = gl[0];
#pragma unroll
    for (int q = 1; q < 4; ++q) if (gl[q] > gm) { gm = gl[q]; gs = q; }
    float den = 0.f;
#pragma unroll
    for (int q = 0; q < 4; ++q) den += __expf(gl[q] - gm);
    const float pg = 1.f / den;
    float el[8];
#pragma unroll
    for (int q = 0; q < 8; ++q) { float s = 0.f; const LAS float* wc = weT + (gs * 8 + q) * 1024;
#pragma unroll
        for (int j = 0; j < 4; ++j) { const f32x4 w = *(const LAS f32x4*)(wc + 256 * j + 4 * lane); s += (v[j].x * w.x + v[j].y * w.y) + (v[j].z * w.z + v[j].w * w.w); }
        el[q] = wave_sum(s) + b_er[gs * 8 + q]; }
    int i0 = 0; float v0 = el[0];
#pragma unroll
    for (int q = 1; q < 8; ++q) if (el[q] > v0) { v0 = el[q]; i0 = q; }
    int i1 = -1; float v1 = -INFINITY;
#pragma unroll
    for (int q = 0; q < 8; ++q) if (q != i0 && el[q] > v1) { v1 = el[q]; i1 = q; }
    const float e1 = __expf(v1 - v0); const float w0g = pg / (1.f + e1), w1g = pg * e1 / (1.f + e1);
    if (lane < 2) {
        const int e = gs * 8 + (lane == 0 ? i0 : i1);
        const unsigned slot = atomicAdd(ecnt + e, 1u);
        ((int*)(ws + SM_ELIST))[(size_t)e * S + slot] = t;
        ((int*)(ws + SM_EID))[2 * t + lane] = e; ((int*)(ws + SM_SLOT))[2 * t + lane] = (int)slot; ((float*)(ws + SM_WT))[2 * t + lane] = lane == 0 ? w0g : w1g;
    }
}
__device__ __forceinline__ void ln2_row(int t, unsigned char* ws, const LAS int* tab, const LAS float* g2, const LAS float* b2, float* out, bool last,
                                        const LAS float* w12, const float* bff, const float* bmi, const float* bmf, int lane) {
    const bf16_t* x1 = (const bf16_t*)(ws + WS_ACTB) + (size_t)t * DM;
    const int e0 = ((const int*)(ws + SM_EID))[2 * t], e1 = ((const int*)(ws + SM_EID))[2 * t + 1];
    const int s0 = ((const int*)(ws + SM_SLOT))[2 * t], s1 = ((const int*)(ws + SM_SLOT))[2 * t + 1];
    const float w0 = ((const float*)(ws + SM_WT))[2 * t], w1 = ((const float*)(ws + SM_WT))[2 * t + 1];
    const bf16_t* y0 = (const bf16_t*)(ws + T_YE) + (size_t)(256 * tab[1 + e0] + s0) * DM; const bf16_t* y1 = (const bf16_t*)(ws + T_YE) + (size_t)(256 * tab[1 + e1] + s1) * DM;
    f32x4 v[4];
#pragma unroll
    for (int j = 0; j < 4; ++j) { const u32x2 xw = *(const u32x2*)(x1 + 256 * j + 4 * lane);
        const f32x4 x = {bflo(xw.x), bfhi(xw.x), bflo(xw.y), bfhi(xw.y)};
        const u32x2 a = *(const u32x2*)(y0 + 256 * j + 4 * lane), b = *(const u32x2*)(y1 + 256 * j + 4 * lane);
        const f32x4 ya = {bflo(a.x), bfhi(a.x), bflo(a.y), bfhi(a.y)}, yb = {bflo(b.x), bfhi(b.x), bflo(b.y), bfhi(b.y)};
        v[j] = x * ALPHA + ya * w0 + yb * w1; }
    {
        float s = 0.f;
#pragma unroll
        for (int j = 0; j < 4; ++j) s += (v[j].x + v[j].y) + (v[j].z + v[j].w);
        const float mean = wave_sum(s) * (1.f / DM); float s2 = 0.f;
#pragma unroll
        for (int j = 0; j < 4; ++j) { v[j] = v[j] - mean; s2 += (v[j].x * v[j].x + v[j].y * v[j].y) + (v[j].z * v[j].z + v[j].w * v[j].w); }
        const float rstd = rsqrtf(wave_sum(s2) * (1.f / DM) + EPS);
#pragma unroll
        for (int j = 0; j < 4; ++j) { const f32x4 g = *(const LAS f32x4*)(g2 + 256 * j + 4 * lane), b = *(const LAS f32x4*)(b2 + 256 * j + 4 * lane); v[j] = v[j] * rstd * g + b; }
    }
    if (last) {
#pragma unroll
        for (int j = 0; j < 4; ++j) *(f32x4*)(out + (size_t)t * DM + 256 * j + 4 * lane) = v[j];
    } else {
        store_row_bf16(v, (bf16_t*)(ws + WS_ACTB) + (size_t)t * DM, lane);
        gates_row(v, w12, bff, bmi, bmf, (float*)(ws + SM_FLF), (float*)(ws + SM_MLI), (float*)(ws + SM_MLF), t, lane);
    }
}

__device__ __forceinline__ const void* ldarg(int k) { int kk = k; asm volatile("" : "+s"(kk)); return ((const void* const*)__builtin_amdgcn_kernarg_segment_ptr())[kk]; }
#ifndef PH_MASK
#define PH_MASK 0x7ff
#endif
#define PHM(k) (((PH_MASK) >> (k)) & 1)
#define IN(k) (lo <= (k) && (k) < hi)
#define SEAM(k) do { if (IN(k) && IN((k) + 1)) { XcdBarrier _b; _b.bar = (unsigned*)ldarg(23) + CW_BAR; _b.x = xb_xcc_id(); _b.st = (volatile LAS unsigned*)(lds + LDS_MISC); xcd_barrier(_b, wave0 == 0 && __builtin_amdgcn_mbcnt_hi(~0u, __builtin_amdgcn_mbcnt_lo(~0u, 0u)) == 0u); } } while (0)
#define PHASE_IDS unsigned char* ws = (unsigned char*)ldarg(23); unsigned* ctl = (unsigned*)ws; float* outp = (float*)ldarg(22); (void)ctl; (void)outp; int tid = wave0 * 64 + (int)__builtin_amdgcn_mbcnt_hi(~0u, __builtin_amdgcn_mbcnt_lo(~0u, 0u)); asm volatile("" : "+v"(tid)); const int lane = tid & 63, wave = __builtin_amdgcn_readfirstlane(tid >> 6); const int gw = bid * 8 + wave, NGW = G * 8; (void)lane; (void)gw; (void)NGW;
#define INP(k) ((const float*)ldarg(k))
template <int l>
__device__ __forceinline__ void layer_phases(LAS unsigned char* lds, const int wave0, const int bid, const int G, const int lo, const int hi, const int sub) {
    constexpr int P = 1 + 10 * l;

        if (PHM(0) && IN(P + 0)) { PHASE_IDS;
            SchedDenseIn Sd{(const char*)(ws + WS_ACTB), (const char*)(ws + WS_WIN) + (size_t)l * NZ * DM * 2, G, bid};
            EpiZ E{(bf16_t*)(ws + WS_ZR), (bf16_t*)(ws + WS_ZT)};
            pg8::gemm_phase<EpiZ, SchedDenseIn>(lds, DM, Sd, E, tid);
            if (G == 256 && bid >= 128)
                moe_weights(INP(17) + (size_t)l * NE * DM * DE, INP(18) + (size_t)l * NE * DM * DE, INP(19) + (size_t)l * NE * DE * DM, ws, lds, lane, wave, (bid - 128) * 8 + wave, 128 * 8, 0, MOE_FILL);
        }
        SEAM(P + 0);
        if (PHM(1) && IN(P + 1)) { PHASE_IDS;
            if (sub & 1) for (int u = bid; u < 256; u += G) mix1_unit(u, ws, ctl + CW_KMAX(l), lds, tid, lane, wave);
            if (sub & 2) { const bool split = (G == 256);
                moe_weights(INP(17) + (size_t)l * NE * DM * DE, INP(18) + (size_t)l * NE * DM * DE, INP(19) + (size_t)l * NE * DE * DM, ws, lds, lane, wave, gw, NGW, split ? MOE_FILL : 0, MOE_ITEMS); }
        }
        SEAM(P + 1);
        if (PHM(2) && IN(P + 2)) { PHASE_IDS;
            for (int u = bid; u < 1536; u += G) {
                const int ty = u >> 9, r = u & 511, h = r >> 7, q = r & 127;
                if (!((sub >> ty) & 1)) continue;
                if (ty == 0) { const float kmaxn = sqrtf(__builtin_bit_cast(float, xb_ld(ctl + CW_KMAX(l) + h))); fox_unit(h, q, ws, kmaxn, INP(7) + l * 256, lds, tid, lane, wave, (sub & 256) ? 1 : ((sub & 512) ? 3 : (1 << 30)), (sub & 768) ? (bf16_t*)(ws + WS_X1) : nullptr); }
                else if (ty == 1) mlstm_local_unit(h, q, ws, INP(6) + (size_t)l * 4 * 1024, lds, tid, lane, wave);
                else moba_gate_unit(h, q, ws, lds, tid, lane, wave);
            }
        }
        SEAM(P + 2);
        if (PHM(3) && IN(P + 3)) { PHASE_IDS;
            if (sub & 1) for (int vb = bid; vb < 256; vb += G) mlstm_scan(ws, lds, tid, lane, wave, vb);
            LAS unsigned char* ltab = lds + LDS_TAB;
            LAS int* tot = (LAS int*)ltab;
            LAS int* pre = (LAS int*)(ltab + 1024);
            __syncthreads();
            if (tid < 256) { const int* cq = (const int*)(ws + SM_CNTQ) + (size_t)tid * 128; int a = 0;
                for (int i = 0; i < 128; i += 4) { const u32x4 v = *(const u32x4*)(cq + i); a += (int)(v.x + v.y + v.z + v.w); }
                tot[tid] = a; pre[tid] = (a + 255) >> 8; }
            __syncthreads();
            if (tid < 64) {
                const int c0 = pre[4 * tid], c1 = pre[4 * tid + 1], c2 = pre[4 * tid + 2], c3 = pre[4 * tid + 3]; const int tsum = c0 + c1 + c2 + c3; int inc = tsum;
#pragma unroll
                for (int o = 1; o < 64; o <<= 1) { const int v = __shfl_up(inc, o); if (tid >= o) inc += v; }
                const int exc = inc - tsum;
                pre[4 * tid] = exc; pre[4 * tid + 1] = exc + c0; pre[4 * tid + 2] = exc + c0 + c1; pre[4 * tid + 3] = exc + c0 + c1 + c2;
                if (tid == 63) pre[256] = inc;
            }
            __syncthreads();
            const int total = (sub & 2) ? pre[256] : 0;
            for (int u = bid; u < total; u += G) {
                int loi = 0, hii = 255;
                while (loi < hii) { const int mid = (loi + hii + 1) >> 1; if (pre[mid] <= u) loi = mid; else hii = mid - 1; }
                moba_part_unit(loi >> 6, loi & 63, u - pre[loi], tot[loi], ws, lds, ltab, tid, lane, wave, (sub >> 10) & 3);
            }
        }
        SEAM(P + 3);
        if (PHM(4) && IN(P + 4)) { PHASE_IDS;
            for (int u = bid; u < 768; u += G) {
                if (u < 512) { if (sub & 1) mlstm_out_unit(u >> 7, u & 127, ws, INP(8) + l * 512, lds, tid, lane, wave); }
                else if (sub & 2) { const int r = u - 512; moba_own_unit(r >> 6, r & 63, ws, INP(9) + l * 256, lds, tid, lane, wave); }
            }
        }
        SEAM(P + 4);
        if (PHM(5) && IN(P + 5)) { PHASE_IDS;
            SchedDense4 Sd{(const char*)(ws + WS_Y), (const char*)(ws + WS_WOUT) + (size_t)l * DM * DM * 2, DM, G, (G % 8 == 0) ? (bid % 8) * (G / 8) + bid / 8 : bid};
            EpiPre1<(l > 0)> E{l == 0 ? (const void*)INP(0) : (const void*)(ws + WS_ACTB), (bf16_t*)(ws + WS_ZT)};
            pg8::gemm_phase<EpiPre1<(l > 0)>, SchedDense4>(lds, DM, Sd, E, tid);
        }
        SEAM(P + 5);
        if (PHM(6) && IN(P + 6)) { PHASE_IDS;
            ln1_router_load(INP(11) + l * DM, INP(12) + l * DM, INP(13) + (size_t)l * DM * 4, INP(15) + (size_t)l * DM * 32, lds, tid);
            __syncthreads();
            const float* bgp = INP(14) + l * 4; const float* bep = INP(16) + l * 32;
#pragma unroll 4
            for (int t = gw; t < S; t += NGW)
                ln1_router_row(t, ws, lds, bgp, bep, ctl + CW_ECNT(l), lane);
            __syncthreads();
        }
        SEAM(P + 6);
        if (PHM(7) && IN(P + 7)) { PHASE_IDS;
            LAS int* tab = (LAS int*)(lds + LDS_TAB);
            moe_table(ctl + CW_ECNT(l), tab, tid);
            SchedMoE Sm{(const char*)(ws + WS_ACTB), (const char*)(ws + WS_WGU), tab, (size_t)DM * DM * 2, DM, G, (G % 8 == 0) ? (bid % 8) * (G / 8) + bid / 8 : bid, (sub & 16) ? 1 : ((sub & 32) ? 2 : 1000), (const int*)(ws + SM_ELIST), nullptr, nullptr};
            EpiGU E{(bf16_t*)(ws + T_H), ctl + CW_GUC(l)};
            pg8::gemm_phase<EpiGU, SchedMoE, true>(lds, DM, Sm, E, tid, (LAS unsigned*)(lds + LDS_TAB + 1024));
        }
        if (PHM(8) && IN(P + 8)) { PHASE_IDS;
            LAS int* tab = (LAS int*)(lds + LDS_TAB);
            moe_table(ctl + CW_ECNT(l), tab, tid);
            SchedMoE Sm{(const char*)(ws + T_H), (const char*)(ws + WS_WD), tab, (size_t)DM * DE * 2, DE, G, (G % 8 == 0) ? (bid % 8) * (G / 8) + bid / 8 : bid, (sub & 16) ? 1 : ((sub & 32) ? 2 : 1000), nullptr, ctl + CW_GUC(l), ctl + CW_BAR + XB_TMO};
            EpiY E{(bf16_t*)(ws + T_YE)};
            pg8::gemm_phase<EpiY, SchedMoE, false, true>(lds, DE, Sm, E, tid);
        }
        SEAM(P + 8);
        if (PHM(9) && IN(P + 9)) { PHASE_IDS;
            LAS int* tab = (LAS int*)(lds + LDS_TAB);
            moe_table(ctl + CW_ECNT(l), tab, tid);
            const bool last = (l == NL - 1);
            LAS float* w12 = (LAS float*)lds;
            if (!last) { load_w12(INP(2) + (size_t)(l + 1) * DM * INW, w12, tid); __syncthreads(); }
            LAS float* g2l = (LAS float*)(lds + 49152); LAS float* b2l = g2l + 1024;
            { const float* g2p = INP(20) + l * DM; const float* b2p = INP(21) + l * DM; for (int i = tid; i < 1024; i += 512) { g2l[i] = g2p[i]; b2l[i] = b2p[i]; } }
            __syncthreads();
            const float* bffp = INP(3) + (l + 1) * 4; const float* bmip = INP(4) + (l + 1) * 4; const float* bmfp = INP(5) + (l + 1) * 4;
#pragma unroll 4
            for (int t = gw; t < S; t += NGW)
                ln2_row(t, ws, tab, g2l, b2l, outp, last, w12, bffp, bmip, bmfp, lane);
            __syncthreads();
        }
        SEAM(P + 9);
}
struct Args { const void* in[22]; float* out; unsigned char* ws; int ph_lo, ph_hi, sub, pad; };
__global__ void __launch_bounds__(512, 2) fwd(Args args) {
    extern __shared__ __attribute__((aligned(16))) unsigned char lds_raw[];
    LAS unsigned char* lds = (LAS unsigned char*)lds_raw;
    const int tid0 = threadIdx.x; const int wave0 = __builtin_amdgcn_readfirstlane(tid0 >> 6);
    const int bid = blockIdx.x, G = gridDim.x;
    if (tid0 < 4) ((LAS unsigned*)(lds + LDS_MISC))[tid0] = 0u;
    __syncthreads();
    const int lo = args.ph_lo, hi = args.ph_hi;
    if (hi - lo > 1 && lo != 99) (void)xcd_barrier_post((unsigned*)ldarg(23) + CW_BAR, (volatile LAS unsigned*)(lds + LDS_MISC));
    if (PHM(10) && IN(0)) { PHASE_IDS; p0_prologue(INP(0), (const int*)ldarg(1), INP(2), INP(10), INP(3), INP(4), INP(5), ws, lds, tid, lane, wave, bid, G); }
    SEAM(0);
    layer_phases<0>(lds, wave0, bid, G, lo, hi, args.sub);
    layer_phases<1>(lds, wave0, bid, G, lo, hi, args.sub);
#if defined(DBG_LISTSUM) || defined(DBG_DUMP_OFF)
    unsigned char* ws = args.ws; unsigned* ctl = (unsigned*)ws; (void)ctl;
#endif
#if 0
#elif defined(DBG_DUMP_OFF)
    if (lo == 99) {
        for (size_t i = (size_t)bid * 512 + tid0; i < (size_t)S * DM; i += (size_t)G * 512) {
#if DBG_DUMP_BF16
            args.out[i] = bf2f(((const bf16_t*)(ws + (DBG_DUMP_OFF)))[DBG_IDX(i)]);
#else
            args.out[i] = ((const float*)(ws + (DBG_DUMP_OFF)))[DBG_IDX(i)];
#endif
        }
    }
#endif
#undef IN
#undef SEAM
}

extern "C" void kernel_launch(void* const* d_in, const int* in_sizes, int n_in, void* d_out, int out_size, void* d_ws, size_t ws_size, hipStream_t stream) {
    static int grid = 0;
    if (grid == 0) {
        if (n_in != 22 || out_size != S * DM || ws_size < WS_END) { fprintf(stderr, "kernel_launch: unexpected shapes (n_in %d, out %d, ws %zu < %zu); nothing launched\n", n_in, out_size, ws_size, (size_t)WS_END); grid = -1; return; }
        int dev = 0, cus = 0;
        if (hipGetDevice(&dev) != hipSuccess || hipDeviceGetAttribute(&cus, hipDeviceAttributeMultiprocessorCount, dev) != hipSuccess) { grid = -1; return; }
        if (hipFuncSetAttribute((const void*)fwd, hipFuncAttributeMaxDynamicSharedMemorySize, LDS_BYTES) != hipSuccess) { fprintf(stderr, "kernel_launch: hipFuncSetAttribute failed\n"); grid = -1; return; }
        int per_cu = 0;
        (void)hipOccupancyMaxActiveBlocksPerMultiprocessor(&per_cu, (const void*)fwd, 512, LDS_BYTES);
        (void)hipGetLastError();
        if (per_cu < 1) fprintf(stderr, "kernel_launch: occupancy query reports %d blocks per CU\n", per_cu);
        grid = cus > 0 ? cus : 256;
    }
    if (grid < 0) return;
    (void)hipMemsetAsync((char*)d_ws + WS_CTL, 0, CTL_BYTES, stream);
    Args a{};
    for (int i = 0; i < 22; ++i) a.in[i] = d_in[i];
    a.out = (float*)d_out; a.ws = (unsigned char*)d_ws; a.sub = 7;
    if (N_LAUNCHES == 1) {
        a.ph_lo = 0; a.ph_hi = NPH;
        hipLaunchKernelGGL(fwd, dim3(grid), dim3(512), LDS_BYTES, stream, a);
    } else {
#if defined(DBG_DUMP_OFF) || defined(DBG_LISTSUM)
        for (int p = 0; p < DBG_NPH; ++p) { a.ph_lo = p; a.ph_hi = p + 1; hipLaunchKernelGGL(fwd, dim3(grid), dim3(512), LDS_BYTES, stream, a); }
        a.ph_lo = 99; a.ph_hi = 100; hipLaunchKernelGGL(fwd, dim3(grid), dim3(512), LDS_BYTES, stream, a);
#else
        for (int p = 0; p < NPH; ++p) { a.ph_lo = p; a.ph_hi = p + 1; hipLaunchKernelGGL(fwd, dim3(grid), dim3(512), LDS_BYTES, stream, a);
#ifdef DUP_MASK
            if (((unsigned long long)(DUP_MASK) >> p) & 1ull) { a.sub = DUP_SUB; hipLaunchKernelGGL(fwd, dim3(grid), dim3(512), LDS_BYTES, stream, a); a.sub = 7; }
#endif
        }
#endif
    }
}
```

```cpp
#include <hip/hip_runtime.h>
#include <cstdio>
#include <cstdint>

#define LAS __attribute__((address_space(3)))
#define GAS __attribute__((address_space(1)))
typedef unsigned short bf16_t;
typedef short bf16x8 __attribute__((ext_vector_type(8)));
typedef short bf16x4 __attribute__((ext_vector_type(4)));
typedef float f32x4 __attribute__((ext_vector_type(4)));
typedef float f32x2 __attribute__((ext_vector_type(2)));
typedef unsigned u32x4 __attribute__((ext_vector_type(4)));
typedef unsigned u32x2 __attribute__((ext_vector_type(2)));

#ifndef N_LAUNCHES
#define N_LAUNCHES 1
#endif

constexpr int S = 16384, DM = 1024, INW = 3596, NL = 2;
constexpr int NZ = 3584;
constexpr int ZRW = 2560;
constexpr int ZR_FQ = 0, ZR_FK = 256, ZR_MQ = 512, ZR_MK = 1024, ZR_MO = 1536, ZR_BQ = 2048, ZR_BK = 2304;
constexpr int ZT_FV = 0, ZT_MV = 256, ZT_BV = 768;
constexpr int ZTP = S + 136;
constexpr int NE = 32, DE = 512, MAXT = 160, PROWS = MAXT * 256;
constexpr float ALPHA = 1.41421356237309515f;
constexpr float EPS = 1e-5f;
constexpr int NPH = 21;

constexpr size_t MiB = 1u << 20;
constexpr size_t WS_CTL = 0, CTL_BYTES = 1 * MiB;
constexpr size_t WS_WIN = 1 * MiB;
constexpr size_t WS_ROPE = 16 * MiB;
constexpr size_t WS_WOUT = 17 * MiB;
constexpr size_t WS_WGU = 21 * MiB;
constexpr size_t WS_WD = 85 * MiB;
constexpr size_t WS_ACTB = 117 * MiB;
constexpr size_t WS_Y = 149 * MiB;
constexpr size_t WS_X1 = 181 * MiB;
constexpr size_t WS_ZR = 245 * MiB;
constexpr size_t WS_ZT = 325 * MiB;
constexpr size_t WS_TMP = 359 * MiB;
constexpr size_t WS_SMALL = 481 * MiB;
constexpr size_t WS_END = 489 * MiB;
constexpr size_t T_QC = WS_TMP, T_KC = WS_TMP + 16 * MiB, T_U = WS_TMP + 32 * MiB, T_CST = WS_TMP + 64 * MiB,
                 T_MPO = WS_TMP + 80 * MiB, T_MPML = WS_TMP + 104 * MiB, T_QIDX = WS_TMP + 106 * MiB;
constexpr size_t T_H = WS_TMP, T_YE = WS_TMP + 40 * MiB;
constexpr size_t SM_FLF = WS_SMALL, SM_FCL = SM_FLF + 256 * 1024, SM_MLI = SM_FCL + 256 * 1024, SM_MLF = SM_MLI + 256 * 1024,
                 SM_MB = SM_MLF + 256 * 1024, SM_MA = SM_MB + 256 * 1024, SM_MPX = SM_MA + 256 * 1024,
                 SM_FTS = SM_MPX + 256 * 1024, SM_KMEAN = SM_FTS + 4096, SM_EID = SM_KMEAN + 65536, SM_SLOT = SM_EID + 131072,
                 SM_WT = SM_SLOT + 131072, SM_ELIST = SM_WT + 131072, SM_MLSC = SM_ELIST + 2 * MiB, SM_NLOC = SM_MLSC + 16384,
                 SM_NST = SM_NLOC + 262144, SM_MSEL = SM_NST + 262144, SM_CNTQ = SM_MSEL + 262144, SM_END = SM_CNTQ + 131072;
static_assert(SM_END <= WS_END, "small region");
static_assert(WS_ZT + (size_t)1024 * ZTP * 2 <= WS_TMP, "transposed z buffer");
constexpr int CW_BAR = 4096;
__host__ __device__ constexpr int CW_ECNT(int l) { return 8192 + 64 * l; }
__host__ __device__ constexpr int CW_KMAX(int l) { return 9216 + 16 * l; }
__host__ __device__ constexpr int CW_GUC(int l) { return 12288 + 4096 * l; }

constexpr int RING_BYTES = 131072;
constexpr int LDS_BYTES = 163840;
constexpr int LDS_MISC = LDS_BYTES - 64;
constexpr int LDS_TAB = LDS_MISC - 4096;

__device__ __forceinline__ unsigned f2bf(float f) { unsigned u = __builtin_bit_cast(unsigned, f); return (u + 0x7fffu + ((u >> 16) & 1u)) >> 16; }
typedef __bf16 bf16x2_t __attribute__((ext_vector_type(2)));
__device__ __forceinline__ unsigned pk2(float lo, float hi) { const f32x2 v = {lo, hi}; const bf16x2_t b = __builtin_convertvector(v, bf16x2_t); return __builtin_bit_cast(unsigned, b); }
__device__ __forceinline__ float bf2f(unsigned h) { return __builtin_bit_cast(float, h << 16); }
__device__ __forceinline__ float bflo(unsigned w) { return __builtin_bit_cast(float, w << 16); }
__device__ __forceinline__ float bfhi(unsigned w) { return __builtin_bit_cast(float, w & 0xffff0000u); }
typedef unsigned u32x2v __attribute__((ext_vector_type(2)));
template <int CTRL> __device__ __forceinline__ float dpp_f(float v) { return __builtin_bit_cast(float, __builtin_amdgcn_update_dpp(0, __builtin_bit_cast(int, v), CTRL, 0xf, 0xf, true)); }
#ifndef RED_MODE
#define RED_MODE 7
#endif
__device__ __forceinline__ float x32f(float v) { if (RED_MODE & 2) { unsigned a = __builtin_bit_cast(unsigned, v), b = a; asm volatile("s_nop 1\n\tv_permlane32_swap_b32 %0, %1" : "+v"(a), "+v"(b));
        return (__builtin_amdgcn_mbcnt_hi(~0u, __builtin_amdgcn_mbcnt_lo(~0u, 0u)) < 32u) ? __builtin_bit_cast(float, b) : __builtin_bit_cast(float, a); } return __shfl_xor(v, 32); }
__device__ __forceinline__ float x16f(float v) { if (RED_MODE & 4) { unsigned a = __builtin_bit_cast(unsigned, v), b = a; asm volatile("s_nop 1\n\tv_permlane16_swap_b32 %0, %1" : "+v"(a), "+v"(b));
        return ((__builtin_amdgcn_mbcnt_hi(~0u, __builtin_amdgcn_mbcnt_lo(~0u, 0u)) >> 4) & 1u) ? __builtin_bit_cast(float, a) : __builtin_bit_cast(float, b); } return __shfl_xor(v, 16); }
__device__ __forceinline__ float grp_sum(float v) { v += x32f(v); v += x16f(v); return v; }
__device__ __forceinline__ float grp_max(float v) { v = fmaxf(v, x32f(v)); v = fmaxf(v, x16f(v)); return v; }
__device__ __forceinline__ float row_sum16(float v) { v += dpp_f<0xB1>(v); v += dpp_f<0x4E>(v); v += dpp_f<0x141>(v); v += dpp_f<0x140>(v); return v; }
__device__ __forceinline__ float row_max16(float v) { v = fmaxf(v, dpp_f<0xB1>(v)); v = fmaxf(v, dpp_f<0x4E>(v)); v = fmaxf(v, dpp_f<0x141>(v)); v = fmaxf(v, dpp_f<0x140>(v)); return v; }
__device__ __forceinline__ float wave_sum(float v) {
    if (RED_MODE & 1) v = row_sum16(v); else { v += __shfl_xor(v, 1); v += __shfl_xor(v, 2); v += __shfl_xor(v, 4); v += __shfl_xor(v, 8); }
    return grp_sum(v); }
__device__ __forceinline__ float wave_max(float v) {
    if (RED_MODE & 1) v = row_max16(v); else { v = fmaxf(v, __shfl_xor(v, 1)); v = fmaxf(v, __shfl_xor(v, 2)); v = fmaxf(v, __shfl_xor(v, 4)); v = fmaxf(v, __shfl_xor(v, 8)); }
    return grp_max(v); }
__device__ __forceinline__ float log_sigmoid(float x) { return fminf(x, 0.f) - log1pf(__expf(-fabsf(x))); }
__device__ __forceinline__ float sigmoidf(float x) { return 1.f / (1.f + __expf(-x)); }
__device__ __forceinline__ float siluf(float x) { return x / (1.f + __expf(-x)); }
#define MFMA16(a, b, c) __builtin_amdgcn_mfma_f32_16x16x32_bf16((a), (b), (c), 0, 0, 0)
#define VM_WAIT() asm volatile("s_waitcnt vmcnt(0)" ::: "memory")

#define XB_TMO      128
#define XB_XCNT(j)  (256  + 64 * (j))
#define XB_XSUB(j)  (1280 + 64 * (j))
#define XB_XGEN(j)  (2304 + 64 * (j))
#define XB_TOP      3328
#define XB_TOPGEN   3392
#define XCD_BAR_WORDS 3456
#define XB_SPIN_CAP (1u << 24)
__device__ __forceinline__ unsigned xb_ld(unsigned* p)              { return __hip_atomic_load(p, __ATOMIC_RELAXED, __HIP_MEMORY_SCOPE_AGENT); }
__device__ __forceinline__ unsigned xb_add(unsigned* p, unsigned v) { return __hip_atomic_fetch_add(p, v, __ATOMIC_RELAXED, __HIP_MEMORY_SCOPE_AGENT); }
__device__ __forceinline__ unsigned xb_xcc_id() { return (unsigned)__builtin_amdgcn_s_getreg((3 << 11) | 20) & 0xFu; }
#define XB_SPIN(cond, bar) do { unsigned _sp = 0; while (cond) { __builtin_amdgcn_s_sleep(1); \
    if ((++_sp & 255u) == 0u) { if (xb_ld(&(bar)[XB_TMO])) break; if (_sp > XB_SPIN_CAP) { atomicAdd(&(bar)[XB_TMO], 1u); break; } } } } while (0)
struct XcdBarrier { unsigned* bar; unsigned x; volatile LAS unsigned* st; };
__device__ __forceinline__ XcdBarrier xcd_barrier_post(unsigned* bar, volatile LAS unsigned* st) {
    XcdBarrier b; b.bar = bar; b.x = xb_xcc_id(); b.st = st;
    if (threadIdx.x == 0) (void)xb_add(&bar[XB_XCNT(b.x)], 1u);
    return b;
}
__device__ __forceinline__ void xcd_barrier_complete(unsigned* bar, unsigned x, unsigned& nloc, unsigned& nx) {
    const unsigned G = gridDim.x * gridDim.y * gridDim.z;
    unsigned sum, cnt, mine, sp = 0u;
    for (;;) {
        sum = 0u; cnt = 0u; mine = 0u;
#pragma unroll
        for (unsigned j = 0; j < 16; ++j) { const unsigned c = xb_ld(&bar[XB_XCNT(j)]); sum += c; cnt += (c > 0u) ? 1u : 0u; mine = (j == x) ? c : mine; }
        if (sum == G) break;
        __builtin_amdgcn_s_sleep(1);
        if ((++sp & 255u) == 0u) { if (xb_ld(&bar[XB_TMO])) break; if (sp > XB_SPIN_CAP) { atomicAdd(&bar[XB_TMO], 1u); break; } }
    }
    nloc = mine > 0u ? mine : 1u; nx = cnt > 0u ? cnt : 1u;
}
__device__ __forceinline__ void xcd_barrier(const XcdBarrier& b, const bool thread0) {
    asm volatile("s_waitcnt vmcnt(0)" ::: "memory");
    __syncthreads();
    if (thread0) {
        unsigned* bar = b.bar;
        __builtin_amdgcn_s_waitcnt(0);
        unsigned nloc = b.st[0], nx = b.st[1];
        if (nloc == 0u) { xcd_barrier_complete(bar, b.x, nloc, nx); b.st[0] = nloc; b.st[1] = nx; }
        const unsigned old = xb_add(&bar[XB_XSUB(b.x)], 1u);
        const unsigned gen = old / nloc;
        if (old + 1u == (gen + 1u) * nloc) {
            __builtin_amdgcn_fence(__ATOMIC_RELEASE, "agent");
            asm volatile("s_waitcnt vmcnt(0)" ::: "memory");
            const unsigned og = xb_add(&bar[XB_TOP], 1u);
            const unsigned tg = og / nx;
            if (og + 1u == (tg + 1u) * nx) xb_add(&bar[XB_TOPGEN], 1u);
            else XB_SPIN(xb_ld(&bar[XB_TOPGEN]) == tg, bar);
            __builtin_amdgcn_fence(__ATOMIC_ACQUIRE, "agent");
            xb_add(&bar[XB_XGEN(b.x)], 1u);
            asm volatile("s_waitcnt vmcnt(0)" ::: "memory");
        } else {
            XB_SPIN(xb_ld(&bar[XB_XGEN(b.x)]) == gen, bar);
            __builtin_amdgcn_fence(__ATOMIC_ACQUIRE, "agent");
            asm volatile("s_waitcnt vmcnt(0)" ::: "memory");
        }
    }
    __syncthreads();
}
namespace pg8 {
constexpr int BM = 256, BK = 64, HALF = 128, HTB = HALF * BK * 2, STAGE_BYTES = 8 * HTB, NXCD = 8, WGM = 8;
__host__ __device__ __forceinline__ int lds_byte(int r, int c) { const int st = (r >> 4) * 2 + (c >> 5), rr = r & 15, cc = c & 31, ob = rr * 64 + cc * 2; return st * 1024 + (ob ^ (((ob >> 9) & 1) << 5)); }
__host__ __device__ __forceinline__ void stage_rc(int b, int& R, int& C) { const int st = b / 1024, sb = b % 1024, swz = sb ^ (((sb >> 9) & 1) << 5); R = (st >> 1) * 16 + swz / 64; C = (st & 1) * 32 + (swz % 64) / 2; }
__host__ __device__ __forceinline__ int perm32(int rho) { const int n = rho >> 4, i = rho & 15; return 8 * (i >> 2) + 4 * n + (i & 3); }

struct GUnit {
    const char* A;
    const char* B;
    int pm, pn, x0;
    const int* list;
    int l0, nl;
};

template <class Epi, class Sched, bool GATHER = false, bool HOOK = false>
__device__ __forceinline__ void gemm_phase(LAS unsigned char* lds, const int K, const Sched& S, const Epi& E, const int tid, LAS unsigned* rtab = nullptr) {
    const int wid = __builtin_amdgcn_readfirstlane(tid >> 6), lane = tid & 63, wr = wid >> 2, wc = wid & 3, fr = lane & 15, fq = lane >> 4;
    const int nt = K / BK;
    unsigned voffA[2], voffB[2];
#pragma unroll
    for (int i = 0; i < 2; ++i) { int R, C; stage_rc(tid * 16 + i * 8192, R, C); const int Rb = (R & ~31) + perm32(R & 31); voffA[i] = (unsigned)(R * K + C) * 2u; voffB[i] = (unsigned)(Rb * K + C) * 2u; }
    const size_t kstep = (size_t)(BK * 2);
    const size_t hstep = (size_t)HALF * K * 2;
    const unsigned ldsw = (unsigned)wid * 1024u;
    const int aoff = lds_byte(wr * 64 + fr, fq * 8), boff = lds_byte(wc * 32 + fr, fq * 8);
#define PG8_SA(b, h) (((b) * 2 + (h)) * HTB)
#define PG8_SB(b, h) ((4 + (b) * 2 + (h)) * HTB)
#define PG8_STAGE(bufoff, gbase, voff) do { _Pragma("unroll") for (int _i = 0; _i < 2; ++_i) \
        __builtin_amdgcn_global_load_lds((const unsigned*)((const char*)(gbase) + (voff)[_i]), (LAS unsigned*)(lds + (bufoff) + ldsw + _i * 8192), 16, 0, 0); } while (0)
#define PG8_STAGE_A(bufoff, gbase, voff) do { _Pragma("unroll") for (int _i = 0; _i < 2; ++_i) \
        __builtin_amdgcn_global_load_lds((const unsigned*)((const char*)(gbase) + (voff)[_i]), (LAS unsigned*)(lds + (bufoff) + ldsw + _i * 8192), 16, 0, HOOK ? 16 : 0); } while (0)
#define PG8_LDA(dst, b, h) do { _Pragma("unroll") for (int m = 0; m < 4; ++m) _Pragma("unroll") for (int k = 0; k < 2; ++k) dst[m][k] = *(const LAS bf16x8*)(lds + PG8_SA(b, h) + aoff + m * 2048 + k * 1024); } while (0)
#define PG8_LDB(dst, b, h) do { _Pragma("unroll") for (int n = 0; n < 2; ++n) _Pragma("unroll") for (int k = 0; k < 2; ++k) dst[n][k] = *(const LAS bf16x8*)(lds + PG8_SB(b, h) + boff + n * 2048 + k * 1024); } while (0)
#define PG8_MMA(ai, bj, At, Bt) do { __builtin_amdgcn_s_setprio(1); _Pragma("unroll") for (int m = 0; m < 4; ++m) _Pragma("unroll") for (int n = 0; n < 2; ++n) _Pragma("unroll") for (int k = 0; k < 2; ++k) \
        acc[ai][bj][m][n] = __builtin_amdgcn_mfma_f32_16x16x32_bf16(Bt[n][k], At[m][k], acc[ai][bj][m][n], 0, 0, 0); __builtin_amdgcn_s_setprio(0); } while (0)
#define PG8_WAIT_V(n) asm volatile("s_waitcnt vmcnt(" #n ")" ::: "memory")
#define PG8_WAIT_L(n) asm volatile("s_waitcnt lgkmcnt(" #n ")" ::: "memory")
#define PG8_BAR __builtin_amdgcn_s_barrier()
#define PG8_SCHED __builtin_amdgcn_sched_barrier(0)
#define PG8_STAGE_G(bufoff, gbase, vo) do { _Pragma("unroll") for (int _i = 0; _i < 2; ++_i) \
        __builtin_amdgcn_global_load_lds((const unsigned*)((const char*)(gbase) + (vo)[_i]), (LAS unsigned*)(lds + (bufoff) + ldsw + _i * 8192), 16, 0, 0); } while (0)
#define PG8_ROWTAB(u, slot) do { if (tid < 256) { int _x = (u).l0 + tid; _x = _x < (u).nl ? _x : (u).nl - 1; rtab[(slot) * 256 + tid] = (unsigned)(u).list[_x] * (unsigned)(K * 2); } } while (0)
#define PG8_LOADCV(slot) do { _Pragma("unroll") for (int _h = 0; _h < 2; ++_h) _Pragma("unroll") for (int _i = 0; _i < 2; ++_i) { int _R, _C; stage_rc(tid * 16 + _i * 8192, _R, _C); \
        cv[_h][_i] = rtab[(slot) * 256 + _h * HALF + _R] + (unsigned)(_C * 2); } } while (0)
    GUnit cur, nxt; int ui = 0;
    if (!S.next(0, cur)) return;
    unsigned cv[2][2]; int par = 0;
    if constexpr (GATHER) { PG8_ROWTAB(cur, 0); __syncthreads(); PG8_LOADCV(0); }
    f32x4 acc[2][2][4][2];
#pragma unroll
    for (int a = 0; a < 2; ++a)
#pragma unroll
        for (int b = 0; b < 2; ++b)
#pragma unroll
            for (int m = 0; m < 4; ++m)
#pragma unroll
                for (int n = 0; n < 2; ++n) acc[a][b][m][n] = (f32x4){0.f, 0.f, 0.f, 0.f};
    bf16x8 At[4][2], B0[2][2], B1[2][2];
    const char* cA = cur.A; const char* cB = cur.B;
    if constexpr (HOOK) S.a_ready(cur, wid, lane);
    PG8_STAGE(PG8_SB(0, 0), cB, voffB); PG8_STAGE(PG8_SB(0, 1), cB + hstep, voffB);
    if constexpr (GATHER) { PG8_STAGE_G(PG8_SA(0, 0), cA, cv[0]); PG8_STAGE_G(PG8_SA(0, 1), cA, cv[1]); } else { PG8_STAGE_A(PG8_SA(0, 0), cA, voffA); PG8_STAGE_A(PG8_SA(0, 1), cA + hstep, voffA); }
    if (wr == 1) PG8_BAR;
    PG8_WAIT_V(2); PG8_BAR;
    PG8_STAGE(PG8_SB(1, 0), cB + kstep, voffB); if constexpr (GATHER) PG8_STAGE_G(PG8_SA(1, 0), cA + kstep, cv[0]); else PG8_STAGE_A(PG8_SA(1, 0), cA + kstep, voffA); PG8_STAGE(PG8_SB(1, 1), cB + hstep + kstep, voffB);
    PG8_WAIT_V(6); PG8_BAR;
    for (;;) {
        const bool has_next = S.next(ui + 1, nxt);
        const char* nA = has_next ? nxt.A : cA; const char* nB = has_next ? nxt.B : cB;
        if constexpr (GATHER) { if (has_next) PG8_ROWTAB(nxt, par ^ 1); }
        for (int t = 0; t < nt; t += 2) {
            const bool last = (t == nt - 2);
            const char* a1 = cA + (size_t)(t + 1) * kstep;
            const char* a2 = last ? nA : cA + (size_t)(t + 2) * kstep; const char* b2 = last ? nB : cB + (size_t)(t + 2) * kstep;
            const char* a3 = a2 + kstep; const char* b3 = b2 + kstep;
            if constexpr (HOOK) { if (last && has_next) S.a_ready(nxt, wid, lane); }
            PG8_LDB(B0, 0, 0); PG8_LDB(B1, 0, 1); PG8_SCHED; PG8_LDA(At, 0, 0);
            if constexpr (GATHER) { PG8_STAGE_G(PG8_SA(1, 1), a1, cv[1]); if (last && has_next) PG8_LOADCV(par ^ 1); } else PG8_STAGE_A(PG8_SA(1, 1), a1 + hstep, voffA);
            PG8_WAIT_V(8); PG8_WAIT_L(0); PG8_BAR; PG8_MMA(0, 0, At, B0); PG8_MMA(0, 1, At, B1); PG8_BAR; PG8_SCHED;
            PG8_LDA(At, 0, 1); PG8_STAGE(PG8_SB(0, 0), b2, voffB); PG8_STAGE(PG8_SB(0, 1), b2 + hstep, voffB); if constexpr (GATHER) PG8_STAGE_G(PG8_SA(0, 0), a2, cv[0]); else PG8_STAGE_A(PG8_SA(0, 0), a2, voffA);
            PG8_WAIT_V(8); PG8_WAIT_L(0); PG8_BAR; PG8_MMA(1, 0, At, B0); PG8_MMA(1, 1, At, B1); PG8_BAR; PG8_SCHED;
            PG8_LDB(B0, 1, 0); PG8_LDB(B1, 1, 1); PG8_SCHED; PG8_LDA(At, 1, 0); if constexpr (GATHER) PG8_STAGE_G(PG8_SA(0, 1), a2, cv[1]); else PG8_STAGE_A(PG8_SA(0, 1), a2 + hstep, voffA);
            PG8_WAIT_V(8); PG8_WAIT_L(0); PG8_BAR; PG8_MMA(0, 0, At, B0); PG8_MMA(0, 1, At, B1); PG8_BAR; PG8_SCHED;
            PG8_LDA(At, 1, 1); PG8_STAGE(PG8_SB(1, 0), b3, voffB); PG8_STAGE(PG8_SB(1, 1), b3 + hstep, voffB); if constexpr (GATHER) PG8_STAGE_G(PG8_SA(1, 0), a3, cv[0]); else PG8_STAGE_A(PG8_SA(1, 0), a3, voffA);
            PG8_WAIT_V(8); PG8_WAIT_L(0); PG8_BAR; PG8_MMA(1, 0, At, B0); PG8_MMA(1, 1, At, B1); PG8_BAR; PG8_SCHED;
        }
        if (wr == 0) PG8_BAR;
        E(acc, cur, wr, wc, fr, fq);
        if (!has_next) break;
#pragma unroll
        for (int a = 0; a < 2; ++a)
#pragma unroll
            for (int b = 0; b < 2; ++b)
#pragma unroll
                for (int m = 0; m < 4; ++m)
#pragma unroll
                    for (int n = 0; n < 2; ++n) acc[a][b][m][n] = (f32x4){0.f, 0.f, 0.f, 0.f};
        cur = nxt; cA = nA; cB = nB; ++ui; par ^= 1;
        if (wr == 1) PG8_BAR;
    }
    PG8_WAIT_V(0);
    PG8_BAR;
#undef PG8_SA
#undef PG8_SB
#undef PG8_STAGE
#undef PG8_STAGE_A
#undef PG8_LDA
#undef PG8_LDB
#undef PG8_MMA
#undef PG8_WAIT_V
#undef PG8_WAIT_L
#undef PG8_BAR
#undef PG8_SCHED
#undef PG8_STAGE_G
#undef PG8_ROWTAB
#undef PG8_LOADCV
}
}
__device__ __forceinline__ int win_srccol(int n) {
    if (n < 256) return n;
    if (n < 512) return n;
    if (n < 1024) return 772 + (n - 512);
    if (n < 1536) return 1284 + (n - 1024);
    if (n < 2048) return 2316 + (n - 1536);
    if (n < 2304) return 2828 + (n - 2048);
    if (n < 2560) return 3084 + (n - 2304);
    if (n < 2816) return 512 + (n - 2560);
    if (n < 3328) return 1796 + (n - 2816);
    return 3340 + (n - 3328);
}
__device__ __forceinline__ void transpose_item(const float* cp, int ld, bf16_t* WT, int Kd, int k0, int n0, LAS float* scr, int lane) {
    float tmp[32];
#pragma unroll
    for (int i = 0; i < 32; ++i) tmp[i] = cp[(size_t)(k0 + 2 * i + (lane >> 5)) * ld];
#pragma unroll
    for (int i = 0; i < 32; ++i) scr[(2 * i + (lane >> 5)) * 33 + (lane & 31)] = tmp[i];
    asm volatile("s_waitcnt vmcnt(0) lgkmcnt(0)" ::: "memory");
    const int c = lane & 7;
#pragma unroll
    for (int j = 0; j < 4; ++j) { const int n = (lane >> 3) + 8 * j; const LAS float* s = scr + (8 * c) * 33 + n;
        u32x4 o; o.x = pk2(s[0 * 33], s[1 * 33]); o.y = pk2(s[2 * 33], s[3 * 33]); o.z = pk2(s[4 * 33], s[5 * 33]); o.w = pk2(s[6 * 33], s[7 * 33]);
        *(u32x4*)(WT + (size_t)(n0 + n) * Kd + k0 + 8 * c) = o; }
    asm volatile("s_waitcnt lgkmcnt(0)" ::: "memory");
}
__device__ __forceinline__ void load_w12(const float* w_in_l, LAS float* w12, int tid) {
    for (int idx = tid; idx < 3 * 1024; idx += 512) { const int k = idx & 1023, q = idx >> 10; const int col = q == 0 ? 768 : (q == 1 ? 2308 : 2312);
        const f32x4 w = *(const f32x4*)(w_in_l + (size_t)k * INW + col);
        w12[(4 * q + 0) * 1024 + k] = w.x; w12[(4 * q + 1) * 1024 + k] = w.y; w12[(4 * q + 2) * 1024 + k] = w.z; w12[(4 * q + 3) * 1024 + k] = w.w; }
}
__device__ __forceinline__ void gates_row(const f32x4 (&v)[4], const LAS float* w12, const float* bff, const float* bmi, const float* bmf, float* flf, float* mli, float* mlf, int t, int lane) {
    float d[12];
#pragma unroll
    for (int c = 0; c < 12; ++c) { float s = 0.f;
#pragma unroll
        for (int j = 0; j < 4; ++j) { const f32x4 w = *(const LAS f32x4*)(w12 + c * 1024 + 256 * j + 4 * lane); s += (v[j].x * w.x + v[j].y * w.y) + (v[j].z * w.z + v[j].w * w.w); }
        d[c] = wave_sum(s); }
    if (lane < 4 && t >= 0) {
        float a = d[0], b = d[4], c = d[8];
#pragma unroll
        for (int h = 1; h < 4; ++h) { if (lane == h) { a = d[h]; b = d[4 + h]; c = d[8 + h]; } }
        flf[lane * S + t] = log_sigmoid(a + bff[lane]);
        mli[lane * S + t] = b + bmi[lane];
        mlf[lane * S + t] = log_sigmoid(c + bmf[lane]);
    }
}
__device__ __forceinline__ void ln_row(f32x4 (&v)[4], const float* gam, const float* bet, int lane) {
    float s = 0.f;
#pragma unroll
    for (int j = 0; j < 4; ++j) s += (v[j].x + v[j].y) + (v[j].z + v[j].w);
    const float mean = wave_sum(s) * (1.f / DM); float s2 = 0.f;
#pragma unroll
    for (int j = 0; j < 4; ++j) { v[j] = v[j] - mean; s2 += (v[j].x * v[j].x + v[j].y * v[j].y) + (v[j].z * v[j].z + v[j].w * v[j].w); }
    const float rstd = rsqrtf(wave_sum(s2) * (1.f / DM) + EPS);
#pragma unroll
    for (int j = 0; j < 4; ++j) { const f32x4 g = *(const f32x4*)(gam + 256 * j + 4 * lane), b = *(const f32x4*)(bet + 256 * j + 4 * lane); v[j] = v[j] * rstd * g + b; }
}
__device__ __forceinline__ void store_row_bf16(const f32x4 (&v)[4], bf16_t* orow, int lane) {
#pragma unroll
    for (int j = 0; j < 4; ++j) { u32x2 o; o.x = pk2(v[j].x, v[j].y); o.y = pk2(v[j].z, v[j].w); *(u32x2*)(orow + 256 * j + 4 * lane) = o; }
}

__device__ __forceinline__ void p0_prologue(const float* x, const int* pos, const float* w_in, const float* w_out, const float* bff, const float* bmi, const float* bmf,
                                            unsigned char* ws, LAS unsigned char* lds, int tid, int lane, int wave, int bid, int G) {
    LAS float* scr = (LAS float*)(lds + wave * 16384);
    const int gw = bid * 8 + wave, NGW = G * 8;
    constexpr int I_IN = 16 * (NZ / 32), I_OUT = 16 * 32;
    for (int it = gw; it < NL * (I_IN + I_OUT); it += NGW) {
        const int l = it / (I_IN + I_OUT); int r = it % (I_IN + I_OUT);
        if (r < I_IN) { const int kb = r / (NZ / 32), nb = r % (NZ / 32); const int n0 = nb * 32;
            const float* cp = w_in + (size_t)l * DM * INW + win_srccol(n0 + (lane & 31));
            transpose_item(cp, INW, (bf16_t*)(ws + WS_WIN) + (size_t)l * NZ * DM, DM, kb * 64, n0, scr, lane);
        } else { r -= I_IN; const int kb = r / 32, nb = r % 32; const int n0 = nb * 32;
            const float* cp = w_out + (size_t)l * DM * DM + n0 + (lane & 31);
            transpose_item(cp, DM, (bf16_t*)(ws + WS_WOUT) + (size_t)l * DM * DM, DM, kb * 64, n0, scr, lane); }
    }
    {
        const double inv[8] = {1.0, 0.19392274474868576, 0.03760603093086393, 0.007292664737217109, 0.001414213562373095, 0.0002742481756762073, 5.318295896944988e-05, 1.031338537721246e-05};
        float* rt = (float*)(ws + WS_ROPE);
        for (int idx = bid * 512 + tid; idx < S * 8; idx += G * 512) { const int t = idx >> 3, i = idx & 7; double iv = inv[0];
#pragma unroll
            for (int q = 1; q < 8; ++q) iv = (i == q) ? inv[q] : iv;
            const double ang = (double)pos[t] * iv; rt[2 * idx] = (float)cos(ang); rt[2 * idx + 1] = (float)sin(ang); }
    }
    __syncthreads();
    LAS float* w12 = (LAS float*)lds;
    load_w12(w_in, w12, tid);
    __syncthreads();
    float* flf = (float*)(ws + SM_FLF); float* mli = (float*)(ws + SM_MLI); float* mlf = (float*)(ws + SM_MLF);
    bf16_t* xb = (bf16_t*)(ws + WS_ACTB);
#pragma unroll 2
    for (int t = gw; t < S; t += NGW) {
        f32x4 v[4];
#pragma unroll
        for (int j = 0; j < 4; ++j) v[j] = *(const f32x4*)(x + (size_t)t * DM + 256 * j + 4 * lane);
        store_row_bf16(v, xb + (size_t)t * DM, lane);
        gates_row(v, w12, bff, bmi, bmf, flf, mli, mlf, t, lane);
    }
    __syncthreads();
}

__device__ __forceinline__ void moe_weights(const float* w_gate_l, const float* w_up_l, const float* w_down_l, unsigned char* ws, LAS unsigned char* lds, int lane, int wave, int gw, int NGW, int it0, int it1) {
    LAS float* scr = (LAS float*)(lds + wave * 16384);
    constexpr int I_GU = 16 * 32, I_D = 8 * 32;
    for (int it = it0 + gw; it < it1; it += NGW) {
        const int e = it / (I_GU + I_D); int r = it % (I_GU + I_D);
        if (r < I_GU) { const int kb = r / 32, nb = r % 32, n0 = nb * 32; const int n = n0 + (lane & 31); const int a = n >> 3, b = n & 7; const int hid = 4 * a + (b & 3);
            const float* cp = ((b >> 2) ? w_up_l : w_gate_l) + (size_t)e * DM * DE + hid;
            transpose_item(cp, DE, (bf16_t*)(ws + WS_WGU) + (size_t)e * DM * DM, DM, kb * 64, n0, scr, lane);
        } else { r -= I_GU; const int kb = r / 32, nb = r % 32, n0 = nb * 32;
            const float* cp = w_down_l + (size_t)e * DE * DM + n0 + (lane & 31);
            transpose_item(cp, DM, (bf16_t*)(ws + WS_WD) + (size_t)e * DM * DE, DE, kb * 64, n0, scr, lane); }
    }
}
constexpr int MOE_ITEMS = NE * (16 * 32 + 8 * 32);
constexpr int MOE_FILL = 6144;
__device__ __forceinline__ void mix1_unit(int u, unsigned char* ws, unsigned* ctl_kmax, LAS unsigned char* lds, int tid, int lane, int wave) {
    const int blk = u >> 2, h = u & 3, t0 = blk * 256;
    bf16_t* ZR = (bf16_t*)(ws + WS_ZR);
    const float* rope = (const float*)(ws + WS_ROPE);
    LAS float* kr = (LAS float*)lds;
    LAS float* part = (LAS float*)(lds + 16384);
    LAS float* sq = (LAS float*)(lds + 16384 + 2048);
    {
        const int tl = tid & 255, which = tid >> 8; const int t = t0 + tl;
        bf16_t* p = ZR + (size_t)t * ZRW + (which ? ZR_BK : ZR_BQ) + h * 64;
        const u32x4 w0 = *(const u32x4*)p, w1 = *(const u32x4*)(p + 8);
        float u1[8], u2[8];
        u1[0] = bflo(w0.x); u1[1] = bfhi(w0.x); u1[2] = bflo(w0.y); u1[3] = bfhi(w0.y); u1[4] = bflo(w0.z); u1[5] = bfhi(w0.z); u1[6] = bflo(w0.w); u1[7] = bfhi(w0.w);
        u2[0] = bflo(w1.x); u2[1] = bfhi(w1.x); u2[2] = bflo(w1.y); u2[3] = bfhi(w1.y); u2[4] = bflo(w1.z); u2[5] = bfhi(w1.z); u2[6] = bflo(w1.w); u2[7] = bfhi(w1.w);
        float o1[8], o2[8];
#pragma unroll
        for (int i = 0; i < 8; ++i) { const f32x2 cs = *(const f32x2*)(rope + ((size_t)t * 8 + i) * 2); o1[i] = u1[i] * cs.x - u2[i] * cs.y; o2[i] = u1[i] * cs.y + u2[i] * cs.x; }
        u32x4 r0, r1;
        r0.x = pk2(o1[0], o1[1]); r0.y = pk2(o1[2], o1[3]); r0.z = pk2(o1[4], o1[5]); r0.w = pk2(o1[6], o1[7]);
        r1.x = pk2(o2[0], o2[1]); r1.y = pk2(o2[2], o2[3]); r1.z = pk2(o2[4], o2[5]); r1.w = pk2(o2[6], o2[7]);
        *(u32x4*)p = r0; *(u32x4*)(p + 8) = r1;
        if (which) {
            LAS float* d = kr + tl * 16;
            d[0] = bflo(r0.x); d[1] = bfhi(r0.x); d[2] = bflo(r0.y); d[3] = bfhi(r0.y); d[4] = bflo(r0.z); d[5] = bfhi(r0.z); d[6] = bflo(r0.w); d[7] = bfhi(r0.w);
            d[8] = bflo(r1.x); d[9] = bfhi(r1.x); d[10] = bflo(r1.y); d[11] = bfhi(r1.y); d[12] = bflo(r1.z); d[13] = bfhi(r1.z); d[14] = bflo(r1.w); d[15] = bfhi(r1.w);
        }
    }
    {
        const int tl = tid & 255, half = tid >> 8;
        const bf16_t* p = ZR + (size_t)(t0 + tl) * ZRW + ZR_FK + h * 64 + half * 32;
        float s = 0.f;
#pragma unroll
        for (int j = 0; j < 4; ++j) { const u32x4 w = *(const u32x4*)(p + 8 * j);
            float a;
            a = bflo(w.x); s += a * a; a = bfhi(w.x); s += a * a; a = bflo(w.y); s += a * a; a = bfhi(w.y); s += a * a;
            a = bflo(w.z); s += a * a; a = bfhi(w.z); s += a * a; a = bflo(w.w); s += a * a; a = bfhi(w.w); s += a * a; }
        sq[tid] = s;
    }
    __syncthreads();
    {
        const int d = tid & 63, pp = tid >> 6; float s = 0.f;
        if (d < 16) { for (int i = 0; i < 32; ++i) s += kr[(pp * 32 + i) * 16 + d]; }
        else { const bf16_t* p = ZR + (size_t)(t0 + pp * 32) * ZRW + ZR_BK + h * 64 + d; for (int i = 0; i < 32; ++i) s += bf2f(p[(size_t)i * ZRW]); }
        part[pp * 64 + d] = s;
    }
    if (wave < 4) {
        const float* flf = (const float*)(ws + SM_FLF) + (size_t)h * S + t0 + wave * 64;
        float v = flf[lane];
#pragma unroll
        for (int o = 1; o < 64; o <<= 1) { const float n = __shfl_up(v, o); if (lane >= o) v += n; }
        ((float*)(ws + SM_FCL))[(size_t)h * S + t0 + wave * 64 + lane] = v;
        if (lane == 63) ((float*)(ws + SM_FTS))[h * 256 + blk * 4 + wave] = v;
    } else {
        const int i = tid - 256; float m = sq[i] + sq[i + 256];
        m = wave_max(m);
        if (lane == 0) atomicMax(ctl_kmax + h, __builtin_bit_cast(unsigned, m));
    }
    __syncthreads();
    if (tid < 64) { float s = 0.f;
#pragma unroll
        for (int pp = 0; pp < 8; ++pp) s += part[pp * 64 + tid];
        ((float*)(ws + SM_KMEAN))[((size_t)h * 64 + blk) * 64 + tid] = s * (1.f / 256.f); }
    __syncthreads();
}
struct RowState { f32x4 O[4]; float m, l; };
constexpr float LOG2E = 1.4426950408889634f, SC2 = 0.125f * LOG2E;

struct KVFrag { bf16x8 k[4]; u32x2 v[8]; };
__device__ __forceinline__ void kv_fetch(KVFrag& f, const bf16_t* krow, const bf16_t* vT, int kb, int lane) {
    const int qi = lane & 15, g = lane >> 4;
    const bf16_t* k0p = krow + (size_t)(kb + qi) * ZRW + 8 * g;
    const bf16_t* k1p = k0p + (size_t)16 * ZRW;
    f.k[0] = *(const bf16x8*)k0p; f.k[1] = *(const bf16x8*)(k0p + 32); f.k[2] = *(const bf16x8*)k1p; f.k[3] = *(const bf16x8*)(k1p + 32);
#pragma unroll
    for (int dt = 0; dt < 4; ++dt) { const bf16_t* vp = vT + (size_t)(16 * dt + qi) * ZTP + kb + 4 * g; f.v[2 * dt] = *(const u32x2*)vp; f.v[2 * dt + 1] = *(const u32x2*)(vp + 16); }
}
__device__ __forceinline__ void attn_compute32(RowState& st, const bf16x8 (&Qf)[2], const KVFrag& f, const f32x4 b0, const f32x4 b1) {
    f32x4 s0 = {0.f, 0.f, 0.f, 0.f}, s1 = {0.f, 0.f, 0.f, 0.f};
    s0 = MFMA16(f.k[0], Qf[0], s0); s0 = MFMA16(f.k[1], Qf[1], s0);
    s1 = MFMA16(f.k[2], Qf[0], s1); s1 = MFMA16(f.k[3], Qf[1], s1);
    float mx = -INFINITY;
#pragma unroll
    for (int r = 0; r < 4; ++r) { s0[r] = s0[r] * SC2 + b0[r]; s1[r] = s1[r] * SC2 + b1[r]; mx = fmaxf(mx, fmaxf(s0[r], s1[r])); }
    mx = grp_max(mx);
    float ps = 0.f; float p0[4], p1[4];
    if (__all(mx <= st.m)) {
#pragma unroll
        for (int r = 0; r < 4; ++r) { p0[r] = __builtin_amdgcn_exp2f(s0[r] - st.m); p1[r] = __builtin_amdgcn_exp2f(s1[r] - st.m); ps += p0[r] + p1[r]; }
        st.l += ps;
    } else {
        const float mn = fmaxf(st.m, mx);
        const float msafe = (mn == -INFINITY) ? 0.f : mn;
        const float alpha = __builtin_amdgcn_exp2f(st.m - msafe);
#pragma unroll
        for (int r = 0; r < 4; ++r) { p0[r] = __builtin_amdgcn_exp2f(s0[r] - msafe); p1[r] = __builtin_amdgcn_exp2f(s1[r] - msafe); ps += p0[r] + p1[r]; }
        st.l = st.l * alpha + ps; st.m = mn;
#pragma unroll
        for (int dt = 0; dt < 4; ++dt) st.O[dt] = st.O[dt] * alpha;
    }
    u32x4 pw; pw.x = pk2(p0[0], p0[1]); pw.y = pk2(p0[2], p0[3]); pw.z = pk2(p1[0], p1[1]); pw.w = pk2(p1[2], p1[3]);
    const bf16x8 pb = __builtin_bit_cast(bf16x8, pw);
#pragma unroll
    for (int dt = 0; dt < 4; ++dt) { u32x4 vw; vw.x = f.v[2 * dt].x; vw.y = f.v[2 * dt].y; vw.z = f.v[2 * dt + 1].x; vw.w = f.v[2 * dt + 1].y;
        st.O[dt] = MFMA16(__builtin_bit_cast(bf16x8, vw), pb, st.O[dt]); }
}
__device__ __forceinline__ void attn_finish(RowState& st, const float* gain, bf16_t* yrow, int lane) {
    const int g = lane >> 4;
    const float inv = 1.f / st.l; float ss = 0.f;
#pragma unroll
    for (int dt = 0; dt < 4; ++dt) { st.O[dt] = st.O[dt] * inv; ss += (st.O[dt].x * st.O[dt].x + st.O[dt].y * st.O[dt].y) + (st.O[dt].z * st.O[dt].z + st.O[dt].w * st.O[dt].w); }
    ss = grp_sum(ss);
    const float rs = rsqrtf(ss * (1.f / 64.f) + EPS);
#pragma unroll
    for (int dt = 0; dt < 4; ++dt) { const f32x4 gg = *(const f32x4*)(gain + 16 * dt + 4 * g); const f32x4 o = st.O[dt] * rs * gg;
        u32x2 w; w.x = pk2(o.x, o.y); w.y = pk2(o.z, o.w); *(u32x2*)(yrow + 16 * dt + 4 * g) = w; }
}

constexpr int KS_PITCH = 72, VS_PITCH = 264, KS_BYTES = 256 * KS_PITCH * 2, VS_BYTES = 64 * VS_PITCH * 2;
__device__ __forceinline__ void stage_kv_block(const bf16_t* krow  , const bf16_t* vT  , int key0, LAS unsigned char* lds, int tid) {
    LAS unsigned char* Ks = lds; LAS unsigned char* Vs = lds + KS_BYTES;
#pragma unroll
    for (int i = 0; i < 4; ++i) { const int c = tid + 512 * i; const int row = c >> 3, part = c & 7;
        const u32x4 v = *(const u32x4*)(krow + (size_t)(key0 + row) * ZRW + part * 8);
        *(LAS u32x4*)(Ks + row * (KS_PITCH * 2) + part * 16) = v; }
#pragma unroll
    for (int i = 0; i < 4; ++i) { const int c = tid + 512 * i; const int row = c >> 5, part = c & 31;
        const u32x4 v = *(const u32x4*)(vT + (size_t)row * ZTP + key0 + part * 8);
        *(LAS u32x4*)(Vs + row * (VS_PITCH * 2) + part * 16) = v; }
}
template <int VPB>
__device__ __forceinline__ void attn_step32_ldsp(RowState& st, const bf16x8 (&Qf)[2], LAS unsigned char* Ks, LAS unsigned char* Vs, int kb, const f32x4 b0, const f32x4 b1, int lane) {
    const int qi = lane & 15, g = lane >> 4;
    f32x4 s0 = {0.f, 0.f, 0.f, 0.f}, s1 = {0.f, 0.f, 0.f, 0.f};
    const LAS unsigned char* k0p = Ks + (kb + qi) * (KS_PITCH * 2) + 16 * g;
    const LAS unsigned char* k1p = k0p + 16 * (KS_PITCH * 2);
    s0 = MFMA16(*(const LAS bf16x8*)k0p, Qf[0], s0); s0 = MFMA16(*(const LAS bf16x8*)(k0p + 64), Qf[1], s0);
    s1 = MFMA16(*(const LAS bf16x8*)k1p, Qf[0], s1); s1 = MFMA16(*(const LAS bf16x8*)(k1p + 64), Qf[1], s1);
    float mx = -INFINITY;
#pragma unroll
    for (int r = 0; r < 4; ++r) { s0[r] = s0[r] * SC2 + b0[r]; s1[r] = s1[r] * SC2 + b1[r]; mx = fmaxf(mx, fmaxf(s0[r], s1[r])); }
    mx = grp_max(mx);
    float ps = 0.f; float p0[4], p1[4];
    if (__all(mx <= st.m)) {
#pragma unroll
        for (int r = 0; r < 4; ++r) { p0[r] = __builtin_amdgcn_exp2f(s0[r] - st.m); p1[r] = __builtin_amdgcn_exp2f(s1[r] - st.m); ps += p0[r] + p1[r]; }
        st.l += ps;
    } else {
        const float mn = fmaxf(st.m, mx);
        const float msafe = (mn == -INFINITY) ? 0.f : mn;
        const float alpha = __builtin_amdgcn_exp2f(st.m - msafe);
#pragma unroll
        for (int r = 0; r < 4; ++r) { p0[r] = __builtin_amdgcn_exp2f(s0[r] - msafe); p1[r] = __builtin_amdgcn_exp2f(s1[r] - msafe); ps += p0[r] + p1[r]; }
        st.l = st.l * alpha + ps; st.m = mn;
#pragma unroll
        for (int dt = 0; dt < 4; ++dt) st.O[dt] = st.O[dt] * alpha;
    }
    u32x4 pw; pw.x = pk2(p0[0], p0[1]); pw.y = pk2(p0[2], p0[3]); pw.z = pk2(p1[0], p1[1]); pw.w = pk2(p1[2], p1[3]);
    const bf16x8 pb = __builtin_bit_cast(bf16x8, pw);
#pragma unroll
    for (int dt = 0; dt < 4; ++dt) { const LAS unsigned char* vp = Vs + (16 * dt + qi) * VPB + (kb + 4 * g) * 2;
        u32x4 vw; const u32x2 lo = *(const LAS u32x2*)vp, hi = *(const LAS u32x2*)(vp + 32); vw.x = lo.x; vw.y = lo.y; vw.z = hi.x; vw.w = hi.y;
        st.O[dt] = MFMA16(__builtin_bit_cast(bf16x8, vw), pb, st.O[dt]); }
}

__device__ __forceinline__ void attn_step32_lds(RowState& st, const bf16x8 (&Qf)[2], LAS unsigned char* lds, int kb, const f32x4 b0, const f32x4 b1, int lane) {
    attn_step32_ldsp<VS_PITCH * 2>(st, Qf, lds, lds + KS_BYTES, kb, b0, b1, lane);
}

constexpr int FW_KEYS = 384, FW_VPB = (FW_KEYS + 8) * 2, FW_KBYTES = FW_KEYS * KS_PITCH * 2, FW_VBYTES = 64 * FW_VPB;
__device__ __forceinline__ void fox_unit(int h, int qt, unsigned char* ws, float kmaxn, const float* g_fox, LAS unsigned char* lds, int tid, int lane, int wave, int cap = 1 << 30, bf16_t* ydst = nullptr) {
    const int qi = lane & 15, g = lane >> 4;
    const int Q0 = qt * 128, q0 = Q0 + wave * 16, q = q0 + qi;
    const bf16_t* ZR = (const bf16_t*)(ws + WS_ZR); const bf16_t* ZT = (const bf16_t*)(ws + WS_ZT);
    const float* clh = (const float*)(ws + SM_FCL) + (size_t)h * S; const float* tsum = (const float*)(ws + SM_FTS) + h * 256;
    const bf16_t* krow = ZR + ZR_FK + h * 64; const bf16_t* vT = ZT + (size_t)(ZT_FV + h * 64) * ZTP;
    LAS unsigned char* Kw = lds; LAS unsigned char* Vw = lds + FW_KBYTES; LAS float* clw = (LAS float*)(lds + FW_KBYTES + FW_VBYTES);
    const int kw0 = Q0 >= 256 ? Q0 - 256 : 0, nk = Q0 + 128 - kw0;
    __syncthreads();
    for (int c = tid; c < nk * 8; c += 512) { const int row = c >> 3, part = c & 7;
        *(LAS u32x4*)(Kw + row * (KS_PITCH * 2) + part * 16) = *(const u32x4*)(krow + (size_t)(kw0 + row) * ZRW + part * 8); }
    { const int cpr = nk >> 3;
      for (int c = tid; c < 64 * cpr; c += 512) { const int row = c / cpr, part = c - row * cpr;
        *(LAS u32x4*)(Vw + row * FW_VPB + part * 16) = *(const u32x4*)(vT + (size_t)row * ZTP + kw0 + part * 8); } }
    for (int c = tid; c < nk; c += 512) clw[c] = clh[kw0 + c] * LOG2E;
    const bf16_t* qrow = ZR + (size_t)q * ZRW + ZR_FQ + h * 64;
    bf16x8 Qf[2]; Qf[0] = *(const bf16x8*)(qrow + 8 * g); Qf[1] = *(const bf16x8*)(qrow + 32 + 8 * g);
    float qs = 0.f;
#pragma unroll
    for (int k = 0; k < 2; ++k)
#pragma unroll
        for (int e = 0; e < 8; ++e) { const float v = bf2f((unsigned short)Qf[k][e]); qs += v * v; }
    const float qn = sqrtf(grp_sum(qs));
    const float cq = clh[q] * LOG2E;
    RowState st;
#pragma unroll
    for (int dt = 0; dt < 4; ++dt) st.O[dt] = (f32x4){0.f, 0.f, 0.f, 0.f};
    st.m = -INFINITY; st.l = 0.f;
    __syncthreads();
    float dT = 0.f; int ktile = q0 >> 6;
    int kb = q0 & ~31;
    bool more = true;
    for (; kb >= kw0; kb -= 32) {
        const int kt = kb >> 6;
        if (kt != ktile) { dT += tsum[kt] * LOG2E; ktile = kt; }
        const float bq = cq + dT; const int kl = kb - kw0;
        const f32x4 c0 = *(const LAS f32x4*)(clw + kl + 4 * g), c1 = *(const LAS f32x4*)(clw + kl + 16 + 4 * g);
        f32x4 b0, b1;
#pragma unroll
        for (int r = 0; r < 4; ++r) { b0[r] = (kb + 4 * g + r <= q) ? bq - c0[r] : -INFINITY; b1[r] = (kb + 16 + 4 * g + r <= q) ? bq - c1[r] : -INFINITY; }
        attn_step32_ldsp<FW_VPB>(st, Qf, Kw, Vw, kl, b0, b1, lane);
        if (kb == 0) { more = false; break; }
        const float bound = qn * kmaxn * SC2 + (bq - clw[kl]);
        if (__all(bound < st.m - 40.f * LOG2E)) { more = false; break; }
        if (--cap <= 0) { more = false; break; }
    }
    if (more) {
        KVFrag cur, nxt;
        kv_fetch(cur, krow, vT, kb, lane);
        for (; kb >= 0; kb -= 32) {
            if (kb >= 32) kv_fetch(nxt, krow, vT, kb - 32, lane);
            const int kt = kb >> 6;
            if (kt != ktile) { dT += tsum[kt] * LOG2E; ktile = kt; }
            const float bq = cq + dT;
            const f32x4 c0 = *(const f32x4*)(clh + kb + 4 * g), c1 = *(const f32x4*)(clh + kb + 16 + 4 * g);
            f32x4 b0, b1;
#pragma unroll
            for (int r = 0; r < 4; ++r) { b0[r] = bq - c0[r] * LOG2E; b1[r] = bq - c1[r] * LOG2E; }
            attn_compute32(st, Qf, cur, b0, b1);
            if (kb == 0) break;
            const float bound = qn * kmaxn * SC2 + (bq - clh[kb] * LOG2E);
            if (__all(bound < st.m - 40.f * LOG2E)) break;
            cur = nxt;
        }
    }
    st.l = grp_sum(st.l);
    attn_finish(st, g_fox + h * 64, (ydst ? ydst : (bf16_t*)(ws + WS_Y)) + (size_t)q * DM + h * 64, lane);
}

__device__ __forceinline__ void moba_gate_unit(int h, int qt, unsigned char* ws, LAS unsigned char* lds, int tid, int lane, int wave) {
    const int own = qt >> 1;
    unsigned* msel = (unsigned*)(ws + SM_MSEL) + (size_t)h * S;
    int* cntq = (int*)(ws + SM_CNTQ) + (size_t)h * 64 * 128;
    const int tq0 = qt * 128 + wave * 16;
    if (own == 0) { if (lane < 16) msel[tq0 + lane] = 0u; if (tid < 64) cntq[tid * 128 + qt] = 0; return; }
    LAS int* hist = (LAS int*)lds;
    __syncthreads();
    if (tid < 64) hist[tid] = 0;
    __syncthreads();
    const int qi = lane & 15, g = lane >> 4;
    const bf16_t* qrow = (const bf16_t*)(ws + WS_ZR) + (size_t)(tq0 + qi) * ZRW + ZR_BQ + h * 64;
    bf16x8 Qf[2]; Qf[0] = *(const bf16x8*)(qrow + 8 * g); Qf[1] = *(const bf16x8*)(qrow + 32 + 8 * g);
    const float* kmean = (const float*)(ws + SM_KMEAN) + (size_t)h * 64 * 64;
    float v[16];
#pragma unroll
    for (int tile = 0; tile < 4; ++tile) {
        f32x4 acc = {0.f, 0.f, 0.f, 0.f};
#pragma unroll
        for (int ks = 0; ks < 2; ++ks) {
            const float* kp = kmean + (size_t)(16 * tile + qi) * 64 + 32 * ks + 8 * g;
            const f32x4 a0 = *(const f32x4*)kp, a1 = *(const f32x4*)(kp + 4);
            u32x4 hi, lo;
            hi.x = pk2(a0.x, a0.y); hi.y = pk2(a0.z, a0.w); hi.z = pk2(a1.x, a1.y); hi.w = pk2(a1.z, a1.w);
            lo.x = pk2(a0.x - bflo(hi.x), a0.y - bfhi(hi.x)); lo.y = pk2(a0.z - bflo(hi.y), a0.w - bfhi(hi.y));
            lo.z = pk2(a1.x - bflo(hi.z), a1.y - bfhi(hi.z)); lo.w = pk2(a1.z - bflo(hi.w), a1.w - bfhi(hi.w));
            acc = MFMA16(__builtin_bit_cast(bf16x8, hi), Qf[ks], acc);
            acc = MFMA16(__builtin_bit_cast(bf16x8, lo), Qf[ks], acc);
        }
#pragma unroll
        for (int r = 0; r < 4; ++r) v[4 * tile + r] = (16 * tile + 4 * g + r < own) ? acc[r] : -INFINITY;
    }
    const int nv = own < 3 ? own : 3;
    unsigned sel = 0u;
#pragma unroll
    for (int k = 0; k < 3; ++k) {
        float lm = v[0]; int li = 4 * g;
#pragma unroll
        for (int e = 1; e < 16; ++e) { const int jj = 16 * (e >> 2) + 4 * g + (e & 3); if (v[e] > lm) { lm = v[e]; li = jj; } }
        const float gm = grp_max(lm);
        int cand = (lm == gm) ? li : 255;
        cand = min(cand, __shfl_xor(cand, 16)); cand = min(cand, __shfl_xor(cand, 32));
        sel |= (unsigned)cand << (8 * k);
#pragma unroll
        for (int e = 0; e < 16; ++e) { const int jj = 16 * (e >> 2) + 4 * g + (e & 3); if (jj == cand) v[e] = -INFINITY; }
    }
    if (g < nv) { const int j = (int)((sel >> (8 * g)) & 0xff);
        const int pos = __hip_atomic_fetch_add(hist + j, 1, __ATOMIC_RELAXED, __HIP_MEMORY_SCOPE_WORKGROUP);
        ((unsigned short*)(ws + T_QIDX))[(((size_t)h * 64 + j) * 128 + qt) * 128 + pos] = (unsigned short)((wave * 16 + qi) | (g << 7)); }
    if (g == 0) msel[tq0 + qi] = (sel & 0xffffffu) | ((unsigned)nv << 24);
    __syncthreads();
    if (tid < 64) cntq[tid * 128 + qt] = hist[tid];
}

__device__ __forceinline__ void moba_part_unit(int h, int j, int ch, int tot, unsigned char* ws, LAS unsigned char* lds, LAS unsigned char* ltab, int tid, int lane, int wave, int dbg = 0) {
    LAS int* pfx = (LAS int*)(ltab + 2112);
    LAS unsigned* slice = (LAS unsigned*)(ltab + 2640);
    LAS int* wtot = (LAS int*)(ltab + 3664);
    const unsigned* msel = (const unsigned*)(ws + SM_MSEL) + (size_t)h * S;
    const int* cntq = (const int*)(ws + SM_CNTQ) + ((size_t)h * 64 + j) * 128;
    const bf16_t* ZR = (const bf16_t*)(ws + WS_ZR); const bf16_t* ZT = (const bf16_t*)(ws + WS_ZT);
    __syncthreads();
    stage_kv_block(ZR + ZR_BK + h * 64, ZT + (size_t)(ZT_BV + h * 64) * ZTP, j * 256, lds, tid);
    if (wave == 0) {
        int v0 = cntq[lane], v1 = cntq[64 + lane];
#pragma unroll
        for (int o = 1; o < 64; o <<= 1) { const int n0 = __shfl_up(v0, o), n1 = __shfl_up(v1, o); if (lane >= o) { v0 += n0; v1 += n1; } }
        v1 += __shfl(v0, 63);
        if (lane == 0) pfx[0] = 0;
        pfx[1 + lane] = v0; pfx[65 + lane] = v1;
    }
    __syncthreads();
    const int lo_pos = 256 * ch, hi_pos = (lo_pos + 256 < tot) ? lo_pos + 256 : tot;
    if (tid < hi_pos - lo_pos) {
        const int pos = lo_pos + tid;
        int a = 0, b = 127; while (a < b) { const int mid = (a + b + 1) >> 1; if (pfx[mid] <= pos) a = mid; else b = mid - 1; }
        const unsigned w = ((const unsigned short*)(ws + T_QIDX))[(((size_t)h * 64 + j) * 128 + a) * 128 + (pos - pfx[a])];
        slice[tid] = (unsigned)(a * 128 + (w & 127u)) | ((w >> 7) << 14);
    }
    __syncthreads();
    const int n = hi_pos - lo_pos;
    const int qi = lane & 15, g = lane >> 4;
    const int pA = wave * 16, pB = 128 + wave * 16;
    if (pA >= n) return;
    const bool hasB = pB < n;
    const bool vA = pA + qi < n, vB = pB + qi < n;
    const unsigned eA = slice[vA ? pA + qi : n - 1], eB = slice[vB ? pB + qi : n - 1];
    const int tA = eA & 0x3fff, rA = eA >> 14, tB = eB & 0x3fff, rB = eB >> 14;
    const bf16_t* qrA = ZR + (size_t)tA * ZRW + ZR_BQ + h * 64; const bf16_t* qrB = ZR + (size_t)tB * ZRW + ZR_BQ + h * 64;
    bf16x8 QA[2], QB[2]; QA[0] = *(const bf16x8*)(qrA + 8 * g); QA[1] = *(const bf16x8*)(qrA + 32 + 8 * g); QB[0] = *(const bf16x8*)(qrB + 8 * g); QB[1] = *(const bf16x8*)(qrB + 32 + 8 * g);
    RowState sA, sB;
#pragma unroll
    for (int dt = 0; dt < 4; ++dt) { sA.O[dt] = (f32x4){0.f, 0.f, 0.f, 0.f}; sB.O[dt] = (f32x4){0.f, 0.f, 0.f, 0.f}; }
    sA.m = -INFINITY; sA.l = 0.f; sB.m = -INFINITY; sB.l = 0.f;
    const f32x4 z = {0.f, 0.f, 0.f, 0.f};
    if (dbg & 1) { sA.l = 1.f; sB.l = 1.f; sA.m = 0.f; sB.m = 0.f; }
    else if (hasB) {
#pragma unroll 4
        for (int kb = 0; kb < 256; kb += 32) { attn_step32_lds(sA, QA, lds, kb, z, z, lane); attn_step32_lds(sB, QB, lds, kb, z, z, lane); } }
    else {
#pragma unroll 4
        for (int kb = 0; kb < 256; kb += 32) attn_step32_lds(sA, QA, lds, kb, z, z, lane); }
    if (dbg & 2) return;
    sA.l = grp_sum(sA.l);
    if (vA) {
        const float inv = 1.f / sA.l;
        bf16_t* po = (bf16_t*)(ws + T_MPO) + (((size_t)h * S + tA) * 3 + rA) * 64;
#pragma unroll
        for (int dt = 0; dt < 4; ++dt) { const f32x4 o = sA.O[dt] * inv; u32x2 w; w.x = pk2(o.x, o.y); w.y = pk2(o.z, o.w); *(u32x2*)(po + 16 * dt + 4 * g) = w; }
        if (g == 0) { float* pm = (float*)(ws + T_MPML) + (((size_t)h * S + tA) * 3 + rA) * 2; pm[0] = sA.m; pm[1] = sA.l; }
    }
    if (hasB) {
        sB.l = grp_sum(sB.l);
        if (vB) {
            const float inv = 1.f / sB.l;
            bf16_t* po = (bf16_t*)(ws + T_MPO) + (((size_t)h * S + tB) * 3 + rB) * 64;
#pragma unroll
            for (int dt = 0; dt < 4; ++dt) { const f32x4 o = sB.O[dt] * inv; u32x2 w; w.x = pk2(o.x, o.y); w.y = pk2(o.z, o.w); *(u32x2*)(po + 16 * dt + 4 * g) = w; }
            if (g == 0) { float* pm = (float*)(ws + T_MPML) + (((size_t)h * S + tB) * 3 + rB) * 2; pm[0] = sB.m; pm[1] = sB.l; }
        }
    }
}

__device__ __forceinline__ void moba_own_unit(int h, int ob, unsigned char* ws, const float* g_moba, LAS unsigned char* lds, int tid, int lane, int wave) {
    const int qi = lane & 15, g = lane >> 4;
    const bf16_t* ZR = (const bf16_t*)(ws + WS_ZR); const bf16_t* ZT = (const bf16_t*)(ws + WS_ZT);
    __syncthreads();
    stage_kv_block(ZR + ZR_BK + h * 64, ZT + (size_t)(ZT_BV + h * 64) * ZTP, ob * 256, lds, tid);
    __syncthreads();
    const int nv = ob < 3 ? ob : 3;
    for (int pass = 0; pass < 2; ++pass) {
        const int ql0 = pass * 128 + wave * 16, ql = ql0 + qi, q = ob * 256 + ql;
        const bf16_t* qrow = ZR + (size_t)q * ZRW + ZR_BQ + h * 64;
        bf16x8 Qf[2]; Qf[0] = *(const bf16x8*)(qrow + 8 * g); Qf[1] = *(const bf16x8*)(qrow + 32 + 8 * g);
        RowState st;
#pragma unroll
        for (int dt = 0; dt < 4; ++dt) st.O[dt] = (f32x4){0.f, 0.f, 0.f, 0.f};
        st.m = -INFINITY; st.l = 0.f;
        for (int kb = ql0 & ~31; kb >= 0; kb -= 32) {
            f32x4 b0, b1;
#pragma unroll
            for (int r = 0; r < 4; ++r) { b0[r] = (kb + 4 * g + r <= ql) ? 0.f : -INFINITY; b1[r] = (kb + 16 + 4 * g + r <= ql) ? 0.f : -INFINITY; }
            attn_step32_lds(st, Qf, lds, kb, b0, b1, lane);
        }
        st.l = grp_sum(st.l);
        for (int rk = 0; rk < nv; ++rk) {
            const float* pm = (const float*)(ws + T_MPML) + (((size_t)h * S + q) * 3 + rk) * 2;
            const float mk = pm[0], lk = pm[1];
            const float M = fmaxf(st.m, mk);
            const float a = __builtin_amdgcn_exp2f(st.m - M), b = lk * __builtin_amdgcn_exp2f(mk - M);
            const bf16_t* po = (const bf16_t*)(ws + T_MPO) + (((size_t)h * S + q) * 3 + rk) * 64;
#pragma unroll
            for (int dt = 0; dt < 4; ++dt) { const u32x2 w = *(const u32x2*)(po + 16 * dt + 4 * g);
                const f32x4 ok = {bflo(w.x), bfhi(w.x), bflo(w.y), bfhi(w.y)};
                st.O[dt] = st.O[dt] * a + ok * b; }
            st.l = st.l * a + b; st.m = M;
        }
        attn_finish(st, g_moba + h * 64, (bf16_t*)(ws + WS_Y) + (size_t)q * DM + 768 + h * 64, lane);
    }
}
constexpr int KT_PITCH = 136;

__device__ __forceinline__ void mlstm_local_unit(int h, int c, unsigned char* ws, const float* conv_w_l, LAS unsigned char* lds, int tid, int lane, int wave) {
    const int t0 = c * 128;
    LAS float* sws = (LAS float*)lds;
    LAS bf16_t* kT = (LAS bf16_t*)(lds + 1024);
    __syncthreads();
    if (wave == 0) {
        const float* mlf = (const float*)(ws + SM_MLF) + (size_t)h * S + t0; const float* mli = (const float*)(ws + SM_MLI) + (size_t)h * S + t0;
        float v0 = mlf[lane], v1 = mlf[64 + lane];
#pragma unroll
        for (int o = 1; o < 64; o <<= 1) { const float n0 = __shfl_up(v0, o), n1 = __shfl_up(v1, o); if (lane >= o) { v0 += n0; v1 += n1; } }
        const float tot0 = __shfl(v0, 63); v1 += tot0;
        const float blast = __shfl(v1, 63);
        const float li0 = mli[lane], li1 = mli[64 + lane];
        const float g0 = blast - v0 + li0, g1 = blast - v1 + li1;
        const float mloc = wave_max(fmaxf(g0, g1));
        sws[lane] = __expf(g0 - mloc); sws[64 + lane] = __expf(g1 - mloc);
        const float a0 = li0 - v0, a1 = li1 - v1;
        float p0 = a0, p1 = a1;
#pragma unroll
        for (int o = 1; o < 64; o <<= 1) { const float n0 = __shfl_up(p0, o), n1 = __shfl_up(p1, o); if (lane >= o) { p0 = fmaxf(p0, n0); p1 = fmaxf(p1, n1); } }
        p1 = fmaxf(p1, __shfl(p0, 63));
        float* mb = (float*)(ws + SM_MB) + (size_t)h * S + t0; float* ma = (float*)(ws + SM_MA) + (size_t)h * S + t0; float* mpx = (float*)(ws + SM_MPX) + (size_t)h * S + t0;
        mb[lane] = v0; mb[64 + lane] = v1; ma[lane] = a0; ma[64 + lane] = a1; mpx[lane] = p0; mpx[64 + lane] = p1;
        if (lane == 0) { float* sc = (float*)(ws + SM_MLSC); sc[h * 128 + c] = blast; sc[512 + h * 128 + c] = mloc; }
    }
    __syncthreads();
    {
        const bf16_t* ZR = (const bf16_t*)(ws + WS_ZR);
        bf16_t* QC = (bf16_t*)(ws + T_QC); bf16_t* KC = (bf16_t*)(ws + T_KC);
        const int r = tid & 31, which = r >> 4, cg = r & 15, tb = tid >> 5;
        const int ch = h * 128 + 8 * cg;
        float cw[4][8];
#pragma unroll
        for (int j = 0; j < 4; ++j) { const f32x4 c0 = *(const f32x4*)(conv_w_l + (size_t)j * 1024 + which * 512 + ch), c1 = *(const f32x4*)(conv_w_l + (size_t)j * 1024 + which * 512 + ch + 4);
            cw[j][0] = c0.x; cw[j][1] = c0.y; cw[j][2] = c0.z; cw[j][3] = c0.w; cw[j][4] = c1.x; cw[j][5] = c1.y; cw[j][6] = c1.z; cw[j][7] = c1.w; }
        const bf16_t* src = ZR + (which ? ZR_MK : ZR_MQ) + ch;
        u32x4 rw[11];
#pragma unroll
        for (int q = 0; q < 11; ++q) { const int tt = t0 + 8 * tb - 3 + q; rw[q] = (tt >= 0) ? *(const u32x4*)(src + (size_t)tt * ZRW) : (u32x4){0u, 0u, 0u, 0u}; }
        const float sc = which ? 0.08838834764831845f : 1.f;
#pragma unroll
        for (int q = 0; q < 8; ++q) {
            const int sl = 8 * tb + q;
            float acc[8];
#pragma unroll
            for (int e = 0; e < 8; ++e) acc[e] = 0.f;
#pragma unroll
            for (int j = 0; j < 4; ++j) { const u32x4 w = rw[q + j];
                acc[0] += bflo(w.x) * cw[j][0]; acc[1] += bfhi(w.x) * cw[j][1]; acc[2] += bflo(w.y) * cw[j][2]; acc[3] += bfhi(w.y) * cw[j][3];
                acc[4] += bflo(w.z) * cw[j][4]; acc[5] += bfhi(w.z) * cw[j][5]; acc[6] += bflo(w.w) * cw[j][6]; acc[7] += bfhi(w.w) * cw[j][7]; }
#pragma unroll
            for (int e = 0; e < 8; ++e) acc[e] = siluf(acc[e]) * sc;
            u32x4 o; o.x = pk2(acc[0], acc[1]); o.y = pk2(acc[2], acc[3]); o.z = pk2(acc[4], acc[5]); o.w = pk2(acc[6], acc[7]);
            *(u32x4*)((which ? KC : QC) + (size_t)(t0 + sl) * 512 + ch) = o;
            if (which) { const float w = sws[sl];
#pragma unroll
                for (int e = 0; e < 8; ++e) kT[(8 * cg + e) * KT_PITCH + sl] = (bf16_t)f2bf(acc[e] * w); }
        }
    }
    __syncthreads();
    {
        const int i = lane & 15, g = lane >> 4;
        const bf16_t* vT = (const bf16_t*)(ws + WS_ZT) + (size_t)(ZT_MV + h * 128 + 16 * wave + i) * ZTP + t0;
        f32x4 acc[8];
#pragma unroll
        for (int n = 0; n < 8; ++n) acc[n] = (f32x4){0.f, 0.f, 0.f, 0.f};
#pragma unroll
        for (int ks = 0; ks < 4; ++ks) {
            const bf16x8 a = *(const bf16x8*)(vT + 32 * ks + 8 * g);
#pragma unroll
            for (int n = 0; n < 8; ++n) { const bf16x8 b = *(const LAS bf16x8*)(kT + (16 * n + i) * KT_PITCH + 32 * ks + 8 * g); acc[n] = MFMA16(a, b, acc[n]); }
        }
        float* U = (float*)(ws + T_U) + ((size_t)(h * 128 + c) * 128) * 128;
#pragma unroll
        for (int n = 0; n < 8; ++n)
#pragma unroll
            for (int r = 0; r < 4; ++r) U[(size_t)(16 * wave + 4 * g + r) * 128 + 16 * n + i] = acc[n][r];
    }
    {
        const int i = lane & 15, g = lane >> 4;
        const bf16x8 ones = {(short)0x3f80, (short)0x3f80, (short)0x3f80, (short)0x3f80, (short)0x3f80, (short)0x3f80, (short)0x3f80, (short)0x3f80};
        f32x4 acc = {0.f, 0.f, 0.f, 0.f};
#pragma unroll
        for (int ks = 0; ks < 4; ++ks) { const bf16x8 b = *(const LAS bf16x8*)(kT + (16 * wave + i) * KT_PITCH + 32 * ks + 8 * g); acc = MFMA16(ones, b, acc); }
        if (g == 0) ((float*)(ws + SM_NLOC))[(size_t)(h * 128 + c) * 128 + 16 * wave + i] = acc[0];
    }
}

__device__ __forceinline__ void mlstm_scan(unsigned char* ws, LAS unsigned char* lds, int tid, int lane, int wave, int bid) {
    if (bid >= 256) return;
    const int h = bid >> 6;
    LAS float* dec = (LAS float*)lds; LAS float* scl = dec + 128;
    __syncthreads();
    if (wave == 0) {
        const float* sc = (const float*)(ws + SM_MLSC);
        const float bl0 = sc[h * 128 + lane], bl1 = sc[h * 128 + 64 + lane], ml0 = sc[512 + h * 128 + lane], ml1 = sc[512 + h * 128 + 64 + lane];
        float m = 0.f, mA = 0.f, mB = 0.f;
#pragma unroll 8
        for (int c = 0; c < 64; ++c) { if (lane == c) mA = m; m = fmaxf(__shfl(bl0, c) + m, __shfl(ml0, c)); }
#pragma unroll 8
        for (int c = 0; c < 64; ++c) { if (lane == c) mB = m; m = fmaxf(__shfl(bl1, c) + m, __shfl(ml1, c)); }
        const float mA1 = fmaxf(bl0 + mA, ml0), mB1 = fmaxf(bl1 + mB, ml1);
        dec[lane] = __expf(bl0 + mA - mA1); scl[lane] = __expf(ml0 - mA1); dec[64 + lane] = __expf(bl1 + mB - mB1); scl[64 + lane] = __expf(ml1 - mB1);
        if ((bid & 63) == 0) { float* mst = (float*)(ws + SM_MLSC) + 1024 + h * 128; mst[lane] = mA; mst[64 + lane] = mB; }
    }
    __syncthreads();
    if (tid < 256) {
        const int el = (bid & 63) * 256 + tid;
        const float* U = (const float*)(ws + T_U) + (size_t)h * 128 * 16384 + el;
        bf16_t* CS = (bf16_t*)(ws + T_CST) + (size_t)h * 128 * 16384 + el;
        float C = 0.f;
        for (int c0 = 0; c0 < 128; c0 += 32) { float u[32];
#pragma unroll
            for (int q = 0; q < 32; ++q) u[q] = U[(size_t)(c0 + q) * 16384];
#pragma unroll
            for (int q = 0; q < 32; ++q) { CS[(size_t)(c0 + q) * 16384] = (bf16_t)f2bf(C); C = dec[c0 + q] * C + scl[c0 + q] * u[q]; } }
    } else if (tid < 258) {
        const int el = (bid & 63) * 2 + (tid - 256);
        const float* NL_ = (const float*)(ws + SM_NLOC) + (size_t)h * 128 * 128 + el;
        float* NS = (float*)(ws + SM_NST) + (size_t)h * 128 * 128 + el;
        float n = 0.f;
        for (int c0 = 0; c0 < 128; c0 += 32) { float u[32];
#pragma unroll
            for (int q = 0; q < 32; ++q) u[q] = NL_[(c0 + q) * 128];
#pragma unroll
            for (int q = 0; q < 32; ++q) { NS[(c0 + q) * 128] = n; n = dec[c0 + q] * n + scl[c0 + q] * u[q]; } }
    }
}

constexpr int ML_PITCHB = 272, ML_MAT = 128 * ML_PITCHB;
__device__ __forceinline__ void mlstm_out_unit(int h, int c, unsigned char* ws, const float* g_mlstm, LAS unsigned char* lds, int tid, int lane, int wave) {
    const int i = lane & 15, g = lane >> 4;
    const int t0 = c * 128, tl = 16 * wave + i, t = t0 + tl;
    const bf16_t* QC = (const bf16_t*)(ws + T_QC); const bf16_t* KC = (const bf16_t*)(ws + T_KC);
    const bf16_t* ZT = (const bf16_t*)(ws + WS_ZT); const bf16_t* ZR = (const bf16_t*)(ws + WS_ZR);
    LAS unsigned char* Cs = lds; LAS unsigned char* Ks = lds + ML_MAT; LAS unsigned char* Vs = lds + 2 * ML_MAT;
    __syncthreads();
    {
        const bf16_t* CS = (const bf16_t*)(ws + T_CST) + ((size_t)(h * 128 + c) * 128) * 128;
        const bf16_t* kc = KC + (size_t)t0 * 512 + h * 128;
        const bf16_t* vt = ZT + (size_t)(ZT_MV + h * 128) * ZTP + t0;
#pragma unroll
        for (int q = 0; q < 4; ++q) { const int cc = tid + 512 * q; const int row = cc >> 4, part = cc & 15;
            const u32x4 a = *(const u32x4*)(CS + (size_t)row * 128 + part * 8);
            const u32x4 b = *(const u32x4*)(kc + (size_t)row * 512 + part * 8);
            const u32x4 d = *(const u32x4*)(vt + (size_t)row * ZTP + part * 8);
            *(LAS u32x4*)(Cs + row * ML_PITCHB + part * 16) = a; *(LAS u32x4*)(Ks + row * ML_PITCHB + part * 16) = b; *(LAS u32x4*)(Vs + row * ML_PITCHB + part * 16) = d; }
    }
    const float* ma = (const float*)(ws + SM_MA) + (size_t)h * S + t0;
    const float mc = ((const float*)(ws + SM_MLSC))[1024 + h * 128 + c];
    const float bt = ((const float*)(ws + SM_MB))[(size_t)h * S + t];
    const float Mx = fmaxf(mc, ((const float*)(ws + SM_MPX))[(size_t)h * S + t]);
    const float w_inter = __expf(mc - Mx);
    bf16x8 Qf[4];
#pragma unroll
    for (int ks = 0; ks < 4; ++ks) Qf[ks] = *(const bf16x8*)(QC + (size_t)t * 512 + h * 128 + 32 * ks + 8 * g);
    float qn = 0.f;
    {
        const float* ns = (const float*)(ws + SM_NST) + (size_t)(h * 128 + c) * 128;
#pragma unroll
        for (int ks = 0; ks < 4; ++ks) { const f32x4 n0 = *(const f32x4*)(ns + 32 * ks + 8 * g), n1 = *(const f32x4*)(ns + 32 * ks + 8 * g + 4);
            qn += bf2f((unsigned short)Qf[ks][0]) * n0.x + bf2f((unsigned short)Qf[ks][1]) * n0.y + bf2f((unsigned short)Qf[ks][2]) * n0.z + bf2f((unsigned short)Qf[ks][3]) * n0.w
                + bf2f((unsigned short)Qf[ks][4]) * n1.x + bf2f((unsigned short)Qf[ks][5]) * n1.y + bf2f((unsigned short)Qf[ks][6]) * n1.z + bf2f((unsigned short)Qf[ks][7]) * n1.w; }
        qn = grp_sum(qn);
    }
    u32x2 mow[8];
    {
        const bf16_t* mo = ZR + (size_t)t * ZRW + ZR_MO + h * 128;
#pragma unroll
        for (int dt = 0; dt < 8; ++dt) mow[dt] = *(const u32x2*)(mo + 16 * dt + 4 * g);
    }
    __syncthreads();
    f32x4 On[8];
#pragma unroll
    for (int dt = 0; dt < 8; ++dt) On[dt] = (f32x4){0.f, 0.f, 0.f, 0.f};
#pragma unroll
    for (int ks = 0; ks < 4; ++ks)
#pragma unroll
        for (int dt = 0; dt < 8; ++dt) { const bf16x8 a = *(const LAS bf16x8*)(Cs + (16 * dt + i) * ML_PITCHB + (32 * ks + 8 * g) * 2); On[dt] = MFMA16(a, Qf[ks], On[dt]); }
#pragma unroll
    for (int dt = 0; dt < 8; ++dt) On[dt] = On[dt] * w_inter;
    float den = 0.f;
    for (int sp = 0; sp <= (wave >> 1); ++sp) {
        f32x4 s0 = {0.f, 0.f, 0.f, 0.f}, s1 = {0.f, 0.f, 0.f, 0.f};
        const LAS unsigned char* k0p = Ks + (32 * sp + i) * ML_PITCHB + 16 * g;
        const LAS unsigned char* k1p = k0p + 16 * ML_PITCHB;
#pragma unroll
        for (int ks = 0; ks < 4; ++ks) { s0 = MFMA16(*(const LAS bf16x8*)(k0p + 64 * ks), Qf[ks], s0); s1 = MFMA16(*(const LAS bf16x8*)(k1p + 64 * ks), Qf[ks], s1); }
        const f32x4 a0 = *(const f32x4*)(ma + 32 * sp + 4 * g), a1 = *(const f32x4*)(ma + 32 * sp + 16 + 4 * g);
        float p0[4], p1[4];
#pragma unroll
        for (int r = 0; r < 4; ++r) {
            const int sl0 = 32 * sp + 4 * g + r, sl1 = sl0 + 16;
            p0[r] = (sl0 <= tl) ? s0[r] * __expf(a0[r] - Mx) : 0.f;
            p1[r] = (sl1 <= tl) ? s1[r] * __expf(a1[r] - Mx) : 0.f;
            den += p0[r] + p1[r];
        }
        u32x4 pw; pw.x = pk2(p0[0], p0[1]); pw.y = pk2(p0[2], p0[3]); pw.z = pk2(p1[0], p1[1]); pw.w = pk2(p1[2], p1[3]);
        const bf16x8 pb = __builtin_bit_cast(bf16x8, pw);
#pragma unroll
        for (int dt = 0; dt < 8; ++dt) { const LAS unsigned char* vp = Vs + (16 * dt + i) * ML_PITCHB + (32 * sp + 4 * g) * 2;
            u32x4 vw; const u32x2 lo = *(const LAS u32x2*)vp, hi = *(const LAS u32x2*)(vp + 32); vw.x = lo.x; vw.y = lo.y; vw.z = hi.x; vw.w = hi.y;
            On[dt] = MFMA16(__builtin_bit_cast(bf16x8, vw), pb, On[dt]); }
    }
    den = grp_sum(den) + w_inter * qn;
    const float dn = fmaxf(fabsf(den), __expf(-(bt + Mx)));
    const float inv = 1.f / dn;
    float ss = 0.f;
#pragma unroll
    for (int dt = 0; dt < 8; ++dt) { const u32x2 w = mow[dt];
        const f32x4 og = {sigmoidf(bflo(w.x)), sigmoidf(bfhi(w.x)), sigmoidf(bflo(w.y)), sigmoidf(bfhi(w.y))};
        On[dt] = On[dt] * inv * og;
        ss += (On[dt].x * On[dt].x + On[dt].y * On[dt].y) + (On[dt].z * On[dt].z + On[dt].w * On[dt].w); }
    ss = grp_sum(ss);
    const float rs = rsqrtf(ss * (1.f / 128.f) + EPS);
    bf16_t* yrow = (bf16_t*)(ws + WS_Y) + (size_t)t * DM + 256 + h * 128;
#pragma unroll
    for (int dt = 0; dt < 8; ++dt) { const f32x4 gg = *(const f32x4*)(g_mlstm + h * 128 + 16 * dt + 4 * g); const f32x4 o = On[dt] * rs * gg;
        u32x2 w; w.x = pk2(o.x, o.y); w.y = pk2(o.z, o.w); *(u32x2*)(yrow + 16 * dt + 4 * g) = w; }
}
struct SchedDenseIn {
    const char* X; const char* W; int G, c;
    __device__ __forceinline__ bool next(int i, pg8::GUnit& u) const {
        constexpr int nM = 64, nN = 14, nwg = nM * nN;
        const long L = (long)i * G + c; if (L >= nwg) return false;
        int wgid = (int)L; { const int q = nwg / pg8::NXCD, r = nwg % pg8::NXCD, xcd = wgid % pg8::NXCD, off = wgid / pg8::NXCD; wgid = (xcd < r ? xcd * (q + 1) : r * (q + 1) + (xcd - r) * q) + off; }
        const int nig = pg8::WGM * nN, gid = wgid / nig, fm = gid * pg8::WGM, gsz = (nM - fm) < pg8::WGM ? (nM - fm) : pg8::WGM;
        const int pm = fm + ((wgid % nig) % gsz), pn = (wgid % nig) / gsz;
        u.pm = pm; u.pn = pn; u.x0 = 0;
        if (pn < 10) { u.A = X + (size_t)pm * 256 * DM * 2; u.B = W + (size_t)pn * 256 * DM * 2; }
        else { u.A = W + (size_t)pn * 256 * DM * 2; u.B = X + (size_t)pm * 256 * DM * 2; }
        return true;
    }
};
struct EpiZ {
    bf16_t* ZR; bf16_t* ZT; int nostore;
    __device__ __forceinline__ void operator()(const f32x4 (&acc)[2][2][4][2], const pg8::GUnit& u, int wr, int wc, int fr, int fq) const {
        if (nostore) return;
        const bool sw = u.pn >= 10;
        bf16_t* base; size_t pitch;
        if (!sw) { base = ZR + (size_t)(256 * u.pm) * ZRW + 256 * u.pn; pitch = ZRW; }
        else { base = ZT + (size_t)(256 * (u.pn - 10)) * ZTP + 256 * u.pm; pitch = ZTP; }
#pragma unroll
        for (int ai = 0; ai < 2; ++ai)
#pragma unroll
            for (int m = 0; m < 4; ++m) { bf16_t* rowp = base + (size_t)(ai * 128 + wr * 64 + m * 16 + fr) * pitch + wc * 32 + 8 * fq;
#pragma unroll
                for (int bj = 0; bj < 2; ++bj) { const f32x4 v0 = acc[ai][bj][m][0], v1 = acc[ai][bj][m][1];
                    u32x4 w; w.x = pk2(v0[0], v0[1]); w.y = pk2(v0[2], v0[3]); w.z = pk2(v1[0], v1[1]); w.w = pk2(v1[2], v1[3]);
                    *(u32x4*)(rowp + bj * 128) = w; } }
    }
};
struct SchedDense4 {
    const char* X; const char* W; int K; int G, c;
    __device__ __forceinline__ bool next(int i, pg8::GUnit& u) const {
        const int L = i * G + c; if (L >= 256) return false;
        const int pm = L >> 2, pn = L & 3;
        u.pm = pm; u.pn = pn; u.x0 = 0;
        u.A = X + (size_t)pm * 256 * K * 2; u.B = W + (size_t)pn * 256 * K * 2;
        return true;
    }
};
template <bool XBF16> struct EpiPre1 {
    const void* xin; bf16_t* out;
    __device__ __forceinline__ void operator()(const f32x4 (&acc)[2][2][4][2], const pg8::GUnit& u, int wr, int wc, int fr, int fq) const {
#pragma unroll
        for (int ai = 0; ai < 2; ++ai)
#pragma unroll
            for (int m = 0; m < 4; ++m) { const size_t off = (size_t)(256 * u.pm + ai * 128 + wr * 64 + m * 16 + fr) * DM + 256 * u.pn + wc * 32 + 8 * fq;
#pragma unroll
                for (int bj = 0; bj < 2; ++bj) {
                    f32x4 x0, x1;
                    if (XBF16) { const u32x4 xw = *(const u32x4*)((const bf16_t*)xin + off + bj * 128); x0 = (f32x4){bflo(xw.x), bfhi(xw.x), bflo(xw.y), bfhi(xw.y)}; x1 = (f32x4){bflo(xw.z), bfhi(xw.z), bflo(xw.w), bfhi(xw.w)}; }
                    else { x0 = *(const f32x4*)((const float*)xin + off + bj * 128); x1 = *(const f32x4*)((const float*)xin + off + bj * 128 + 4); }
                    const f32x4 v0 = x0 * ALPHA + acc[ai][bj][m][0], v1 = x1 * ALPHA + acc[ai][bj][m][1];
                    u32x4 w; w.x = pk2(v0[0], v0[1]); w.y = pk2(v0[2], v0[3]); w.z = pk2(v1[0], v1[1]); w.w = pk2(v1[2], v1[3]);
                    *(u32x4*)(out + off + bj * 128) = w; } }
    }
};
__device__ __forceinline__ void moe_table(const unsigned* ecnt, LAS int* tab, int tid) {
    __syncthreads();
    if (tid < 64) {
        const int e = tid; const unsigned cnt_e = e < NE ? xb_ld((unsigned*)ecnt + e) : 0u; const int n = (int)((cnt_e + 255u) >> 8);
        if (e < NE) tab[216 + e] = (int)cnt_e;
        int inc = n;
#pragma unroll
        for (int o = 1; o < 32; o <<= 1) { const int v = __shfl_up(inc, o); if (e >= o) inc += v; }
        const int exc = inc - n;
        if (e < NE) { tab[1 + e] = exc; for (int j = 0; j < n; ++j) tab[40 + exc + j] = e; }
        if (e == NE - 1) { tab[1 + NE] = inc; tab[0] = inc; }
    }
    __syncthreads();
}
struct SchedMoE {
    const char* Abase; const char* Wbase; const LAS int* tab; size_t wstride; int K; int G, c; int maxr; const int* elist; unsigned* guc; unsigned* tmo;
    __device__ __forceinline__ int unit_of(int i, int U) const {
        if (elist) return i * G + c;
        const int r = U % G; if (r == 0) return i * G + c;
        const int nl = G - r;
        if (c >= r) return i < 2 ? i * nl + (c - r) : 2 * nl + (i - 2) * G + c;
        return 2 * nl + i * G + c;
    }
    __device__ __forceinline__ void a_ready(const pg8::GUnit& u, int wid, int lane) const {
        if (wid == 0) {
            unsigned polls = 0;
            while ((unsigned)__builtin_amdgcn_readfirstlane(__hip_atomic_load(guc + 16 * u.pm, __ATOMIC_RELAXED, __HIP_MEMORY_SCOPE_AGENT)) < 32u) {
                if ((++polls & 255u) == 0u) { if (__builtin_amdgcn_readfirstlane(__hip_atomic_load(tmo, __ATOMIC_RELAXED, __HIP_MEMORY_SCOPE_AGENT)) != 0u) break;
                    if (polls > (1u << 22)) { if (lane == 0) atomicAdd(tmo, 1u); break; } }
                __builtin_amdgcn_s_sleep(2); }
            asm volatile("s_waitcnt vmcnt(0)" ::: "memory");
        }
        asm volatile("" ::: "memory"); __builtin_amdgcn_s_barrier(); asm volatile("" ::: "memory");
    }
    __device__ __forceinline__ bool next(int i, pg8::GUnit& u) const {
        if (i >= maxr) return false;
        const int T = __builtin_amdgcn_readfirstlane(tab[0]); const int L = unit_of(i, 4 * T); if (L >= 4 * T) return false;
        const int tile = L >> 2, pn = L & 3; const int e = __builtin_amdgcn_readfirstlane(tab[40 + tile]);
        u.pm = tile; u.pn = pn; u.x0 = e;
        u.B = Wbase + (size_t)e * wstride + (size_t)pn * 256 * K * 2;
        if (elist) { u.A = Abase; u.list = elist + (size_t)e * S; u.l0 = 256 * (tile - __builtin_amdgcn_readfirstlane(tab[1 + e])); u.nl = __builtin_amdgcn_readfirstlane(tab[216 + e]); }
        else { u.A = Abase + (size_t)tile * 256 * K * 2; u.list = nullptr; u.l0 = 0; u.nl = 0; }
        return true;
    }
};
struct EpiGU {
    bf16_t* H; unsigned* guc;
    __device__ __forceinline__ void operator()(const f32x4 (&acc)[2][2][4][2], const pg8::GUnit& u, int wr, int wc, int fr, int fq) const {
#pragma unroll
        for (int ai = 0; ai < 2; ++ai)
#pragma unroll
            for (int m = 0; m < 4; ++m) { bf16_t* rowp = H + (size_t)(256 * u.pm + ai * 128 + wr * 64 + m * 16 + fr) * DE + (256 * u.pn + wc * 32 + 8 * fq) / 2;
#pragma unroll
                for (int bj = 0; bj < 2; ++bj) { const f32x4 gt = acc[ai][bj][m][0], up = acc[ai][bj][m][1];
                    const unsigned long long w = (unsigned long long)pk2(siluf(gt[0]) * up[0], siluf(gt[1]) * up[1]) | ((unsigned long long)pk2(siluf(gt[2]) * up[2], siluf(gt[3]) * up[3]) << 32);
                    __hip_atomic_store((unsigned long long*)(rowp + bj * 64), w, __ATOMIC_RELAXED, __HIP_MEMORY_SCOPE_AGENT); } }
        asm volatile("s_waitcnt vmcnt(0)" ::: "memory");
        if (fr == 0 && fq == 0) (void)__hip_atomic_fetch_add(guc + 16 * u.pm, 1u, __ATOMIC_RELAXED, __HIP_MEMORY_SCOPE_AGENT);
    }
};
struct EpiY {
    bf16_t* Y;
    __device__ __forceinline__ void operator()(const f32x4 (&acc)[2][2][4][2], const pg8::GUnit& u, int wr, int wc, int fr, int fq) const {
#pragma unroll
        for (int ai = 0; ai < 2; ++ai)
#pragma unroll
            for (int m = 0; m < 4; ++m) { bf16_t* rowp = Y + (size_t)(256 * u.pm + ai * 128 + wr * 64 + m * 16 + fr) * DM + 256 * u.pn + wc * 32 + 8 * fq;
#pragma unroll
                for (int bj = 0; bj < 2; ++bj) { const f32x4 v0 = acc[ai][bj][m][0], v1 = acc[ai][bj][m][1];
                    u32x4 w; w.x = pk2(v0[0], v0[1]); w.y = pk2(v0[2], v0[3]); w.z = pk2(v1[0], v1[1]); w.w = pk2(v1[2], v1[3]);
                    *(u32x4*)(rowp + bj * 128) = w; } }
    }
};

constexpr int R6_WG = 0, R6_WE = 16384, R6_G = 16384 + 131072, R6_B = R6_G + 4096, R6_END = R6_B + 4096;
static_assert(R6_END <= LDS_TAB, "router weights fit under the table region");
__device__ __forceinline__ void ln1_router_load(const float* g1, const float* b1, const float* w_grp, const float* w_er, LAS unsigned char* lds, int tid) {
    LAS float* wgT = (LAS float*)(lds + R6_WG); LAS float* weT = (LAS float*)(lds + R6_WE); LAS float* gg = (LAS float*)(lds + R6_G); LAS float* bb = (LAS float*)(lds + R6_B);
    for (int i = tid; i < 1024; i += 512) { const f32x4 w = *(const f32x4*)(w_grp + 4 * i); wgT[i] = w.x; wgT[1024 + i] = w.y; wgT[2048 + i] = w.z; wgT[3072 + i] = w.w; gg[i] = g1[i]; bb[i] = b1[i]; }
    for (int i = tid; i < 1024 * 8; i += 512) { const int k = i >> 3, c4 = (i & 7) * 4; const f32x4 w = *(const f32x4*)(w_er + (size_t)k * 32 + c4);
        weT[(c4 + 0) * 1024 + k] = w.x; weT[(c4 + 1) * 1024 + k] = w.y; weT[(c4 + 2) * 1024 + k] = w.z; weT[(c4 + 3) * 1024 + k] = w.w; }
}
__device__ __forceinline__ void ln1_router_row(int t, unsigned char* ws, const LAS unsigned char* lds, const float* b_grp, const float* b_er, unsigned* ecnt, int lane) {
    const LAS float* wgT = (const LAS float*)(lds + R6_WG); const LAS float* weT = (const LAS float*)(lds + R6_WE); const LAS float* gg = (const LAS float*)(lds + R6_G); const LAS float* bb = (const LAS float*)(lds + R6_B);
    const bf16_t* p1 = (const bf16_t*)(ws + WS_ZT) + (size_t)t * DM;
    f32x4 v[4];
#pragma unroll
    for (int j = 0; j < 4; ++j) { const u32x2 w = *(const u32x2*)(p1 + 256 * j + 4 * lane); v[j] = (f32x4){bflo(w.x), bfhi(w.x), bflo(w.y), bfhi(w.y)}; }
    {
        float s = 0.f;
#pragma unroll
        for (int j = 0; j < 4; ++j) s += (v[j].x + v[j].y) + (v[j].z + v[j].w);
        const float mean = wave_sum(s) * (1.f / DM); float s2 = 0.f;
#pragma unroll
        for (int j = 0; j < 4; ++j) { v[j] = v[j] - mean; s2 += (v[j].x * v[j].x + v[j].y * v[j].y) + (v[j].z * v[j].z + v[j].w * v[j].w); }
        const float rstd = rsqrtf(wave_sum(s2) * (1.f / DM) + EPS);
#pragma unroll
        for (int j = 0; j < 4; ++j) { const f32x4 g = *(const LAS f32x4*)(gg + 256 * j + 4 * lane), b = *(const LAS f32x4*)(bb + 256 * j + 4 * lane); v[j] = v[j] * rstd * g + b; }
    }
    store_row_bf16(v, (bf16_t*)(ws + WS_ACTB) + (size_t)t * DM, lane);
    float gl[4];
#pragma unroll
    for (int q = 0; q < 4; ++q) { float s = 0.f;
#pragma unroll
        for (int j = 0; j < 4; ++j) { const f32x4 w = *(const LAS f32x4*)(wgT + q * 1024 + 256 * j + 4 * lane); s += (v[j].x * w.x + v[j].y * w.y) + (v[j].z * w.z + v[j].w * w.w); }
        gl[q] = wave_sum(s) + b_grp[q]; }
    int gs = 0; float gm = gl[0];
#pragma unroll
    for (int q = 1; q < 4; ++q) if (gl[q] > gm) { gm = gl[q]; gs = q; }
    float den = 0.f;
#pragma unroll
    for (int q = 0; q < 4; ++q) den += __expf(gl[q] - gm);
    const float pg = 1.f / den;
    float el[8];
#pragma unroll
    for (int q = 0; q < 8; ++q) { float s = 0.f; const LAS float* wc = weT + (gs * 8 + q) * 1024;
#pragma unroll
        for (int j = 0; j < 4; ++j) { const f32x4 w = *(const LAS f32x4*)(wc + 256 * j + 4 * lane); s += (v[j].x * w.x + v[j].y * w.y) + (v[j].z * w.z + v[j].w * w.w); }
        el[q] = wave_sum(s) + b_er[gs * 8 + q]; }
    int i0 = 0; float v0 = el[0];
#pragma unroll
    for (int q = 1; q < 8; ++q) if (el[q] > v0) { v0 = el[q]; i0 = q; }
    int i1 = -1; float v1 = -INFINITY;
#pragma unroll
    for (int q = 0; q < 8; ++q) if (q != i0 && el[q] > v1) { v1 = el[q]; i1 = q; }
    const float e1 = __expf(v1 - v0); const float w0g = pg / (1.f + e1), w1g = pg * e1 / (1.f + e1);
    if (lane < 2) {
        const int e = gs * 8 + (lane == 0 ? i0 : i1);
        const unsigned slot = atomicAdd(ecnt + e, 1u);
        ((int*)(ws + SM_ELIST))[(size_t)e * S + slot] = t;
        ((int*)(ws + SM_EID))[2 * t + lane] = e; ((int*)(ws + SM_SLOT))[2 * t + lane] = (int)slot; ((float*)(ws + SM_WT))[2 * t + lane] = lane == 0 ? w0g : w1g;
    }
}
__device__ __forceinline__ void ln2_row(int t, unsigned char* ws, const LAS int* tab, const LAS float* g2, const LAS float* b2, float* out, bool last,
                                        const LAS float* w12, const float* bff, const float* bmi, const float* bmf, int lane, int dbg = 0) {
    const bf16_t* x1 = (const bf16_t*)(ws + WS_ACTB) + (size_t)t * DM;
    const int e0 = ((const int*)(ws + SM_EID))[2 * t], e1 = ((const int*)(ws + SM_EID))[2 * t + 1];
    const int s0 = ((const int*)(ws + SM_SLOT))[2 * t], s1 = ((const int*)(ws + SM_SLOT))[2 * t + 1];
    const float w0 = ((const float*)(ws + SM_WT))[2 * t], w1 = ((const float*)(ws + SM_WT))[2 * t + 1];
    const bf16_t* y0 = (const bf16_t*)(ws + T_YE) + (size_t)(256 * tab[1 + e0] + s0) * DM; const bf16_t* y1 = (const bf16_t*)(ws + T_YE) + (size_t)(256 * tab[1 + e1] + s1) * DM;
    f32x4 v[4];
#pragma unroll
    for (int j = 0; j < 4; ++j) { const u32x2 xw = *(const u32x2*)(x1 + 256 * j + 4 * lane);
        const f32x4 x = {bflo(xw.x), bfhi(xw.x), bflo(xw.y), bfhi(xw.y)};
        const u32x2 a = *(const u32x2*)(y0 + 256 * j + 4 * lane), b = *(const u32x2*)(y1 + 256 * j + 4 * lane);
        const f32x4 ya = {bflo(a.x), bfhi(a.x), bflo(a.y), bfhi(a.y)}, yb = {bflo(b.x), bfhi(b.x), bflo(b.y), bfhi(b.y)};
        v[j] = x * ALPHA + ya * w0 + yb * w1; }
    {
        float s = 0.f;
#pragma unroll
        for (int j = 0; j < 4; ++j) s += (v[j].x + v[j].y) + (v[j].z + v[j].w);
        const float mean = wave_sum(s) * (1.f / DM); float s2 = 0.f;
#pragma unroll
        for (int j = 0; j < 4; ++j) { v[j] = v[j] - mean; s2 += (v[j].x * v[j].x + v[j].y * v[j].y) + (v[j].z * v[j].z + v[j].w * v[j].w); }
        const float rstd = rsqrtf(wave_sum(s2) * (1.f / DM) + EPS);
#pragma unroll
        for (int j = 0; j < 4; ++j) { const f32x4 g = *(const LAS f32x4*)(g2 + 256 * j + 4 * lane), b = *(const LAS f32x4*)(b2 + 256 * j + 4 * lane); v[j] = v[j] * rstd * g + b; }
    }
    if (dbg & 1) { if (!(dbg & 2) && !last) gates_row(v, w12, bff, bmi, bmf, (float*)(ws + WS_ROPE), (float*)(ws + WS_ROPE), (float*)(ws + WS_ROPE), -1, lane); return; }
    if (last) {
#pragma unroll
        for (int j = 0; j < 4; ++j) *(f32x4*)(out + (size_t)t * DM + 256 * j + 4 * lane) = v[j];
    } else {
        store_row_bf16(v, (bf16_t*)(ws + WS_ACTB) + (size_t)t * DM, lane);
        gates_row(v, w12, bff, bmi, bmf, (float*)(ws + SM_FLF), (float*)(ws + SM_MLI), (float*)(ws + SM_MLF), t, lane);
    }
}

__device__ __forceinline__ const void* ldarg(int k) { int kk = k; asm volatile("" : "+s"(kk)); return ((const void* const*)__builtin_amdgcn_kernarg_segment_ptr())[kk]; }
#ifndef PH_MASK
#define PH_MASK 0x7ff
#endif
#define PHM(k) (((PH_MASK) >> (k)) & 1)
#define IN(k) (lo <= (k) && (k) < hi)
#define SEAM(k) do { if (IN(k) && IN((k) + 1)) { XcdBarrier _b; _b.bar = (unsigned*)ldarg(23) + CW_BAR; _b.x = xb_xcc_id(); _b.st = (volatile LAS unsigned*)(lds + LDS_MISC); xcd_barrier(_b, wave0 == 0 && __builtin_amdgcn_mbcnt_hi(~0u, __builtin_amdgcn_mbcnt_lo(~0u, 0u)) == 0u); } } while (0)
#define PHASE_IDS unsigned char* ws = (unsigned char*)ldarg(23); unsigned* ctl = (unsigned*)ws; float* outp = (float*)ldarg(22); (void)ctl; (void)outp; int tid = wave0 * 64 + (int)__builtin_amdgcn_mbcnt_hi(~0u, __builtin_amdgcn_mbcnt_lo(~0u, 0u)); asm volatile("" : "+v"(tid)); const int lane = tid & 63, wave = __builtin_amdgcn_readfirstlane(tid >> 6); const int gw = bid * 8 + wave, NGW = G * 8; (void)lane; (void)gw; (void)NGW;
#define INP(k) ((const float*)ldarg(k))
template <int l>
__device__ __forceinline__ void layer_phases(LAS unsigned char* lds, const int wave0, const int bid, const int G, const int lo, const int hi, const int sub) {
    constexpr int P = 1 + 10 * l;

        if (PHM(0) && IN(P + 0)) { PHASE_IDS;
            SchedDenseIn Sd{(const char*)(ws + WS_ACTB), (const char*)(ws + WS_WIN) + (size_t)l * NZ * DM * 2, G, bid};
            EpiZ E{(bf16_t*)(ws + WS_ZR), (bf16_t*)(ws + WS_ZT), (sub >> 12) & 1};
            pg8::gemm_phase<EpiZ, SchedDenseIn>(lds, DM, Sd, E, tid);
            if (G == 256 && bid >= 128 && !((sub >> 13) & 1))
                moe_weights(INP(17) + (size_t)l * NE * DM * DE, INP(18) + (size_t)l * NE * DM * DE, INP(19) + (size_t)l * NE * DE * DM, ws, lds, lane, wave, (bid - 128) * 8 + wave, 128 * 8, 0, MOE_FILL);
        }
        SEAM(P + 0);
        if (PHM(1) && IN(P + 1)) { PHASE_IDS;
            if (sub & 1) for (int u = bid; u < 256; u += G) mix1_unit(u, ws, ctl + CW_KMAX(l), lds, tid, lane, wave);
            if (sub & 2) { const bool split = (G == 256);
                moe_weights(INP(17) + (size_t)l * NE * DM * DE, INP(18) + (size_t)l * NE * DM * DE, INP(19) + (size_t)l * NE * DE * DM, ws, lds, lane, wave, gw, NGW, split ? MOE_FILL : 0, MOE_ITEMS); }
        }
        SEAM(P + 1);
        if (PHM(2) && IN(P + 2)) { PHASE_IDS;
            for (int u = bid; u < 1536; u += G) {
                const int ty = u >> 9, r = u & 511, h = r >> 7, q = r & 127;
                if (!((sub >> ty) & 1)) continue;
                if (ty == 0) { const float kmaxn = sqrtf(__builtin_bit_cast(float, xb_ld(ctl + CW_KMAX(l) + h))); fox_unit(h, q, ws, kmaxn, INP(7) + l * 256, lds, tid, lane, wave, (sub & 256) ? 1 : ((sub & 512) ? 3 : (1 << 30)), (sub & 768) ? (bf16_t*)(ws + WS_X1) : nullptr); }
                else if (ty == 1) mlstm_local_unit(h, q, ws, INP(6) + (size_t)l * 4 * 1024, lds, tid, lane, wave);
                else moba_gate_unit(h, q, ws, lds, tid, lane, wave);
            }
        }
        SEAM(P + 2);
        if (PHM(3) && IN(P + 3)) { PHASE_IDS;
            if (sub & 1) for (int vb = bid; vb < 256; vb += G) mlstm_scan(ws, lds, tid, lane, wave, vb);
            LAS unsigned char* ltab = lds + LDS_TAB;
            LAS int* tot = (LAS int*)ltab;
            LAS int* pre = (LAS int*)(ltab + 1024);
            __syncthreads();
            if (tid < 256) { const int* cq = (const int*)(ws + SM_CNTQ) + (size_t)tid * 128; int a = 0;
                for (int i = 0; i < 128; i += 4) { const u32x4 v = *(const u32x4*)(cq + i); a += (int)(v.x + v.y + v.z + v.w); }
                tot[tid] = a; pre[tid] = (a + 255) >> 8; }
            __syncthreads();
            if (tid < 64) {
                const int c0 = pre[4 * tid], c1 = pre[4 * tid + 1], c2 = pre[4 * tid + 2], c3 = pre[4 * tid + 3]; const int tsum = c0 + c1 + c2 + c3; int inc = tsum;
#pragma unroll
                for (int o = 1; o < 64; o <<= 1) { const int v = __shfl_up(inc, o); if (tid >= o) inc += v; }
                const int exc = inc - tsum;
                pre[4 * tid] = exc; pre[4 * tid + 1] = exc + c0; pre[4 * tid + 2] = exc + c0 + c1; pre[4 * tid + 3] = exc + c0 + c1 + c2;
                if (tid == 63) pre[256] = inc;
            }
            __syncthreads();
            const int total = (sub & 2) ? pre[256] : 0;
            for (int u = bid; u < total; u += G) {
                int loi = 0, hii = 255;
                while (loi < hii) { const int mid = (loi + hii + 1) >> 1; if (pre[mid] <= u) loi = mid; else hii = mid - 1; }
                moba_part_unit(loi >> 6, loi & 63, u - pre[loi], tot[loi], ws, lds, ltab, tid, lane, wave, (sub >> 10) & 3);
            }
        }
        SEAM(P + 3);
        if (PHM(4) && IN(P + 4)) { PHASE_IDS;
            for (int u = bid; u < 768; u += G) {
                if (u < 512) { if (sub & 1) mlstm_out_unit(u >> 7, u & 127, ws, INP(8) + l * 512, lds, tid, lane, wave); }
                else if (sub & 2) { const int r = u - 512; moba_own_unit(r >> 6, r & 63, ws, INP(9) + l * 256, lds, tid, lane, wave); }
            }
        }
        SEAM(P + 4);
        if (PHM(5) && IN(P + 5)) { PHASE_IDS;
            SchedDense4 Sd{(const char*)(ws + WS_Y), (const char*)(ws + WS_WOUT) + (size_t)l * DM * DM * 2, DM, G, (G % 8 == 0) ? (bid % 8) * (G / 8) + bid / 8 : bid};
            EpiPre1<(l > 0)> E{l == 0 ? (const void*)INP(0) : (const void*)(ws + WS_ACTB), (bf16_t*)(ws + WS_ZT)};
            pg8::gemm_phase<EpiPre1<(l > 0)>, SchedDense4>(lds, DM, Sd, E, tid);
        }
        SEAM(P + 5);
        if (PHM(6) && IN(P + 6)) { PHASE_IDS;
            ln1_router_load(INP(11) + l * DM, INP(12) + l * DM, INP(13) + (size_t)l * DM * 4, INP(15) + (size_t)l * DM * 32, lds, tid);
            __syncthreads();
            const float* bgp = INP(14) + l * 4; const float* bep = INP(16) + l * 32;
#pragma unroll 8
            for (int t = gw; t < S; t += NGW)
                ln1_router_row(t, ws, lds, bgp, bep, ctl + CW_ECNT(l), lane);
            __syncthreads();
        }
        SEAM(P + 6);
        if (PHM(7) && IN(P + 7)) { PHASE_IDS;
            LAS int* tab = (LAS int*)(lds + LDS_TAB);
            moe_table(ctl + CW_ECNT(l), tab, tid);
            SchedMoE Sm{(const char*)(ws + WS_ACTB), (const char*)(ws + WS_WGU), tab, (size_t)DM * DM * 2, DM, G, (G % 8 == 0) ? (bid % 8) * (G / 8) + bid / 8 : bid, (sub & 16) ? 1 : ((sub & 32) ? 2 : 1000), (const int*)(ws + SM_ELIST), nullptr, nullptr};
            EpiGU E{(bf16_t*)(ws + T_H), ctl + CW_GUC(l)};
            pg8::gemm_phase<EpiGU, SchedMoE, true>(lds, DM, Sm, E, tid, (LAS unsigned*)(lds + LDS_TAB + 1024));
        }
        if (PHM(8) && IN(P + 8)) { PHASE_IDS;
            LAS int* tab = (LAS int*)(lds + LDS_TAB);
            moe_table(ctl + CW_ECNT(l), tab, tid);
            SchedMoE Sm{(const char*)(ws + T_H), (const char*)(ws + WS_WD), tab, (size_t)DM * DE * 2, DE, G, (G % 8 == 0) ? (bid % 8) * (G / 8) + bid / 8 : bid, (sub & 16) ? 1 : ((sub & 32) ? 2 : 1000), nullptr, ctl + CW_GUC(l), ctl + CW_BAR + XB_TMO};
            EpiY E{(bf16_t*)(ws + T_YE)};
            pg8::gemm_phase<EpiY, SchedMoE, false, true>(lds, DE, Sm, E, tid);
        }
        SEAM(P + 8);
        if (PHM(9) && IN(P + 9)) { PHASE_IDS;
            LAS int* tab = (LAS int*)(lds + LDS_TAB);
            moe_table(ctl + CW_ECNT(l), tab, tid);
            const bool last = (l == NL - 1);
            LAS float* w12 = (LAS float*)lds;
            if (!last) { load_w12(INP(2) + (size_t)(l + 1) * DM * INW, w12, tid); __syncthreads(); }
            LAS float* g2l = (LAS float*)(lds + 49152); LAS float* b2l = g2l + 1024;
            { const float* g2p = INP(20) + l * DM; const float* b2p = INP(21) + l * DM; for (int i = tid; i < 1024; i += 512) { g2l[i] = g2p[i]; b2l[i] = b2p[i]; } }
            __syncthreads();
            const float* bffp = INP(3) + (l + 1) * 4; const float* bmip = INP(4) + (l + 1) * 4; const float* bmfp = INP(5) + (l + 1) * 4;
#pragma unroll 8
            for (int t = gw; t < S; t += NGW)
                ln2_row(t, ws, tab, g2l, b2l, outp, last, w12, bffp, bmip, bmfp, lane, (sub >> 14) & 3);
            __syncthreads();
        }
        SEAM(P + 9);
}
struct Args { const void* in[22]; float* out; unsigned char* ws; int ph_lo, ph_hi, sub, pad; };
__global__ void __launch_bounds__(512, 2) fwd(Args args) {
    extern __shared__ __attribute__((aligned(16))) unsigned char lds_raw[];
    LAS unsigned char* lds = (LAS unsigned char*)lds_raw;
    const int tid0 = threadIdx.x; const int wave0 = __builtin_amdgcn_readfirstlane(tid0 >> 6);
    const int bid = blockIdx.x, G = gridDim.x;
    if (tid0 < 4) ((LAS unsigned*)(lds + LDS_MISC))[tid0] = 0u;
    __syncthreads();
    const int lo = args.ph_lo, hi = args.ph_hi;
    if (hi - lo > 1 && lo != 99) (void)xcd_barrier_post((unsigned*)ldarg(23) + CW_BAR, (volatile LAS unsigned*)(lds + LDS_MISC));
    if (PHM(10) && IN(0)) { PHASE_IDS; p0_prologue(INP(0), (const int*)ldarg(1), INP(2), INP(10), INP(3), INP(4), INP(5), ws, lds, tid, lane, wave, bid, G); }
    SEAM(0);
    layer_phases<0>(lds, wave0, bid, G, lo, hi, args.sub);
    layer_phases<1>(lds, wave0, bid, G, lo, hi, args.sub);
#undef IN
#undef SEAM
}

extern "C" void kernel_launch(void* const* d_in, const int* in_sizes, int n_in, void* d_out, int out_size, void* d_ws, size_t ws_size, hipStream_t stream) {
    static int grid = 0;
    if (grid == 0) {
        if (n_in != 22 || out_size != S * DM || ws_size < WS_END) { fprintf(stderr, "kernel_launch: unexpected shapes (n_in %d, out %d, ws %zu < %zu); nothing launched\n", n_in, out_size, ws_size, (size_t)WS_END); grid = -1; return; }
        int dev = 0, cus = 0;
        if (hipGetDevice(&dev) != hipSuccess || hipDeviceGetAttribute(&cus, hipDeviceAttributeMultiprocessorCount, dev) != hipSuccess) { grid = -1; return; }
        if (hipFuncSetAttribute((const void*)fwd, hipFuncAttributeMaxDynamicSharedMemorySize, LDS_BYTES) != hipSuccess) { fprintf(stderr, "kernel_launch: hipFuncSetAttribute failed\n"); grid = -1; return; }
        int per_cu = 0;
        (void)hipOccupancyMaxActiveBlocksPerMultiprocessor(&per_cu, (const void*)fwd, 512, LDS_BYTES);
        (void)hipGetLastError();
        if (per_cu < 1) fprintf(stderr, "kernel_launch: occupancy query reports %d blocks per CU\n", per_cu);
        grid = cus > 0 ? cus : 256;
    }
    if (grid < 0) return;
    (void)hipMemsetAsync((char*)d_ws + WS_CTL, 0, CTL_BYTES, stream);
    Args a{};
    for (int i = 0; i < 22; ++i) a.in[i] = d_in[i];
    a.out = (float*)d_out; a.ws = (unsigned char*)d_ws; a.sub = 7;
    if (N_LAUNCHES == 1) {
        a.ph_lo = 0; a.ph_hi = NPH;
        hipLaunchKernelGGL(fwd, dim3(grid), dim3(512), LDS_BYTES, stream, a);
    } else {
        for (int p = 0; p < NPH; ++p) { a.ph_lo = p; a.ph_hi = p + 1; hipLaunchKernelGGL(fwd, dim3(grid), dim3(512), LDS_BYTES, stream, a);
#ifdef DUP_MASK
            if (((unsigned long long)(DUP_MASK) >> p) & 1ull) { a.sub = DUP_SUB; hipLaunchKernelGGL(fwd, dim3(grid), dim3(512), LDS_BYTES, stream, a); a.sub = 7; }
#endif
        }
    }
}
```

```cpp
#include <hip/hip_runtime.h>
#include <cstdio>
#include <cstdint>

#define LAS __attribute__((address_space(3)))
#define GAS __attribute__((address_space(1)))
typedef unsigned short bf16_t;
typedef short bf16x8 __attribute__((ext_vector_type(8)));
typedef short bf16x4 __attribute__((ext_vector_type(4)));
typedef float f32x4 __attribute__((ext_vector_type(4)));
typedef float f32x2 __attribute__((ext_vector_type(2)));
typedef unsigned u32x4 __attribute__((ext_vector_type(4)));
typedef unsigned u32x2 __attribute__((ext_vector_type(2)));

#ifndef N_LAUNCHES
#define N_LAUNCHES 1
#endif

constexpr int S = 16384, DM = 1024, INW = 3596, NL = 2;
constexpr int NZ = 3584;
constexpr int ZRW = 2560;
constexpr int ZR_FQ = 0, ZR_FK = 256, ZR_MQ = 512, ZR_MK = 1024, ZR_MO = 1536, ZR_BQ = 2048, ZR_BK = 2304;
constexpr int ZT_FV = 0, ZT_MV = 256, ZT_BV = 768;
constexpr int ZTP = S + 136;
constexpr int NE = 32, DE = 512, MAXT = 160, PROWS = MAXT * 256;
constexpr float ALPHA = 1.41421356237309515f;
constexpr float EPS = 1e-5f;
constexpr int NPH = 21;

constexpr size_t MiB = 1u << 20;
constexpr size_t WS_CTL = 0, CTL_BYTES = 1 * MiB;
constexpr size_t WS_WIN = 1 * MiB;
constexpr size_t WS_ROPE = 16 * MiB;
constexpr size_t WS_WOUT = 17 * MiB;
constexpr size_t WS_WGU = 21 * MiB;
constexpr size_t WS_WD = 85 * MiB;
constexpr size_t WS_ACTB = 117 * MiB;
constexpr size_t WS_Y = 149 * MiB;
constexpr size_t WS_X1 = 181 * MiB;
constexpr size_t WS_ZR = 245 * MiB;
constexpr size_t WS_ZT = 325 * MiB;
constexpr size_t WS_TMP = 359 * MiB;
constexpr size_t WS_SMALL = 481 * MiB;
constexpr size_t WS_END = 489 * MiB;
constexpr size_t T_QC = WS_TMP, T_KC = WS_TMP + 16 * MiB, T_U = WS_TMP + 32 * MiB, T_CST = WS_TMP + 64 * MiB,
                 T_MPO = WS_TMP + 80 * MiB, T_MPML = WS_TMP + 104 * MiB, T_QIDX = WS_TMP + 106 * MiB;
constexpr size_t T_H = WS_TMP, T_YE = WS_TMP + 40 * MiB;
constexpr size_t SM_FLF = WS_SMALL, SM_FCL = SM_FLF + 256 * 1024, SM_MLI = SM_FCL + 256 * 1024, SM_MLF = SM_MLI + 256 * 1024,
                 SM_MB = SM_MLF + 256 * 1024, SM_MA = SM_MB + 256 * 1024, SM_MPX = SM_MA + 256 * 1024,
                 SM_FTS = SM_MPX + 256 * 1024, SM_KMEAN = SM_FTS + 4096, SM_EID = SM_KMEAN + 65536, SM_SLOT = SM_EID + 131072,
                 SM_WT = SM_SLOT + 131072, SM_ELIST = SM_WT + 131072, SM_MLSC = SM_ELIST + 2 * MiB, SM_NLOC = SM_MLSC + 16384,
                 SM_NST = SM_NLOC + 262144, SM_MSEL = SM_NST + 262144, SM_CNTQ = SM_MSEL + 262144, SM_END = SM_CNTQ + 131072;
static_assert(SM_END <= WS_END, "small region");
static_assert(WS_ZT + (size_t)1024 * ZTP * 2 <= WS_TMP, "transposed z buffer");
constexpr int CW_BAR = 4096;
__host__ __device__ constexpr int CW_ECNT(int l) { return 8192 + 64 * l; }
__host__ __device__ constexpr int CW_KMAX(int l) { return 9216 + 16 * l; }
__host__ __device__ constexpr int CW_GUC(int l) { return 12288 + 4096 * l; }

constexpr int RING_BYTES = 131072;
constexpr int LDS_BYTES = 163840;
constexpr int LDS_MISC = LDS_BYTES - 64;
constexpr int LDS_TAB = LDS_MISC - 4096;

__device__ __forceinline__ unsigned f2bf(float f) { unsigned u = __builtin_bit_cast(unsigned, f); return (u + 0x7fffu + ((u >> 16) & 1u)) >> 16; }
typedef __bf16 bf16x2_t __attribute__((ext_vector_type(2)));
__device__ __forceinline__ unsigned pk2(float lo, float hi) { const f32x2 v = {lo, hi}; const bf16x2_t b = __builtin_convertvector(v, bf16x2_t); return __builtin_bit_cast(unsigned, b); }
__device__ __forceinline__ float bf2f(unsigned h) { return __builtin_bit_cast(float, h << 16); }
__device__ __forceinline__ float bflo(unsigned w) { return __builtin_bit_cast(float, w << 16); }
__device__ __forceinline__ float bfhi(unsigned w) { return __builtin_bit_cast(float, w & 0xffff0000u); }
typedef unsigned u32x2v __attribute__((ext_vector_type(2)));
template <int CTRL> __device__ __forceinline__ float dpp_f(float v) { return __builtin_bit_cast(float, __builtin_amdgcn_update_dpp(0, __builtin_bit_cast(int, v), CTRL, 0xf, 0xf, true)); }
#ifndef RED_MODE
#define RED_MODE 7
#endif
__device__ __forceinline__ float x32f(float v) { if (RED_MODE & 2) { unsigned a = __builtin_bit_cast(unsigned, v), b = a; asm volatile("s_nop 1\n\tv_permlane32_swap_b32 %0, %1" : "+v"(a), "+v"(b));
        return (__builtin_amdgcn_mbcnt_hi(~0u, __builtin_amdgcn_mbcnt_lo(~0u, 0u)) < 32u) ? __builtin_bit_cast(float, b) : __builtin_bit_cast(float, a); } return __shfl_xor(v, 32); }
__device__ __forceinline__ float x16f(float v) { if (RED_MODE & 4) { unsigned a = __builtin_bit_cast(unsigned, v), b = a; asm volatile("s_nop 1\n\tv_permlane16_swap_b32 %0, %1" : "+v"(a), "+v"(b));
        return ((__builtin_amdgcn_mbcnt_hi(~0u, __builtin_amdgcn_mbcnt_lo(~0u, 0u)) >> 4) & 1u) ? __builtin_bit_cast(float, a) : __builtin_bit_cast(float, b); } return __shfl_xor(v, 16); }
__device__ __forceinline__ float grp_sum(float v) { v += x32f(v); v += x16f(v); return v; }
__device__ __forceinline__ float grp_max(float v) { v = fmaxf(v, x32f(v)); v = fmaxf(v, x16f(v)); return v; }
__device__ __forceinline__ float row_sum16(float v) { v += dpp_f<0xB1>(v); v += dpp_f<0x4E>(v); v += dpp_f<0x141>(v); v += dpp_f<0x140>(v); return v; }
__device__ __forceinline__ float row_max16(float v) { v = fmaxf(v, dpp_f<0xB1>(v)); v = fmaxf(v, dpp_f<0x4E>(v)); v = fmaxf(v, dpp_f<0x141>(v)); v = fmaxf(v, dpp_f<0x140>(v)); return v; }
__device__ __forceinline__ float wave_sum(float v) {
    if (RED_MODE & 1) v = row_sum16(v); else { v += __shfl_xor(v, 1); v += __shfl_xor(v, 2); v += __shfl_xor(v, 4); v += __shfl_xor(v, 8); }
    return grp_sum(v); }
__device__ __forceinline__ float wave_max(float v) {
    if (RED_MODE & 1) v = row_max16(v); else { v = fmaxf(v, __shfl_xor(v, 1)); v = fmaxf(v, __shfl_xor(v, 2)); v = fmaxf(v, __shfl_xor(v, 4)); v = fmaxf(v, __shfl_xor(v, 8)); }
    return grp_max(v); }
__device__ __forceinline__ float log_sigmoid(float x) { return fminf(x, 0.f) - log1pf(__expf(-fabsf(x))); }
__device__ __forceinline__ float sigmoidf(float x) { return 1.f / (1.f + __expf(-x)); }
__device__ __forceinline__ float siluf(float x) { return x / (1.f + __expf(-x)); }
#define MFMA16(a, b, c) __builtin_amdgcn_mfma_f32_16x16x32_bf16((a), (b), (c), 0, 0, 0)
#define VM_WAIT() asm volatile("s_waitcnt vmcnt(0)" ::: "memory")

#define XB_TMO      128
#define XB_XCNT(j)  (256  + 64 * (j))
#define XB_XSUB(j)  (1280 + 64 * (j))
#define XB_XGEN(j)  (2304 + 64 * (j))
#define XB_TOP      3328
#define XB_TOPGEN   3392
#define XCD_BAR_WORDS 3456
#define XB_SPIN_CAP (1u << 24)
__device__ __forceinline__ unsigned xb_ld(unsigned* p)              { return __hip_atomic_load(p, __ATOMIC_RELAXED, __HIP_MEMORY_SCOPE_AGENT); }
__device__ __forceinline__ unsigned xb_add(unsigned* p, unsigned v) { return __hip_atomic_fetch_add(p, v, __ATOMIC_RELAXED, __HIP_MEMORY_SCOPE_AGENT); }
__device__ __forceinline__ unsigned xb_xcc_id() { return (unsigned)__builtin_amdgcn_s_getreg((3 << 11) | 20) & 0xFu; }
#define XB_SPIN(cond, bar) do { unsigned _sp = 0; while (cond) { __builtin_amdgcn_s_sleep(1); \
    if ((++_sp & 255u) == 0u) { if (xb_ld(&(bar)[XB_TMO])) break; if (_sp > XB_SPIN_CAP) { atomicAdd(&(bar)[XB_TMO], 1u); break; } } } } while (0)
struct XcdBarrier { unsigned* bar; unsigned x; volatile LAS unsigned* st; };
__device__ __forceinline__ XcdBarrier xcd_barrier_post(unsigned* bar, volatile LAS unsigned* st) {
    XcdBarrier b; b.bar = bar; b.x = xb_xcc_id(); b.st = st;
    if (threadIdx.x == 0) (void)xb_add(&bar[XB_XCNT(b.x)], 1u);
    return b;
}
__device__ __forceinline__ void xcd_barrier_complete(unsigned* bar, unsigned x, unsigned& nloc, unsigned& nx) {
    const unsigned G = gridDim.x * gridDim.y * gridDim.z;
    unsigned sum, cnt, mine, sp = 0u;
    for (;;) {
        sum = 0u; cnt = 0u; mine = 0u;
#pragma unroll
        for (unsigned j = 0; j < 16; ++j) { const unsigned c = xb_ld(&bar[XB_XCNT(j)]); sum += c; cnt += (c > 0u) ? 1u : 0u; mine = (j == x) ? c : mine; }
        if (sum == G) break;
        __builtin_amdgcn_s_sleep(1);
        if ((++sp & 255u) == 0u) { if (xb_ld(&bar[XB_TMO])) break; if (sp > XB_SPIN_CAP) { atomicAdd(&bar[XB_TMO], 1u); break; } }
    }
    nloc = mine > 0u ? mine : 1u; nx = cnt > 0u ? cnt : 1u;
}
__device__ __forceinline__ void xcd_barrier(const XcdBarrier& b, const bool thread0) {
    asm volatile("s_waitcnt vmcnt(0)" ::: "memory");
    __syncthreads();
    if (thread0) {
        unsigned* bar = b.bar;
        __builtin_amdgcn_s_waitcnt(0);
        unsigned nloc = b.st[0], nx = b.st[1];
        if (nloc == 0u) { xcd_barrier_complete(bar, b.x, nloc, nx); b.st[0] = nloc; b.st[1] = nx; }
        const unsigned old = xb_add(&bar[XB_XSUB(b.x)], 1u);
        const unsigned gen = old / nloc;
        if (old + 1u == (gen + 1u) * nloc) {
            __builtin_amdgcn_fence(__ATOMIC_RELEASE, "agent");
            asm volatile("s_waitcnt vmcnt(0)" ::: "memory");
            const unsigned og = xb_add(&bar[XB_TOP], 1u);
            const unsigned tg = og / nx;
            if (og + 1u == (tg + 1u) * nx) xb_add(&bar[XB_TOPGEN], 1u);
            else XB_SPIN(xb_ld(&bar[XB_TOPGEN]) == tg, bar);
            __builtin_amdgcn_fence(__ATOMIC_ACQUIRE, "agent");
            xb_add(&bar[XB_XGEN(b.x)], 1u);
            asm volatile("s_waitcnt vmcnt(0)" ::: "memory");
        } else {
            XB_SPIN(xb_ld(&bar[XB_XGEN(b.x)]) == gen, bar);
            __builtin_amdgcn_fence(__ATOMIC_ACQUIRE, "agent");
            asm volatile("s_waitcnt vmcnt(0)" ::: "memory");
        }
    }
    __syncthreads();
}
namespace pg8 {
constexpr int BM = 256, BK = 64, HALF = 128, HTB = HALF * BK * 2, STAGE_BYTES = 8 * HTB, NXCD = 8, WGM = 8;
__host__ __device__ __forceinline__ int lds_byte(int r, int c) { const int st = (r >> 4) * 2 + (c >> 5), rr = r & 15, cc = c & 31, ob = rr * 64 + cc * 2; return st * 1024 + (ob ^ (((ob >> 9) & 1) << 5)); }
__host__ __device__ __forceinline__ void stage_rc(int b, int& R, int& C) { const int st = b / 1024, sb = b % 1024, swz = sb ^ (((sb >> 9) & 1) << 5); R = (st >> 1) * 16 + swz / 64; C = (st & 1) * 32 + (swz % 64) / 2; }
__host__ __device__ __forceinline__ int perm32(int rho) { const int n = rho >> 4, i = rho & 15; return 8 * (i >> 2) + 4 * n + (i & 3); }

struct GUnit {
    const char* A;
    const char* B;
    int pm, pn, x0;
    const int* list;
    int l0, nl;
};

template <class Epi, class Sched, bool GATHER = false, bool HOOK = false>
__device__ __forceinline__ void gemm_phase(LAS unsigned char* lds, const int K, const Sched& S, const Epi& E, const int tid, LAS unsigned* rtab = nullptr) {
    const int wid = __builtin_amdgcn_readfirstlane(tid >> 6), lane = tid & 63, wr = wid >> 2, wc = wid & 3, fr = lane & 15, fq = lane >> 4;
    const int nt = K / BK;
    unsigned voffA[2], voffB[2];
#pragma unroll
    for (int i = 0; i < 2; ++i) { int R, C; stage_rc(tid * 16 + i * 8192, R, C); const int Rb = (R & ~31) + perm32(R & 31); voffA[i] = (unsigned)(R * K + C) * 2u; voffB[i] = (unsigned)(Rb * K + C) * 2u; }
    const size_t kstep = (size_t)(BK * 2);
    const size_t hstep = (size_t)HALF * K * 2;
    const unsigned ldsw = (unsigned)wid * 1024u;
    const int aoff = lds_byte(wr * 64 + fr, fq * 8), boff = lds_byte(wc * 32 + fr, fq * 8);
#define PG8_SA(b, h) (((b) * 2 + (h)) * HTB)
#define PG8_SB(b, h) ((4 + (b) * 2 + (h)) * HTB)
#define PG8_STAGE(bufoff, gbase, voff) do { _Pragma("unroll") for (int _i = 0; _i < 2; ++_i) \
        __builtin_amdgcn_global_load_lds((const unsigned*)((const char*)(gbase) + (voff)[_i]), (LAS unsigned*)(lds + (bufoff) + ldsw + _i * 8192), 16, 0, 0); } while (0)
#define PG8_STAGE_A(bufoff, gbase, voff) do { _Pragma("unroll") for (int _i = 0; _i < 2; ++_i) \
        __builtin_amdgcn_global_load_lds((const unsigned*)((const char*)(gbase) + (voff)[_i]), (LAS unsigned*)(lds + (bufoff) + ldsw + _i * 8192), 16, 0, HOOK ? 16 : 0); } while (0)
#define PG8_LDA(dst, b, h) do { _Pragma("unroll") for (int m = 0; m < 4; ++m) _Pragma("unroll") for (int k = 0; k < 2; ++k) dst[m][k] = *(const LAS bf16x8*)(lds + PG8_SA(b, h) + aoff + m * 2048 + k * 1024); } while (0)
#define PG8_LDB(dst, b, h) do { _Pragma("unroll") for (int n = 0; n < 2; ++n) _Pragma("unroll") for (int k = 0; k < 2; ++k) dst[n][k] = *(const LAS bf16x8*)(lds + PG8_SB(b, h) + boff + n * 2048 + k * 1024); } while (0)
#define PG8_MMA(ai, bj, At, Bt) do { __builtin_amdgcn_s_setprio(1); _Pragma("unroll") for (int m = 0; m < 4; ++m) _Pragma("unroll") for (int n = 0; n < 2; ++n) _Pragma("unroll") for (int k = 0; k < 2; ++k) \
        acc[ai][bj][m][n] = __builtin_amdgcn_mfma_f32_16x16x32_bf16(Bt[n][k], At[m][k], acc[ai][bj][m][n], 0, 0, 0); __builtin_amdgcn_s_setprio(0); } while (0)
#define PG8_WAIT_V(n) asm volatile("s_waitcnt vmcnt(" #n ")" ::: "memory")
#define PG8_WAIT_L(n) asm volatile("s_waitcnt lgkmcnt(" #n ")" ::: "memory")
#define PG8_BAR __builtin_amdgcn_s_barrier()
#define PG8_SCHED __builtin_amdgcn_sched_barrier(0)
#define PG8_STAGE_G(bufoff, gbase, vo) do { _Pragma("unroll") for (int _i = 0; _i < 2; ++_i) \
        __builtin_amdgcn_global_load_lds((const unsigned*)((const char*)(gbase) + (vo)[_i]), (LAS unsigned*)(lds + (bufoff) + ldsw + _i * 8192), 16, 0, 0); } while (0)
#define PG8_ROWTAB(u, slot) do { if (tid < 256) { int _x = (u).l0 + tid; _x = _x < (u).nl ? _x : (u).nl - 1; rtab[(slot) * 256 + tid] = (unsigned)(u).list[_x] * (unsigned)(K * 2); } } while (0)
#define PG8_LOADCV(slot) do { _Pragma("unroll") for (int _h = 0; _h < 2; ++_h) _Pragma("unroll") for (int _i = 0; _i < 2; ++_i) { int _R, _C; stage_rc(tid * 16 + _i * 8192, _R, _C); \
        cv[_h][_i] = rtab[(slot) * 256 + _h * HALF + _R] + (unsigned)(_C * 2); } } while (0)
    GUnit cur, nxt; int ui = 0;
    if (!S.next(0, cur)) return;
    unsigned cv[2][2]; int par = 0;
    if constexpr (GATHER) { PG8_ROWTAB(cur, 0); __syncthreads(); PG8_LOADCV(0); }
    f32x4 acc[2][2][4][2];
#pragma unroll
    for (int a = 0; a < 2; ++a)
#pragma unroll
        for (int b = 0; b < 2; ++b)
#pragma unroll
            for (int m = 0; m < 4; ++m)
#pragma unroll
                for (int n = 0; n < 2; ++n) acc[a][b][m][n] = (f32x4){0.f, 0.f, 0.f, 0.f};
    bf16x8 At[4][2], B0[2][2], B1[2][2];
    const char* cA = cur.A; const char* cB = cur.B;
    if constexpr (HOOK) S.a_ready(cur, wid, lane);
    PG8_STAGE(PG8_SB(0, 0), cB, voffB); PG8_STAGE(PG8_SB(0, 1), cB + hstep, voffB);
    if constexpr (GATHER) { PG8_STAGE_G(PG8_SA(0, 0), cA, cv[0]); PG8_STAGE_G(PG8_SA(0, 1), cA, cv[1]); } else { PG8_STAGE_A(PG8_SA(0, 0), cA, voffA); PG8_STAGE_A(PG8_SA(0, 1), cA + hstep, voffA); }
    if (wr == 1) PG8_BAR;
    PG8_WAIT_V(2); PG8_BAR;
    PG8_STAGE(PG8_SB(1, 0), cB + kstep, voffB); if constexpr (GATHER) PG8_STAGE_G(PG8_SA(1, 0), cA + kstep, cv[0]); else PG8_STAGE_A(PG8_SA(1, 0), cA + kstep, voffA); PG8_STAGE(PG8_SB(1, 1), cB + hstep + kstep, voffB);
    PG8_WAIT_V(6); PG8_BAR;
    for (;;) {
        const bool has_next = S.next(ui + 1, nxt);
        const char* nA = has_next ? nxt.A : cA; const char* nB = has_next ? nxt.B : cB;
        if constexpr (GATHER) { if (has_next) PG8_ROWTAB(nxt, par ^ 1); }
        for (int t = 0; t < nt; t += 2) {
            const bool last = (t == nt - 2);
            const char* a1 = cA + (size_t)(t + 1) * kstep;
            const char* a2 = last ? nA : cA + (size_t)(t + 2) * kstep; const char* b2 = last ? nB : cB + (size_t)(t + 2) * kstep;
            const char* a3 = a2 + kstep; const char* b3 = b2 + kstep;
            if constexpr (HOOK) { if (last && has_next) S.a_ready(nxt, wid, lane); }
            PG8_LDB(B0, 0, 0); PG8_LDB(B1, 0, 1); PG8_SCHED; PG8_LDA(At, 0, 0);
            if constexpr (GATHER) { PG8_STAGE_G(PG8_SA(1, 1), a1, cv[1]); if (last && has_next) PG8_LOADCV(par ^ 1); } else PG8_STAGE_A(PG8_SA(1, 1), a1 + hstep, voffA);
            PG8_WAIT_V(8); PG8_WAIT_L(0); PG8_BAR; PG8_MMA(0, 0, At, B0); PG8_MMA(0, 1, At, B1); PG8_BAR; PG8_SCHED;
            PG8_LDA(At, 0, 1); PG8_STAGE(PG8_SB(0, 0), b2, voffB); PG8_STAGE(PG8_SB(0, 1), b2 + hstep, voffB); if constexpr (GATHER) PG8_STAGE_G(PG8_SA(0, 0), a2, cv[0]); else PG8_STAGE_A(PG8_SA(0, 0), a2, voffA);
            PG8_WAIT_V(8); PG8_WAIT_L(0); PG8_BAR; PG8_MMA(1, 0, At, B0); PG8_MMA(1, 1, At, B1); PG8_BAR; PG8_SCHED;
            PG8_LDB(B0, 1, 0); PG8_LDB(B1, 1, 1); PG8_SCHED; PG8_LDA(At, 1, 0); if constexpr (GATHER) PG8_STAGE_G(PG8_SA(0, 1), a2, cv[1]); else PG8_STAGE_A(PG8_SA(0, 1), a2 + hstep, voffA);
            PG8_WAIT_V(8); PG8_WAIT_L(0); PG8_BAR; PG8_MMA(0, 0, At, B0); PG8_MMA(0, 1, At, B1); PG8_BAR; PG8_SCHED;
            PG8_LDA(At, 1, 1); PG8_STAGE(PG8_SB(1, 0), b3, voffB); PG8_STAGE(PG8_SB(1, 1), b3 + hstep, voffB); if constexpr (GATHER) PG8_STAGE_G(PG8_SA(1, 0), a3, cv[0]); else PG8_STAGE_A(PG8_SA(1, 0), a3, voffA);
            PG8_WAIT_V(8); PG8_WAIT_L(0); PG8_BAR; PG8_MMA(1, 0, At, B0); PG8_MMA(1, 1, At, B1); PG8_BAR; PG8_SCHED;
        }
        if (wr == 0) PG8_BAR;
        E(acc, cur, wr, wc, fr, fq);
        if (!has_next) break;
#pragma unroll
        for (int a = 0; a < 2; ++a)
#pragma unroll
            for (int b = 0; b < 2; ++b)
#pragma unroll
                for (int m = 0; m < 4; ++m)
#pragma unroll
                    for (int n = 0; n < 2; ++n) acc[a][b][m][n] = (f32x4){0.f, 0.f, 0.f, 0.f};
        cur = nxt; cA = nA; cB = nB; ++ui; par ^= 1;
        if (wr == 1) PG8_BAR;
    }
    PG8_WAIT_V(0);
    PG8_BAR;
#undef PG8_SA
#undef PG8_SB
#undef PG8_STAGE
#undef PG8_STAGE_A
#undef PG8_LDA
#undef PG8_LDB
#undef PG8_MMA
#undef PG8_WAIT_V
#undef PG8_WAIT_L
#undef PG8_BAR
#undef PG8_SCHED
#undef PG8_STAGE_G
#undef PG8_ROWTAB
#undef PG8_LOADCV
}
}
__device__ __forceinline__ int win_srccol(int n) {
    if (n < 256) return n;
    if (n < 512) return n;
    if (n < 1024) return 772 + (n - 512);
    if (n < 1536) return 1284 + (n - 1024);
    if (n < 2048) return 2316 + (n - 1536);
    if (n < 2304) return 2828 + (n - 2048);
    if (n < 2560) return 3084 + (n - 2304);
    if (n < 2816) return 512 + (n - 2560);
    if (n < 3328) return 1796 + (n - 2816);
    return 3340 + (n - 3328);
}
__device__ __forceinline__ void transpose_item(const float* cp, int ld, bf16_t* WT, int Kd, int k0, int n0, LAS float* scr, int lane) {
    float tmp[32];
#pragma unroll
    for (int i = 0; i < 32; ++i) tmp[i] = cp[(size_t)(k0 + 2 * i + (lane >> 5)) * ld];
#pragma unroll
    for (int i = 0; i < 32; ++i) scr[(2 * i + (lane >> 5)) * 33 + (lane & 31)] = tmp[i];
    asm volatile("s_waitcnt vmcnt(0) lgkmcnt(0)" ::: "memory");
    const int c = lane & 7;
#pragma unroll
    for (int j = 0; j < 4; ++j) { const int n = (lane >> 3) + 8 * j; const LAS float* s = scr + (8 * c) * 33 + n;
        u32x4 o; o.x = pk2(s[0 * 33], s[1 * 33]); o.y = pk2(s[2 * 33], s[3 * 33]); o.z = pk2(s[4 * 33], s[5 * 33]); o.w = pk2(s[6 * 33], s[7 * 33]);
        *(u32x4*)(WT + (size_t)(n0 + n) * Kd + k0 + 8 * c) = o; }
    asm volatile("s_waitcnt lgkmcnt(0)" ::: "memory");
}
__device__ __forceinline__ void load_w12(const float* w_in_l, LAS float* w12, int tid) {
    for (int idx = tid; idx < 3 * 1024; idx += 512) { const int k = idx & 1023, q = idx >> 10; const int col = q == 0 ? 768 : (q == 1 ? 2308 : 2312);
        const f32x4 w = *(const f32x4*)(w_in_l + (size_t)k * INW + col);
        w12[(4 * q + 0) * 1024 + k] = w.x; w12[(4 * q + 1) * 1024 + k] = w.y; w12[(4 * q + 2) * 1024 + k] = w.z; w12[(4 * q + 3) * 1024 + k] = w.w; }
}
__device__ __forceinline__ void gates_row(const f32x4 (&v)[4], const LAS float* w12, const float* bff, const float* bmi, const float* bmf, float* flf, float* mli, float* mlf, int t, int lane) {
    float d[12];
#pragma unroll
    for (int c = 0; c < 12; ++c) { float s = 0.f;
#pragma unroll
        for (int j = 0; j < 4; ++j) { const f32x4 w = *(const LAS f32x4*)(w12 + c * 1024 + 256 * j + 4 * lane); s += (v[j].x * w.x + v[j].y * w.y) + (v[j].z * w.z + v[j].w * w.w); }
        d[c] = wave_sum(s); }
    if (lane < 4 && t >= 0) {
        float a = d[0], b = d[4], c = d[8];
#pragma unroll
        for (int h = 1; h < 4; ++h) { if (lane == h) { a = d[h]; b = d[4 + h]; c = d[8 + h]; } }
        flf[lane * S + t] = log_sigmoid(a + bff[lane]);
        mli[lane * S + t] = b + bmi[lane];
        mlf[lane * S + t] = log_sigmoid(c + bmf[lane]);
    }
}
__device__ __forceinline__ void ln_row(f32x4 (&v)[4], const float* gam, const float* bet, int lane) {
    float s = 0.f;
#pragma unroll
    for (int j = 0; j < 4; ++j) s += (v[j].x + v[j].y) + (v[j].z + v[j].w);
    const float mean = wave_sum(s) * (1.f / DM); float s2 = 0.f;
#pragma unroll
    for (int j = 0; j < 4; ++j) { v[j] = v[j] - mean; s2 += (v[j].x * v[j].x + v[j].y * v[j].y) + (v[j].z * v[j].z + v[j].w * v[j].w); }
    const float rstd = rsqrtf(wave_sum(s2) * (1.f / DM) + EPS);
#pragma unroll
    for (int j = 0; j < 4; ++j) { const f32x4 g = *(const f32x4*)(gam + 256 * j + 4 * lane), b = *(const f32x4*)(bet + 256 * j + 4 * lane); v[j] = v[j] * rstd * g + b; }
}
__device__ __forceinline__ void store_row_bf16(const f32x4 (&v)[4], bf16_t* orow, int lane) {
#pragma unroll
    for (int j = 0; j < 4; ++j) { u32x2 o; o.x = pk2(v[j].x, v[j].y); o.y = pk2(v[j].z, v[j].w); *(u32x2*)(orow + 256 * j + 4 * lane) = o; }
}

__device__ __forceinline__ void p0_prologue(const float* x, const int* pos, const float* w_in, const float* w_out, const float* bff, const float* bmi, const float* bmf,
                                            unsigned char* ws, LAS unsigned char* lds, int tid, int lane, int wave, int bid, int G) {
    LAS float* scr = (LAS float*)(lds + wave * 16384);
    const int gw = bid * 8 + wave, NGW = G * 8;
    constexpr int I_IN = 16 * (NZ / 32), I_OUT = 16 * 32;
    for (int it = gw; it < NL * (I_IN + I_OUT); it += NGW) {
        const int l = it / (I_IN + I_OUT); int r = it % (I_IN + I_OUT);
        if (r < I_IN) { const int kb = r / (NZ / 32), nb = r % (NZ / 32); const int n0 = nb * 32;
            const float* cp = w_in + (size_t)l * DM * INW + win_srccol(n0 + (lane & 31));
            transpose_item(cp, INW, (bf16_t*)(ws + WS_WIN) + (size_t)l * NZ * DM, DM, kb * 64, n0, scr, lane);
        } else { r -= I_IN; const int kb = r / 32, nb = r % 32; const int n0 = nb * 32;
            const float* cp = w_out + (size_t)l * DM * DM + n0 + (lane & 31);
            transpose_item(cp, DM, (bf16_t*)(ws + WS_WOUT) + (size_t)l * DM * DM, DM, kb * 64, n0, scr, lane); }
    }
    {
        const double inv[8] = {1.0, 0.19392274474868576, 0.03760603093086393, 0.007292664737217109, 0.001414213562373095, 0.0002742481756762073, 5.318295896944988e-05, 1.031338537721246e-05};
        float* rt = (float*)(ws + WS_ROPE);
        for (int idx = bid * 512 + tid; idx < S * 8; idx += G * 512) { const int t = idx >> 3, i = idx & 7; double iv = inv[0];
#pragma unroll
            for (int q = 1; q < 8; ++q) iv = (i == q) ? inv[q] : iv;
            const double ang = (double)pos[t] * iv; rt[2 * idx] = (float)cos(ang); rt[2 * idx + 1] = (float)sin(ang); }
    }
    __syncthreads();
    LAS float* w12 = (LAS float*)lds;
    load_w12(w_in, w12, tid);
    __syncthreads();
    float* flf = (float*)(ws + SM_FLF); float* mli = (float*)(ws + SM_MLI); float* mlf = (float*)(ws + SM_MLF);
    bf16_t* xb = (bf16_t*)(ws + WS_ACTB);
#pragma unroll 2
    for (int t = gw; t < S; t += NGW) {
        f32x4 v[4];
#pragma unroll
        for (int j = 0; j < 4; ++j) v[j] = *(const f32x4*)(x + (size_t)t * DM + 256 * j + 4 * lane);
        store_row_bf16(v, xb + (size_t)t * DM, lane);
        gates_row(v, w12, bff, bmi, bmf, flf, mli, mlf, t, lane);
    }
    __syncthreads();
}

__device__ __forceinline__ void moe_weights(const float* w_gate_l, const float* w_up_l, const float* w_down_l, unsigned char* ws, LAS unsigned char* lds, int lane, int wave, int gw, int NGW, int it0, int it1) {
    LAS float* scr = (LAS float*)(lds + wave * 16384);
    constexpr int I_GU = 16 * 32, I_D = 8 * 32;
    for (int it = it0 + gw; it < it1; it += NGW) {
        const int e = it / (I_GU + I_D); int r = it % (I_GU + I_D);
        if (r < I_GU) { const int kb = r / 32, nb = r % 32, n0 = nb * 32; const int n = n0 + (lane & 31); const int a = n >> 3, b = n & 7; const int hid = 4 * a + (b & 3);
            const float* cp = ((b >> 2) ? w_up_l : w_gate_l) + (size_t)e * DM * DE + hid;
            transpose_item(cp, DE, (bf16_t*)(ws + WS_WGU) + (size_t)e * DM * DM, DM, kb * 64, n0, scr, lane);
        } else { r -= I_GU; const int kb = r / 32, nb = r % 32, n0 = nb * 32;
            const float* cp = w_down_l + (size_t)e * DE * DM + n0 + (lane & 31);
            transpose_item(cp, DM, (bf16_t*)(ws + WS_WD) + (size_t)e * DM * DE, DE, kb * 64, n0, scr, lane); }
    }
}
constexpr int MOE_ITEMS = NE * (16 * 32 + 8 * 32);
constexpr int MOE_FILL = 6144;
__device__ __forceinline__ void mix1_unit(int u, unsigned char* ws, unsigned* ctl_kmax, LAS unsigned char* lds, int tid, int lane, int wave) {
    const int blk = u >> 2, h = u & 3, t0 = blk * 256;
    bf16_t* ZR = (bf16_t*)(ws + WS_ZR);
    const float* rope = (const float*)(ws + WS_ROPE);
    LAS float* kr = (LAS float*)lds;
    LAS float* part = (LAS float*)(lds + 16384);
    LAS float* sq = (LAS float*)(lds + 16384 + 2048);
    {
        const int tl = tid & 255, which = tid >> 8; const int t = t0 + tl;
        bf16_t* p = ZR + (size_t)t * ZRW + (which ? ZR_BK : ZR_BQ) + h * 64;
        const u32x4 w0 = *(const u32x4*)p, w1 = *(const u32x4*)(p + 8);
        float u1[8], u2[8];
        u1[0] = bflo(w0.x); u1[1] = bfhi(w0.x); u1[2] = bflo(w0.y); u1[3] = bfhi(w0.y); u1[4] = bflo(w0.z); u1[5] = bfhi(w0.z); u1[6] = bflo(w0.w); u1[7] = bfhi(w0.w);
        u2[0] = bflo(w1.x); u2[1] = bfhi(w1.x); u2[2] = bflo(w1.y); u2[3] = bfhi(w1.y); u2[4] = bflo(w1.z); u2[5] = bfhi(w1.z); u2[6] = bflo(w1.w); u2[7] = bfhi(w1.w);
        float o1[8], o2[8];
#pragma unroll
        for (int i = 0; i < 8; ++i) { const f32x2 cs = *(const f32x2*)(rope + ((size_t)t * 8 + i) * 2); o1[i] = u1[i] * cs.x - u2[i] * cs.y; o2[i] = u1[i] * cs.y + u2[i] * cs.x; }
        u32x4 r0, r1;
        r0.x = pk2(o1[0], o1[1]); r0.y = pk2(o1[2], o1[3]); r0.z = pk2(o1[4], o1[5]); r0.w = pk2(o1[6], o1[7]);
        r1.x = pk2(o2[0], o2[1]); r1.y = pk2(o2[2], o2[3]); r1.z = pk2(o2[4], o2[5]); r1.w = pk2(o2[6], o2[7]);
        *(u32x4*)p = r0; *(u32x4*)(p + 8) = r1;
        if (which) {
            LAS float* d = kr + tl * 16;
            d[0] = bflo(r0.x); d[1] = bfhi(r0.x); d[2] = bflo(r0.y); d[3] = bfhi(r0.y); d[4] = bflo(r0.z); d[5] = bfhi(r0.z); d[6] = bflo(r0.w); d[7] = bfhi(r0.w);
            d[8] = bflo(r1.x); d[9] = bfhi(r1.x); d[10] = bflo(r1.y); d[11] = bfhi(r1.y); d[12] = bflo(r1.z); d[13] = bfhi(r1.z); d[14] = bflo(r1.w); d[15] = bfhi(r1.w);
        }
    }
    {
        const int tl = tid & 255, half = tid >> 8;
        const bf16_t* p = ZR + (size_t)(t0 + tl) * ZRW + ZR_FK + h * 64 + half * 32;
        float s = 0.f;
#pragma unroll
        for (int j = 0; j < 4; ++j) { const u32x4 w = *(const u32x4*)(p + 8 * j);
            float a;
            a = bflo(w.x); s += a * a; a = bfhi(w.x); s += a * a; a = bflo(w.y); s += a * a; a = bfhi(w.y); s += a * a;
            a = bflo(w.z); s += a * a; a = bfhi(w.z); s += a * a; a = bflo(w.w); s += a * a; a = bfhi(w.w); s += a * a; }
        sq[tid] = s;
    }
    __syncthreads();
    {
        const int d = tid & 63, pp = tid >> 6; float s = 0.f;
        if (d < 16) { for (int i = 0; i < 32; ++i) s += kr[(pp * 32 + i) * 16 + d]; }
        else { const bf16_t* p = ZR + (size_t)(t0 + pp * 32) * ZRW + ZR_BK + h * 64 + d; for (int i = 0; i < 32; ++i) s += bf2f(p[(size_t)i * ZRW]); }
        part[pp * 64 + d] = s;
    }
    if (wave < 4) {
        const float* flf = (const float*)(ws + SM_FLF) + (size_t)h * S + t0 + wave * 64;
        float v = flf[lane];
#pragma unroll
        for (int o = 1; o < 64; o <<= 1) { const float n = __shfl_up(v, o); if (lane >= o) v += n; }
        ((float*)(ws + SM_FCL))[(size_t)h * S + t0 + wave * 64 + lane] = v;
        if (lane == 63) ((float*)(ws + SM_FTS))[h * 256 + blk * 4 + wave] = v;
    } else {
        const int i = tid - 256; float m = sq[i] + sq[i + 256];
        m = wave_max(m);
        if (lane == 0) atomicMax(ctl_kmax + h, __builtin_bit_cast(unsigned, m));
    }
    __syncthreads();
    if (tid < 64) { float s = 0.f;
#pragma unroll
        for (int pp = 0; pp < 8; ++pp) s += part[pp * 64 + tid];
        ((float*)(ws + SM_KMEAN))[((size_t)h * 64 + blk) * 64 + tid] = s * (1.f / 256.f); }
    __syncthreads();
}
struct RowState { f32x4 O[4]; float m, l; };
constexpr float LOG2E = 1.4426950408889634f, SC2 = 0.125f * LOG2E;

struct KVFrag { bf16x8 k[4]; u32x2 v[8]; };
__device__ __forceinline__ void kv_fetch(KVFrag& f, const bf16_t* krow, const bf16_t* vT, int kb, int lane) {
    const int qi = lane & 15, g = lane >> 4;
    const bf16_t* k0p = krow + (size_t)(kb + qi) * ZRW + 8 * g;
    const bf16_t* k1p = k0p + (size_t)16 * ZRW;
    f.k[0] = *(const bf16x8*)k0p; f.k[1] = *(const bf16x8*)(k0p + 32); f.k[2] = *(const bf16x8*)k1p; f.k[3] = *(const bf16x8*)(k1p + 32);
#pragma unroll
    for (int dt = 0; dt < 4; ++dt) { const bf16_t* vp = vT + (size_t)(16 * dt + qi) * ZTP + kb + 4 * g; f.v[2 * dt] = *(const u32x2*)vp; f.v[2 * dt + 1] = *(const u32x2*)(vp + 16); }
}
__device__ __forceinline__ void attn_compute32(RowState& st, const bf16x8 (&Qf)[2], const KVFrag& f, const f32x4 b0, const f32x4 b1) {
    f32x4 s0 = {0.f, 0.f, 0.f, 0.f}, s1 = {0.f, 0.f, 0.f, 0.f};
    s0 = MFMA16(f.k[0], Qf[0], s0); s0 = MFMA16(f.k[1], Qf[1], s0);
    s1 = MFMA16(f.k[2], Qf[0], s1); s1 = MFMA16(f.k[3], Qf[1], s1);
    float mx = -INFINITY;
#pragma unroll
    for (int r = 0; r < 4; ++r) { s0[r] = s0[r] * SC2 + b0[r]; s1[r] = s1[r] * SC2 + b1[r]; mx = fmaxf(mx, fmaxf(s0[r], s1[r])); }
    mx = grp_max(mx);
    float ps = 0.f; float p0[4], p1[4];
    if (__all(mx <= st.m)) {
#pragma unroll
        for (int r = 0; r < 4; ++r) { p0[r] = __builtin_amdgcn_exp2f(s0[r] - st.m); p1[r] = __builtin_amdgcn_exp2f(s1[r] - st.m); ps += p0[r] + p1[r]; }
        st.l += ps;
    } else {
        const float mn = fmaxf(st.m, mx);
        const float msafe = (mn == -INFINITY) ? 0.f : mn;
        const float alpha = __builtin_amdgcn_exp2f(st.m - msafe);
#pragma unroll
        for (int r = 0; r < 4; ++r) { p0[r] = __builtin_amdgcn_exp2f(s0[r] - msafe); p1[r] = __builtin_amdgcn_exp2f(s1[r] - msafe); ps += p0[r] + p1[r]; }
        st.l = st.l * alpha + ps; st.m = mn;
#pragma unroll
        for (int dt = 0; dt < 4; ++dt) st.O[dt] = st.O[dt] * alpha;
    }
    u32x4 pw; pw.x = pk2(p0[0], p0[1]); pw.y = pk2(p0[2], p0[3]); pw.z = pk2(p1[0], p1[1]); pw.w = pk2(p1[2], p1[3]);
    const bf16x8 pb = __builtin_bit_cast(bf16x8, pw);
#pragma unroll
    for (int dt = 0; dt < 4; ++dt) { u32x4 vw; vw.x = f.v[2 * dt].x; vw.y = f.v[2 * dt].y; vw.z = f.v[2 * dt + 1].x; vw.w = f.v[2 * dt + 1].y;
        st.O[dt] = MFMA16(__builtin_bit_cast(bf16x8, vw), pb, st.O[dt]); }
}
__device__ __forceinline__ void attn_finish(RowState& st, const float* gain, bf16_t* yrow, int lane) {
    const int g = lane >> 4;
    const float inv = 1.f / st.l; float ss = 0.f;
#pragma unroll
    for (int dt = 0; dt < 4; ++dt) { st.O[dt] = st.O[dt] * inv; ss += (st.O[dt].x * st.O[dt].x + st.O[dt].y * st.O[dt].y) + (st.O[dt].z * st.O[dt].z + st.O[dt].w * st.O[dt].w); }
    ss = grp_sum(ss);
    const float rs = rsqrtf(ss * (1.f / 64.f) + EPS);
#pragma unroll
    for (int dt = 0; dt < 4; ++dt) { const f32x4 gg = *(const f32x4*)(gain + 16 * dt + 4 * g); const f32x4 o = st.O[dt] * rs * gg;
        u32x2 w; w.x = pk2(o.x, o.y); w.y = pk2(o.z, o.w); *(u32x2*)(yrow + 16 * dt + 4 * g) = w; }
}

constexpr int KS_PITCH = 72, VS_PITCH = 264, KS_BYTES = 256 * KS_PITCH * 2, VS_BYTES = 64 * VS_PITCH * 2;
__device__ __forceinline__ void stage_kv_block(const bf16_t* krow  , const bf16_t* vT  , int key0, LAS unsigned char* lds, int tid) {
    LAS unsigned char* Ks = lds; LAS unsigned char* Vs = lds + KS_BYTES;
#pragma unroll
    for (int i = 0; i < 4; ++i) { const int c = tid + 512 * i; const int row = c >> 3, part = c & 7;
        const u32x4 v = *(const u32x4*)(krow + (size_t)(key0 + row) * ZRW + part * 8);
        *(LAS u32x4*)(Ks + row * (KS_PITCH * 2) + part * 16) = v; }
#pragma unroll
    for (int i = 0; i < 4; ++i) { const int c = tid + 512 * i; const int row = c >> 5, part = c & 31;
        const u32x4 v = *(const u32x4*)(vT + (size_t)row * ZTP + key0 + part * 8);
        *(LAS u32x4*)(Vs + row * (VS_PITCH * 2) + part * 16) = v; }
}
template <int VPB>
__device__ __forceinline__ void attn_step32_ldsp(RowState& st, const bf16x8 (&Qf)[2], LAS unsigned char* Ks, LAS unsigned char* Vs, int kb, const f32x4 b0, const f32x4 b1, int lane) {
    const int qi = lane & 15, g = lane >> 4;
    f32x4 s0 = {0.f, 0.f, 0.f, 0.f}, s1 = {0.f, 0.f, 0.f, 0.f};
    const LAS unsigned char* k0p = Ks + (kb + qi) * (KS_PITCH * 2) + 16 * g;
    const LAS unsigned char* k1p = k0p + 16 * (KS_PITCH * 2);
    s0 = MFMA16(*(const LAS bf16x8*)k0p, Qf[0], s0); s0 = MFMA16(*(const LAS bf16x8*)(k0p + 64), Qf[1], s0);
    s1 = MFMA16(*(const LAS bf16x8*)k1p, Qf[0], s1); s1 = MFMA16(*(const LAS bf16x8*)(k1p + 64), Qf[1], s1);
    float mx = -INFINITY;
#pragma unroll
    for (int r = 0; r < 4; ++r) { s0[r] = s0[r] * SC2 + b0[r]; s1[r] = s1[r] * SC2 + b1[r]; mx = fmaxf(mx, fmaxf(s0[r], s1[r])); }
    mx = grp_max(mx);
    float ps = 0.f; float p0[4], p1[4];
    if (__all(mx <= st.m)) {
#pragma unroll
        for (int r = 0; r < 4; ++r) { p0[r] = __builtin_amdgcn_exp2f(s0[r] - st.m); p1[r] = __builtin_amdgcn_exp2f(s1[r] - st.m); ps += p0[r] + p1[r]; }
        st.l += ps;
    } else {
        const float mn = fmaxf(st.m, mx);
        const float msafe = (mn == -INFINITY) ? 0.f : mn;
        const float alpha = __builtin_amdgcn_exp2f(st.m - msafe);
#pragma unroll
        for (int r = 0; r < 4; ++r) { p0[r] = __builtin_amdgcn_exp2f(s0[r] - msafe); p1[r] = __builtin_amdgcn_exp2f(s1[r] - msafe); ps += p0[r] + p1[r]; }
        st.l = st.l * alpha + ps; st.m = mn;
#pragma unroll
        for (int dt = 0; dt < 4; ++dt) st.O[dt] = st.O[dt] * alpha;
    }
    u32x4 pw; pw.x = pk2(p0[0], p0[1]); pw.y = pk2(p0[2], p0[3]); pw.z = pk2(p1[0], p1[1]); pw.w = pk2(p1[2], p1[3]);
    const bf16x8 pb = __builtin_bit_cast(bf16x8, pw);
#pragma unroll
    for (int dt = 0; dt < 4; ++dt) { const LAS unsigned char* vp = Vs + (16 * dt + qi) * VPB + (kb + 4 * g) * 2;
        u32x4 vw; const u32x2 lo = *(const LAS u32x2*)vp, hi = *(const LAS u32x2*)(vp + 32); vw.x = lo.x; vw.y = lo.y; vw.z = hi.x; vw.w = hi.y;
        st.O[dt] = MFMA16(__builtin_bit_cast(bf16x8, vw), pb, st.O[dt]); }
}

__device__ __forceinline__ void attn_step32_lds(RowState& st, const bf16x8 (&Qf)[2], LAS unsigned char* lds, int kb, const f32x4 b0, const f32x4 b1, int lane) {
    attn_step32_ldsp<VS_PITCH * 2>(st, Qf, lds, lds + KS_BYTES, kb, b0, b1, lane);
}

constexpr int FW_KEYS = 384, FW_VPB = (FW_KEYS + 8) * 2, FW_KBYTES = FW_KEYS * KS_PITCH * 2, FW_VBYTES = 64 * FW_VPB;
__device__ __forceinline__ void fox_unit(int h, int qt, unsigned char* ws, float kmaxn, const float* g_fox, LAS unsigned char* lds, int tid, int lane, int wave, int cap = 1 << 30, bf16_t* ydst = nullptr) {
    const int qi = lane & 15, g = lane >> 4;
    const int Q0 = qt * 128, q0 = Q0 + wave * 16, q = q0 + qi;
    const bf16_t* ZR = (const bf16_t*)(ws + WS_ZR); const bf16_t* ZT = (const bf16_t*)(ws + WS_ZT);
    const float* clh = (const float*)(ws + SM_FCL) + (size_t)h * S; const float* tsum = (const float*)(ws + SM_FTS) + h * 256;
    const bf16_t* krow = ZR + ZR_FK + h * 64; const bf16_t* vT = ZT + (size_t)(ZT_FV + h * 64) * ZTP;
    LAS unsigned char* Kw = lds; LAS unsigned char* Vw = lds + FW_KBYTES; LAS float* clw = (LAS float*)(lds + FW_KBYTES + FW_VBYTES);
    const int kw0 = Q0 >= 256 ? Q0 - 256 : 0, nk = Q0 + 128 - kw0;
    __syncthreads();
    for (int c = tid; c < nk * 8; c += 512) { const int row = c >> 3, part = c & 7;
        *(LAS u32x4*)(Kw + row * (KS_PITCH * 2) + part * 16) = *(const u32x4*)(krow + (size_t)(kw0 + row) * ZRW + part * 8); }
    { const int cpr = nk >> 3;
      for (int c = tid; c < 64 * cpr; c += 512) { const int row = c / cpr, part = c - row * cpr;
        *(LAS u32x4*)(Vw + row * FW_VPB + part * 16) = *(const u32x4*)(vT + (size_t)row * ZTP + kw0 + part * 8); } }
    for (int c = tid; c < nk; c += 512) clw[c] = clh[kw0 + c] * LOG2E;
    const bf16_t* qrow = ZR + (size_t)q * ZRW + ZR_FQ + h * 64;
    bf16x8 Qf[2]; Qf[0] = *(const bf16x8*)(qrow + 8 * g); Qf[1] = *(const bf16x8*)(qrow + 32 + 8 * g);
    float qs = 0.f;
#pragma unroll
    for (int k = 0; k < 2; ++k)
#pragma unroll
        for (int e = 0; e < 8; ++e) { const float v = bf2f((unsigned short)Qf[k][e]); qs += v * v; }
    const float qn = sqrtf(grp_sum(qs));
    const float cq = clh[q] * LOG2E;
    RowState st;
#pragma unroll
    for (int dt = 0; dt < 4; ++dt) st.O[dt] = (f32x4){0.f, 0.f, 0.f, 0.f};
    st.m = -INFINITY; st.l = 0.f;
    __syncthreads();
    float dT = 0.f; int ktile = q0 >> 6;
    int kb = q0 & ~31;
    bool more = true;
    for (; kb >= kw0; kb -= 32) {
        const int kt = kb >> 6;
        if (kt != ktile) { dT += tsum[kt] * LOG2E; ktile = kt; }
        const float bq = cq + dT; const int kl = kb - kw0;
        const f32x4 c0 = *(const LAS f32x4*)(clw + kl + 4 * g), c1 = *(const LAS f32x4*)(clw + kl + 16 + 4 * g);
        f32x4 b0, b1;
#pragma unroll
        for (int r = 0; r < 4; ++r) { b0[r] = (kb + 4 * g + r <= q) ? bq - c0[r] : -INFINITY; b1[r] = (kb + 16 + 4 * g + r <= q) ? bq - c1[r] : -INFINITY; }
        attn_step32_ldsp<FW_VPB>(st, Qf, Kw, Vw, kl, b0, b1, lane);
        if (kb == 0) { more = false; break; }
        const float bound = qn * kmaxn * SC2 + (bq - clw[kl]);
        if (__all(bound < st.m - 40.f * LOG2E)) { more = false; break; }
        if (--cap <= 0) { more = false; break; }
    }
    if (more) {
        KVFrag cur, nxt;
        kv_fetch(cur, krow, vT, kb, lane);
        for (; kb >= 0; kb -= 32) {
            if (kb >= 32) kv_fetch(nxt, krow, vT, kb - 32, lane);
            const int kt = kb >> 6;
            if (kt != ktile) { dT += tsum[kt] * LOG2E; ktile = kt; }
            const float bq = cq + dT;
            const f32x4 c0 = *(const f32x4*)(clh + kb + 4 * g), c1 = *(const f32x4*)(clh + kb + 16 + 4 * g);
            f32x4 b0, b1;
#pragma unroll
            for (int r = 0; r < 4; ++r) { b0[r] = bq - c0[r] * LOG2E; b1[r] = bq - c1[r] * LOG2E; }
            attn_compute32(st, Qf, cur, b0, b1);
            if (kb == 0) break;
            const float bound = qn * kmaxn * SC2 + (bq - clh[kb] * LOG2E);
            if (__all(bound < st.m - 40.f * LOG2E)) break;
            cur = nxt;
        }
    }
    st.l = grp_sum(st.l);
    attn_finish(st, g_fox + h * 64, (ydst ? ydst : (bf16_t*)(ws + WS_Y)) + (size_t)q * DM + h * 64, lane);
}

__device__ __forceinline__ void moba_gate_unit(int h, int qt, unsigned char* ws, LAS unsigned char* lds, int tid, int lane, int wave) {
    const int own = qt >> 1;
    unsigned* msel = (unsigned*)(ws + SM_MSEL) + (size_t)h * S;
    int* cntq = (int*)(ws + SM_CNTQ) + (size_t)h * 64 * 128;
    const int tq0 = qt * 128 + wave * 16;
    if (own == 0) { if (lane < 16) msel[tq0 + lane] = 0u; if (tid < 64) cntq[tid * 128 + qt] = 0; return; }
    LAS int* hist = (LAS int*)lds;
    __syncthreads();
    if (tid < 64) hist[tid] = 0;
    __syncthreads();
    const int qi = lane & 15, g = lane >> 4;
    const bf16_t* qrow = (const bf16_t*)(ws + WS_ZR) + (size_t)(tq0 + qi) * ZRW + ZR_BQ + h * 64;
    bf16x8 Qf[2]; Qf[0] = *(const bf16x8*)(qrow + 8 * g); Qf[1] = *(const bf16x8*)(qrow + 32 + 8 * g);
    const float* kmean = (const float*)(ws + SM_KMEAN) + (size_t)h * 64 * 64;
    float v[16];
#pragma unroll
    for (int tile = 0; tile < 4; ++tile) {
        f32x4 acc = {0.f, 0.f, 0.f, 0.f};
#pragma unroll
        for (int ks = 0; ks < 2; ++ks) {
            const float* kp = kmean + (size_t)(16 * tile + qi) * 64 + 32 * ks + 8 * g;
            const f32x4 a0 = *(const f32x4*)kp, a1 = *(const f32x4*)(kp + 4);
            u32x4 hi, lo;
            hi.x = pk2(a0.x, a0.y); hi.y = pk2(a0.z, a0.w); hi.z = pk2(a1.x, a1.y); hi.w = pk2(a1.z, a1.w);
            lo.x = pk2(a0.x - bflo(hi.x), a0.y - bfhi(hi.x)); lo.y = pk2(a0.z - bflo(hi.y), a0.w - bfhi(hi.y));
            lo.z = pk2(a1.x - bflo(hi.z), a1.y - bfhi(hi.z)); lo.w = pk2(a1.z - bflo(hi.w), a1.w - bfhi(hi.w));
            acc = MFMA16(__builtin_bit_cast(bf16x8, hi), Qf[ks], acc);
            acc = MFMA16(__builtin_bit_cast(bf16x8, lo), Qf[ks], acc);
        }
#pragma unroll
        for (int r = 0; r < 4; ++r) v[4 * tile + r] = (16 * tile + 4 * g + r < own) ? acc[r] : -INFINITY;
    }
    const int nv = own < 3 ? own : 3;
    unsigned sel = 0u;
#pragma unroll
    for (int k = 0; k < 3; ++k) {
        float lm = v[0]; int li = 4 * g;
#pragma unroll
        for (int e = 1; e < 16; ++e) { const int jj = 16 * (e >> 2) + 4 * g + (e & 3); if (v[e] > lm) { lm = v[e]; li = jj; } }
        const float gm = grp_max(lm);
        int cand = (lm == gm) ? li : 255;
        cand = min(cand, __shfl_xor(cand, 16)); cand = min(cand, __shfl_xor(cand, 32));
        sel |= (unsigned)cand << (8 * k);
#pragma unroll
        for (int e = 0; e < 16; ++e) { const int jj = 16 * (e >> 2) + 4 * g + (e & 3); if (jj == cand) v[e] = -INFINITY; }
    }
    if (g < nv) { const int j = (int)((sel >> (8 * g)) & 0xff);
        const int pos = __hip_atomic_fetch_add(hist + j, 1, __ATOMIC_RELAXED, __HIP_MEMORY_SCOPE_WORKGROUP);
        ((unsigned short*)(ws + T_QIDX))[(((size_t)h * 64 + j) * 128 + qt) * 128 + pos] = (unsigned short)((wave * 16 + qi) | (g << 7)); }
    if (g == 0) msel[tq0 + qi] = (sel & 0xffffffu) | ((unsigned)nv << 24);
    __syncthreads();
    if (tid < 64) cntq[tid * 128 + qt] = hist[tid];
}

__device__ __forceinline__ void moba_part_unit(int h, int j, int ch, int tot, unsigned char* ws, LAS unsigned char* lds, LAS unsigned char* ltab, int tid, int lane, int wave, int dbg = 0, bool staged = false) {
    LAS int* pfx = (LAS int*)(ltab + 2112);
    LAS unsigned* slice = (LAS unsigned*)(ltab + 2640);
    LAS int* wtot = (LAS int*)(ltab + 3664);
    const unsigned* msel = (const unsigned*)(ws + SM_MSEL) + (size_t)h * S;
    const int* cntq = (const int*)(ws + SM_CNTQ) + ((size_t)h * 64 + j) * 128;
    const bf16_t* ZR = (const bf16_t*)(ws + WS_ZR); const bf16_t* ZT = (const bf16_t*)(ws + WS_ZT);
    __syncthreads();
    if (!staged) stage_kv_block(ZR + ZR_BK + h * 64, ZT + (size_t)(ZT_BV + h * 64) * ZTP, j * 256, lds, tid);
    if (!staged && wave == 0) {
        int v0 = cntq[lane], v1 = cntq[64 + lane];
#pragma unroll
        for (int o = 1; o < 64; o <<= 1) { const int n0 = __shfl_up(v0, o), n1 = __shfl_up(v1, o); if (lane >= o) { v0 += n0; v1 += n1; } }
        v1 += __shfl(v0, 63);
        if (lane == 0) pfx[0] = 0;
        pfx[1 + lane] = v0; pfx[65 + lane] = v1;
    }
    __syncthreads();
    const int lo_pos = 256 * ch, hi_pos = (lo_pos + 256 < tot) ? lo_pos + 256 : tot;
    if (tid < hi_pos - lo_pos) {
        const int pos = lo_pos + tid;
        int a = 0, b = 127; while (a < b) { const int mid = (a + b + 1) >> 1; if (pfx[mid] <= pos) a = mid; else b = mid - 1; }
        const unsigned w = ((const unsigned short*)(ws + T_QIDX))[(((size_t)h * 64 + j) * 128 + a) * 128 + (pos - pfx[a])];
        slice[tid] = (unsigned)(a * 128 + (w & 127u)) | ((w >> 7) << 14);
    }
    __syncthreads();
    const int n = hi_pos - lo_pos;
    const int qi = lane & 15, g = lane >> 4;
    const int pA = wave * 16, pB = 128 + wave * 16;
    if (pA >= n) return;
    const bool hasB = pB < n;
    const bool vA = pA + qi < n, vB = pB + qi < n;
    const unsigned eA = slice[vA ? pA + qi : n - 1], eB = slice[vB ? pB + qi : n - 1];
    const int tA = eA & 0x3fff, rA = eA >> 14, tB = eB & 0x3fff, rB = eB >> 14;
    const bf16_t* qrA = ZR + (size_t)tA * ZRW + ZR_BQ + h * 64; const bf16_t* qrB = ZR + (size_t)tB * ZRW + ZR_BQ + h * 64;
    bf16x8 QA[2], QB[2]; QA[0] = *(const bf16x8*)(qrA + 8 * g); QA[1] = *(const bf16x8*)(qrA + 32 + 8 * g); QB[0] = *(const bf16x8*)(qrB + 8 * g); QB[1] = *(const bf16x8*)(qrB + 32 + 8 * g);
    RowState sA, sB;
#pragma unroll
    for (int dt = 0; dt < 4; ++dt) { sA.O[dt] = (f32x4){0.f, 0.f, 0.f, 0.f}; sB.O[dt] = (f32x4){0.f, 0.f, 0.f, 0.f}; }
    sA.m = -INFINITY; sA.l = 0.f; sB.m = -INFINITY; sB.l = 0.f;
    const f32x4 z = {0.f, 0.f, 0.f, 0.f};
    if (dbg & 1) { sA.l = 1.f; sB.l = 1.f; sA.m = 0.f; sB.m = 0.f; }
    else if (hasB) {
#pragma unroll 4
        for (int kb = 0; kb < 256; kb += 32) { attn_step32_lds(sA, QA, lds, kb, z, z, lane); attn_step32_lds(sB, QB, lds, kb, z, z, lane); } }
    else {
#pragma unroll 4
        for (int kb = 0; kb < 256; kb += 32) attn_step32_lds(sA, QA, lds, kb, z, z, lane); }
    if (dbg & 2) return;
    sA.l = grp_sum(sA.l);
    if (vA) {
        const float inv = 1.f / sA.l;
        bf16_t* po = (bf16_t*)(ws + T_MPO) + (((size_t)h * S + tA) * 3 + rA) * 64;
#pragma unroll
        for (int dt = 0; dt < 4; ++dt) { const f32x4 o = sA.O[dt] * inv; u32x2 w; w.x = pk2(o.x, o.y); w.y = pk2(o.z, o.w); *(u32x2*)(po + 16 * dt + 4 * g) = w; }
        if (g == 0) { float* pm = (float*)(ws + T_MPML) + (((size_t)h * S + tA) * 3 + rA) * 2; pm[0] = sA.m; pm[1] = sA.l; }
    }
    if (hasB) {
        sB.l = grp_sum(sB.l);
        if (vB) {
            const float inv = 1.f / sB.l;
            bf16_t* po = (bf16_t*)(ws + T_MPO) + (((size_t)h * S + tB) * 3 + rB) * 64;
#pragma unroll
            for (int dt = 0; dt < 4; ++dt) { const f32x4 o = sB.O[dt] * inv; u32x2 w; w.x = pk2(o.x, o.y); w.y = pk2(o.z, o.w); *(u32x2*)(po + 16 * dt + 4 * g) = w; }
            if (g == 0) { float* pm = (float*)(ws + T_MPML) + (((size_t)h * S + tB) * 3 + rB) * 2; pm[0] = sB.m; pm[1] = sB.l; }
        }
    }
}

__device__ __forceinline__ void moba_own_unit(int h, int ob, unsigned char* ws, const float* g_moba, LAS unsigned char* lds, int tid, int lane, int wave) {
    const int qi = lane & 15, g = lane >> 4;
    const bf16_t* ZR = (const bf16_t*)(ws + WS_ZR); const bf16_t* ZT = (const bf16_t*)(ws + WS_ZT);
    __syncthreads();
    stage_kv_block(ZR + ZR_BK + h * 64, ZT + (size_t)(ZT_BV + h * 64) * ZTP, ob * 256, lds, tid);
    __syncthreads();
    const int nv = ob < 3 ? ob : 3;
    for (int pass = 0; pass < 2; ++pass) {
        const int ql0 = pass * 128 + wave * 16, ql = ql0 + qi, q = ob * 256 + ql;
        const bf16_t* qrow = ZR + (size_t)q * ZRW + ZR_BQ + h * 64;
        bf16x8 Qf[2]; Qf[0] = *(const bf16x8*)(qrow + 8 * g); Qf[1] = *(const bf16x8*)(qrow + 32 + 8 * g);
        RowState st;
#pragma unroll
        for (int dt = 0; dt < 4; ++dt) st.O[dt] = (f32x4){0.f, 0.f, 0.f, 0.f};
        st.m = -INFINITY; st.l = 0.f;
        for (int kb = ql0 & ~31; kb >= 0; kb -= 32) {
            f32x4 b0, b1;
#pragma unroll
            for (int r = 0; r < 4; ++r) { b0[r] = (kb + 4 * g + r <= ql) ? 0.f : -INFINITY; b1[r] = (kb + 16 + 4 * g + r <= ql) ? 0.f : -INFINITY; }
            attn_step32_lds(st, Qf, lds, kb, b0, b1, lane);
        }
        st.l = grp_sum(st.l);
        for (int rk = 0; rk < nv; ++rk) {
            const float* pm = (const float*)(ws + T_MPML) + (((size_t)h * S + q) * 3 + rk) * 2;
            const float mk = pm[0], lk = pm[1];
            const float M = fmaxf(st.m, mk);
            const float a = __builtin_amdgcn_exp2f(st.m - M), b = lk * __builtin_amdgcn_exp2f(mk - M);
            const bf16_t* po = (const bf16_t*)(ws + T_MPO) + (((size_t)h * S + q) * 3 + rk) * 64;
#pragma unroll
            for (int dt = 0; dt < 4; ++dt) { const u32x2 w = *(const u32x2*)(po + 16 * dt + 4 * g);
                const f32x4 ok = {bflo(w.x), bfhi(w.x), bflo(w.y), bfhi(w.y)};
                st.O[dt] = st.O[dt] * a + ok * b; }
            st.l = st.l * a + b; st.m = M;
        }
        attn_finish(st, g_moba + h * 64, (bf16_t*)(ws + WS_Y) + (size_t)q * DM + 768 + h * 64, lane);
    }
}
constexpr int KT_PITCH = 136;

__device__ __forceinline__ void mlstm_local_unit(int h, int c, unsigned char* ws, const float* conv_w_l, LAS unsigned char* lds, int tid, int lane, int wave) {
    const int t0 = c * 128;
    LAS float* sws = (LAS float*)lds;
    LAS bf16_t* kT = (LAS bf16_t*)(lds + 1024);
    __syncthreads();
    if (wave == 0) {
        const float* mlf = (const float*)(ws + SM_MLF) + (size_t)h * S + t0; const float* mli = (const float*)(ws + SM_MLI) + (size_t)h * S + t0;
        float v0 = mlf[lane], v1 = mlf[64 + lane];
#pragma unroll
        for (int o = 1; o < 64; o <<= 1) { const float n0 = __shfl_up(v0, o), n1 = __shfl_up(v1, o); if (lane >= o) { v0 += n0; v1 += n1; } }
        const float tot0 = __shfl(v0, 63); v1 += tot0;
        const float blast = __shfl(v1, 63);
        const float li0 = mli[lane], li1 = mli[64 + lane];
        const float g0 = blast - v0 + li0, g1 = blast - v1 + li1;
        const float mloc = wave_max(fmaxf(g0, g1));
        sws[lane] = __expf(g0 - mloc); sws[64 + lane] = __expf(g1 - mloc);
        const float a0 = li0 - v0, a1 = li1 - v1;
        float p0 = a0, p1 = a1;
#pragma unroll
        for (int o = 1; o < 64; o <<= 1) { const float n0 = __shfl_up(p0, o), n1 = __shfl_up(p1, o); if (lane >= o) { p0 = fmaxf(p0, n0); p1 = fmaxf(p1, n1); } }
        p1 = fmaxf(p1, __shfl(p0, 63));
        float* mb = (float*)(ws + SM_MB) + (size_t)h * S + t0; float* ma = (float*)(ws + SM_MA) + (size_t)h * S + t0; float* mpx = (float*)(ws + SM_MPX) + (size_t)h * S + t0;
        mb[lane] = v0; mb[64 + lane] = v1; ma[lane] = a0; ma[64 + lane] = a1; mpx[lane] = p0; mpx[64 + lane] = p1;
        if (lane == 0) { float* sc = (float*)(ws + SM_MLSC); sc[h * 128 + c] = blast; sc[512 + h * 128 + c] = mloc; }
    }
    __syncthreads();
    {
        const bf16_t* ZR = (const bf16_t*)(ws + WS_ZR);
        bf16_t* QC = (bf16_t*)(ws + T_QC); bf16_t* KC = (bf16_t*)(ws + T_KC);
        const int r = tid & 31, which = r >> 4, cg = r & 15, tb = tid >> 5;
        const int ch = h * 128 + 8 * cg;
        float cw[4][8];
#pragma unroll
        for (int j = 0; j < 4; ++j) { const f32x4 c0 = *(const f32x4*)(conv_w_l + (size_t)j * 1024 + which * 512 + ch), c1 = *(const f32x4*)(conv_w_l + (size_t)j * 1024 + which * 512 + ch + 4);
            cw[j][0] = c0.x; cw[j][1] = c0.y; cw[j][2] = c0.z; cw[j][3] = c0.w; cw[j][4] = c1.x; cw[j][5] = c1.y; cw[j][6] = c1.z; cw[j][7] = c1.w; }
        const bf16_t* src = ZR + (which ? ZR_MK : ZR_MQ) + ch;
        u32x4 rw[11];
#pragma unroll
        for (int q = 0; q < 11; ++q) { const int tt = t0 + 8 * tb - 3 + q; rw[q] = (tt >= 0) ? *(const u32x4*)(src + (size_t)tt * ZRW) : (u32x4){0u, 0u, 0u, 0u}; }
        const float sc = which ? 0.08838834764831845f : 1.f;
#pragma unroll
        for (int q = 0; q < 8; ++q) {
            const int sl = 8 * tb + q;
            float acc[8];
#pragma unroll
            for (int e = 0; e < 8; ++e) acc[e] = 0.f;
#pragma unroll
            for (int j = 0; j < 4; ++j) { const u32x4 w = rw[q + j];
                acc[0] += bflo(w.x) * cw[j][0]; acc[1] += bfhi(w.x) * cw[j][1]; acc[2] += bflo(w.y) * cw[j][2]; acc[3] += bfhi(w.y) * cw[j][3];
                acc[4] += bflo(w.z) * cw[j][4]; acc[5] += bfhi(w.z) * cw[j][5]; acc[6] += bflo(w.w) * cw[j][6]; acc[7] += bfhi(w.w) * cw[j][7]; }
#pragma unroll
            for (int e = 0; e < 8; ++e) acc[e] = siluf(acc[e]) * sc;
            u32x4 o; o.x = pk2(acc[0], acc[1]); o.y = pk2(acc[2], acc[3]); o.z = pk2(acc[4], acc[5]); o.w = pk2(acc[6], acc[7]);
            *(u32x4*)((which ? KC : QC) + (size_t)(t0 + sl) * 512 + ch) = o;
            if (which) { const float w = sws[sl];
#pragma unroll
                for (int e = 0; e < 8; ++e) kT[(8 * cg + e) * KT_PITCH + sl] = (bf16_t)f2bf(acc[e] * w); }
        }
    }
    __syncthreads();
    {
        const int i = lane & 15, g = lane >> 4;
        const bf16_t* vT = (const bf16_t*)(ws + WS_ZT) + (size_t)(ZT_MV + h * 128 + 16 * wave + i) * ZTP + t0;
        f32x4 acc[8];
#pragma unroll
        for (int n = 0; n < 8; ++n) acc[n] = (f32x4){0.f, 0.f, 0.f, 0.f};
#pragma unroll
        for (int ks = 0; ks < 4; ++ks) {
            const bf16x8 a = *(const bf16x8*)(vT + 32 * ks + 8 * g);
#pragma unroll
            for (int n = 0; n < 8; ++n) { const bf16x8 b = *(const LAS bf16x8*)(kT + (16 * n + i) * KT_PITCH + 32 * ks + 8 * g); acc[n] = MFMA16(a, b, acc[n]); }
        }
        float* U = (float*)(ws + T_U) + ((size_t)(h * 128 + c) * 128) * 128;
#pragma unroll
        for (int n = 0; n < 8; ++n)
#pragma unroll
            for (int r = 0; r < 4; ++r) U[(size_t)(16 * wave + 4 * g + r) * 128 + 16 * n + i] = acc[n][r];
    }
    {
        const int i = lane & 15, g = lane >> 4;
        const bf16x8 ones = {(short)0x3f80, (short)0x3f80, (short)0x3f80, (short)0x3f80, (short)0x3f80, (short)0x3f80, (short)0x3f80, (short)0x3f80};
        f32x4 acc = {0.f, 0.f, 0.f, 0.f};
#pragma unroll
        for (int ks = 0; ks < 4; ++ks) { const bf16x8 b = *(const LAS bf16x8*)(kT + (16 * wave + i) * KT_PITCH + 32 * ks + 8 * g); acc = MFMA16(ones, b, acc); }
        if (g == 0) ((float*)(ws + SM_NLOC))[(size_t)(h * 128 + c) * 128 + 16 * wave + i] = acc[0];
    }
}

__device__ __forceinline__ void mlstm_scan(unsigned char* ws, LAS unsigned char* lds, int tid, int lane, int wave, int bid) {
    if (bid >= 256) return;
    const int h = bid >> 6;
    LAS float* dec = (LAS float*)lds; LAS float* scl = dec + 128;
    __syncthreads();
    if (wave == 0) {
        const float* sc = (const float*)(ws + SM_MLSC);
        const float bl0 = sc[h * 128 + lane], bl1 = sc[h * 128 + 64 + lane], ml0 = sc[512 + h * 128 + lane], ml1 = sc[512 + h * 128 + 64 + lane];
        float m = 0.f, mA = 0.f, mB = 0.f;
#pragma unroll 8
        for (int c = 0; c < 64; ++c) { if (lane == c) mA = m; m = fmaxf(__shfl(bl0, c) + m, __shfl(ml0, c)); }
#pragma unroll 8
        for (int c = 0; c < 64; ++c) { if (lane == c) mB = m; m = fmaxf(__shfl(bl1, c) + m, __shfl(ml1, c)); }
        const float mA1 = fmaxf(bl0 + mA, ml0), mB1 = fmaxf(bl1 + mB, ml1);
        dec[lane] = __expf(bl0 + mA - mA1); scl[lane] = __expf(ml0 - mA1); dec[64 + lane] = __expf(bl1 + mB - mB1); scl[64 + lane] = __expf(ml1 - mB1);
        if ((bid & 63) == 0) { float* mst = (float*)(ws + SM_MLSC) + 1024 + h * 128; mst[lane] = mA; mst[64 + lane] = mB; }
    }
    __syncthreads();
    if (tid < 256) {
        const int el = (bid & 63) * 256 + tid;
        const float* U = (const float*)(ws + T_U) + (size_t)h * 128 * 16384 + el;
        bf16_t* CS = (bf16_t*)(ws + T_CST) + (size_t)h * 128 * 16384 + el;
        float C = 0.f;
        for (int c0 = 0; c0 < 128; c0 += 32) { float u[32];
#pragma unroll
            for (int q = 0; q < 32; ++q) u[q] = U[(size_t)(c0 + q) * 16384];
#pragma unroll
            for (int q = 0; q < 32; ++q) { CS[(size_t)(c0 + q) * 16384] = (bf16_t)f2bf(C); C = dec[c0 + q] * C + scl[c0 + q] * u[q]; } }
    } else if (tid < 258) {
        const int el = (bid & 63) * 2 + (tid - 256);
        const float* NL_ = (const float*)(ws + SM_NLOC) + (size_t)h * 128 * 128 + el;
        float* NS = (float*)(ws + SM_NST) + (size_t)h * 128 * 128 + el;
        float n = 0.f;
        for (int c0 = 0; c0 < 128; c0 += 32) { float u[32];
#pragma unroll
            for (int q = 0; q < 32; ++q) u[q] = NL_[(c0 + q) * 128];
#pragma unroll
            for (int q = 0; q < 32; ++q) { NS[(c0 + q) * 128] = n; n = dec[c0 + q] * n + scl[c0 + q] * u[q]; } }
    }
}

constexpr int ML_PITCHB = 272, ML_MAT = 128 * ML_PITCHB;
__device__ __forceinline__ void mlstm_out_unit(int h, int c, unsigned char* ws, const float* g_mlstm, LAS unsigned char* lds, int tid, int lane, int wave) {
    const int i = lane & 15, g = lane >> 4;
    const int t0 = c * 128, tl = 16 * wave + i, t = t0 + tl;
    const bf16_t* QC = (const bf16_t*)(ws + T_QC); const bf16_t* KC = (const bf16_t*)(ws + T_KC);
    const bf16_t* ZT = (const bf16_t*)(ws + WS_ZT); const bf16_t* ZR = (const bf16_t*)(ws + WS_ZR);
    LAS unsigned char* Cs = lds; LAS unsigned char* Ks = lds + ML_MAT; LAS unsigned char* Vs = lds + 2 * ML_MAT;
    __syncthreads();
    {
        const bf16_t* CS = (const bf16_t*)(ws + T_CST) + ((size_t)(h * 128 + c) * 128) * 128;
        const bf16_t* kc = KC + (size_t)t0 * 512 + h * 128;
        const bf16_t* vt = ZT + (size_t)(ZT_MV + h * 128) * ZTP + t0;
#pragma unroll
        for (int q = 0; q < 4; ++q) { const int cc = tid + 512 * q; const int row = cc >> 4, part = cc & 15;
            const u32x4 a = *(const u32x4*)(CS + (size_t)row * 128 + part * 8);
            const u32x4 b = *(const u32x4*)(kc + (size_t)row * 512 + part * 8);
            const u32x4 d = *(const u32x4*)(vt + (size_t)row * ZTP + part * 8);
            *(LAS u32x4*)(Cs + row * ML_PITCHB + part * 16) = a; *(LAS u32x4*)(Ks + row * ML_PITCHB + part * 16) = b; *(LAS u32x4*)(Vs + row * ML_PITCHB + part * 16) = d; }
    }
    const float* ma = (const float*)(ws + SM_MA) + (size_t)h * S + t0;
    const float mc = ((const float*)(ws + SM_MLSC))[1024 + h * 128 + c];
    const float bt = ((const float*)(ws + SM_MB))[(size_t)h * S + t];
    const float Mx = fmaxf(mc, ((const float*)(ws + SM_MPX))[(size_t)h * S + t]);
    const float w_inter = __expf(mc - Mx);
    bf16x8 Qf[4];
#pragma unroll
    for (int ks = 0; ks < 4; ++ks) Qf[ks] = *(const bf16x8*)(QC + (size_t)t * 512 + h * 128 + 32 * ks + 8 * g);
    float qn = 0.f;
    {
        const float* ns = (const float*)(ws + SM_NST) + (size_t)(h * 128 + c) * 128;
#pragma unroll
        for (int ks = 0; ks < 4; ++ks) { const f32x4 n0 = *(const f32x4*)(ns + 32 * ks + 8 * g), n1 = *(const f32x4*)(ns + 32 * ks + 8 * g + 4);
            qn += bf2f((unsigned short)Qf[ks][0]) * n0.x + bf2f((unsigned short)Qf[ks][1]) * n0.y + bf2f((unsigned short)Qf[ks][2]) * n0.z + bf2f((unsigned short)Qf[ks][3]) * n0.w
                + bf2f((unsigned short)Qf[ks][4]) * n1.x + bf2f((unsigned short)Qf[ks][5]) * n1.y + bf2f((unsigned short)Qf[ks][6]) * n1.z + bf2f((unsigned short)Qf[ks][7]) * n1.w; }
        qn = grp_sum(qn);
    }
    u32x2 mow[8];
    {
        const bf16_t* mo = ZR + (size_t)t * ZRW + ZR_MO + h * 128;
#pragma unroll
        for (int dt = 0; dt < 8; ++dt) mow[dt] = *(const u32x2*)(mo + 16 * dt + 4 * g);
    }
    __syncthreads();
    f32x4 On[8];
#pragma unroll
    for (int dt = 0; dt < 8; ++dt) On[dt] = (f32x4){0.f, 0.f, 0.f, 0.f};
#pragma unroll
    for (int ks = 0; ks < 4; ++ks)
#pragma unroll
        for (int dt = 0; dt < 8; ++dt) { const bf16x8 a = *(const LAS bf16x8*)(Cs + (16 * dt + i) * ML_PITCHB + (32 * ks + 8 * g) * 2); On[dt] = MFMA16(a, Qf[ks], On[dt]); }
#pragma unroll
    for (int dt = 0; dt < 8; ++dt) On[dt] = On[dt] * w_inter;
    float den = 0.f;
    for (int sp = 0; sp <= (wave >> 1); ++sp) {
        f32x4 s0 = {0.f, 0.f, 0.f, 0.f}, s1 = {0.f, 0.f, 0.f, 0.f};
        const LAS unsigned char* k0p = Ks + (32 * sp + i) * ML_PITCHB + 16 * g;
        const LAS unsigned char* k1p = k0p + 16 * ML_PITCHB;
#pragma unroll
        for (int ks = 0; ks < 4; ++ks) { s0 = MFMA16(*(const LAS bf16x8*)(k0p + 64 * ks), Qf[ks], s0); s1 = MFMA16(*(const LAS bf16x8*)(k1p + 64 * ks), Qf[ks], s1); }
        const f32x4 a0 = *(const f32x4*)(ma + 32 * sp + 4 * g), a1 = *(const f32x4*)(ma + 32 * sp + 16 + 4 * g);
        float p0[4], p1[4];
#pragma unroll
        for (int r = 0; r < 4; ++r) {
            const int sl0 = 32 * sp + 4 * g + r, sl1 = sl0 + 16;
            p0[r] = (sl0 <= tl) ? s0[r] * __expf(a0[r] - Mx) : 0.f;
            p1[r] = (sl1 <= tl) ? s1[r] * __expf(a1[r] - Mx) : 0.f;
            den += p0[r] + p1[r];
        }
        u32x4 pw; pw.x = pk2(p0[0], p0[1]); pw.y = pk2(p0[2], p0[3]); pw.z = pk2(p1[0], p1[1]); pw.w = pk2(p1[2], p1[3]);
        const bf16x8 pb = __builtin_bit_cast(bf16x8, pw);
#pragma unroll
        for (int dt = 0; dt < 8; ++dt) { const LAS unsigned char* vp = Vs + (16 * dt + i) * ML_PITCHB + (32 * sp + 4 * g) * 2;
            u32x4 vw; const u32x2 lo = *(const LAS u32x2*)vp, hi = *(const LAS u32x2*)(vp + 32); vw.x = lo.x; vw.y = lo.y; vw.z = hi.x; vw.w = hi.y;
            On[dt] = MFMA16(__builtin_bit_cast(bf16x8, vw), pb, On[dt]); }
    }
    den = grp_sum(den) + w_inter * qn;
    const float dn = fmaxf(fabsf(den), __expf(-(bt + Mx)));
    const float inv = 1.f / dn;
    float ss = 0.f;
#pragma unroll
    for (int dt = 0; dt < 8; ++dt) { const u32x2 w = mow[dt];
        const f32x4 og = {sigmoidf(bflo(w.x)), sigmoidf(bfhi(w.x)), sigmoidf(bflo(w.y)), sigmoidf(bfhi(w.y))};
        On[dt] = On[dt] * inv * og;
        ss += (On[dt].x * On[dt].x + On[dt].y * On[dt].y) + (On[dt].z * On[dt].z + On[dt].w * On[dt].w); }
    ss = grp_sum(ss);
    const float rs = rsqrtf(ss * (1.f / 128.f) + EPS);
    bf16_t* yrow = (bf16_t*)(ws + WS_Y) + (size_t)t * DM + 256 + h * 128;
#pragma unroll
    for (int dt = 0; dt < 8; ++dt) { const f32x4 gg = *(const f32x4*)(g_mlstm + h * 128 + 16 * dt + 4 * g); const f32x4 o = On[dt] * rs * gg;
        u32x2 w; w.x = pk2(o.x, o.y); w.y = pk2(o.z, o.w); *(u32x2*)(yrow + 16 * dt + 4 * g) = w; }
}
struct SchedDenseIn {
    const char* X; const char* W; int G, c;
    __device__ __forceinline__ bool next(int i, pg8::GUnit& u) const {
        constexpr int nM = 64, nN = 14, nwg = nM * nN;
        const long L = (long)i * G + c; if (L >= nwg) return false;
        int wgid = (int)L; { const int q = nwg / pg8::NXCD, r = nwg % pg8::NXCD, xcd = wgid % pg8::NXCD, off = wgid / pg8::NXCD; wgid = (xcd < r ? xcd * (q + 1) : r * (q + 1) + (xcd - r) * q) + off; }
        const int nig = pg8::WGM * nN, gid = wgid / nig, fm = gid * pg8::WGM, gsz = (nM - fm) < pg8::WGM ? (nM - fm) : pg8::WGM;
        const int pm = fm + ((wgid % nig) % gsz), pn = (wgid % nig) / gsz;
        u.pm = pm; u.pn = pn; u.x0 = 0;
        if (pn < 10) { u.A = X + (size_t)pm * 256 * DM * 2; u.B = W + (size_t)pn * 256 * DM * 2; }
        else { u.A = W + (size_t)pn * 256 * DM * 2; u.B = X + (size_t)pm * 256 * DM * 2; }
        return true;
    }
};
struct EpiZ {
    bf16_t* ZR; bf16_t* ZT; int nostore;
    __device__ __forceinline__ void operator()(const f32x4 (&acc)[2][2][4][2], const pg8::GUnit& u, int wr, int wc, int fr, int fq) const {
        if (nostore) return;
        const bool sw = u.pn >= 10;
        bf16_t* base; size_t pitch;
        if (!sw) { base = ZR + (size_t)(256 * u.pm) * ZRW + 256 * u.pn; pitch = ZRW; }
        else { base = ZT + (size_t)(256 * (u.pn - 10)) * ZTP + 256 * u.pm; pitch = ZTP; }
#pragma unroll
        for (int ai = 0; ai < 2; ++ai)
#pragma unroll
            for (int m = 0; m < 4; ++m) { bf16_t* rowp = base + (size_t)(ai * 128 + wr * 64 + m * 16 + fr) * pitch + wc * 32 + 8 * fq;
#pragma unroll
                for (int bj = 0; bj < 2; ++bj) { const f32x4 v0 = acc[ai][bj][m][0], v1 = acc[ai][bj][m][1];
                    u32x4 w; w.x = pk2(v0[0], v0[1]); w.y = pk2(v0[2], v0[3]); w.z = pk2(v1[0], v1[1]); w.w = pk2(v1[2], v1[3]);
                    *(u32x4*)(rowp + bj * 128) = w; } }
    }
};
struct SchedDense4 {
    const char* X; const char* W; int K; int G, c;
    __device__ __forceinline__ bool next(int i, pg8::GUnit& u) const {
        const int L = i * G + c; if (L >= 256) return false;
        const int pm = L >> 2, pn = L & 3;
        u.pm = pm; u.pn = pn; u.x0 = 0;
        u.A = X + (size_t)pm * 256 * K * 2; u.B = W + (size_t)pn * 256 * K * 2;
        return true;
    }
};
template <bool XBF16> struct EpiPre1 {
    const void* xin; bf16_t* out;
    __device__ __forceinline__ void operator()(const f32x4 (&acc)[2][2][4][2], const pg8::GUnit& u, int wr, int wc, int fr, int fq) const {
#pragma unroll
        for (int ai = 0; ai < 2; ++ai)
#pragma unroll
            for (int m = 0; m < 4; ++m) { const size_t off = (size_t)(256 * u.pm + ai * 128 + wr * 64 + m * 16 + fr) * DM + 256 * u.pn + wc * 32 + 8 * fq;
#pragma unroll
                for (int bj = 0; bj < 2; ++bj) {
                    f32x4 x0, x1;
                    if (XBF16) { const u32x4 xw = *(const u32x4*)((const bf16_t*)xin + off + bj * 128); x0 = (f32x4){bflo(xw.x), bfhi(xw.x), bflo(xw.y), bfhi(xw.y)}; x1 = (f32x4){bflo(xw.z), bfhi(xw.z), bflo(xw.w), bfhi(xw.w)}; }
                    else { x0 = *(const f32x4*)((const float*)xin + off + bj * 128); x1 = *(const f32x4*)((const float*)xin + off + bj * 128 + 4); }
                    const f32x4 v0 = x0 * ALPHA + acc[ai][bj][m][0], v1 = x1 * ALPHA + acc[ai][bj][m][1];
                    u32x4 w; w.x = pk2(v0[0], v0[1]); w.y = pk2(v0[2], v0[3]); w.z = pk2(v1[0], v1[1]); w.w = pk2(v1[2], v1[3]);
                    *(u32x4*)(out + off + bj * 128) = w; } }
    }
};
__device__ __forceinline__ void moe_table(const unsigned* ecnt, LAS int* tab, int tid) {
    __syncthreads();
    if (tid < 64) {
        const int e = tid; const unsigned cnt_e = e < NE ? xb_ld((unsigned*)ecnt + e) : 0u; const int n = (int)((cnt_e + 255u) >> 8);
        if (e < NE) tab[216 + e] = (int)cnt_e;
        int inc = n;
#pragma unroll
        for (int o = 1; o < 32; o <<= 1) { const int v = __shfl_up(inc, o); if (e >= o) inc += v; }
        const int exc = inc - n;
        if (e < NE) { tab[1 + e] = exc; for (int j = 0; j < n; ++j) tab[40 + exc + j] = e; }
        if (e == NE - 1) { tab[1 + NE] = inc; tab[0] = inc; }
    }
    __syncthreads();
}
struct SchedMoE {
    const char* Abase; const char* Wbase; const LAS int* tab; size_t wstride; int K; int G, c; int maxr; const int* elist; unsigned* guc; unsigned* tmo;
    __device__ __forceinline__ int unit_of(int i, int U) const {
        if (elist) return i * G + c;
        const int r = U % G; if (r == 0) return i * G + c;
        const int nl = G - r;
        if (c >= r) return i < 2 ? i * nl + (c - r) : 2 * nl + (i - 2) * G + c;
        return 2 * nl + i * G + c;
    }
    __device__ __forceinline__ void a_ready(const pg8::GUnit& u, int wid, int lane) const {
        if (wid == 0) {
            unsigned polls = 0;
            while ((unsigned)__builtin_amdgcn_readfirstlane(__hip_atomic_load(guc + 16 * u.pm, __ATOMIC_RELAXED, __HIP_MEMORY_SCOPE_AGENT)) < 32u) {
                if ((++polls & 255u) == 0u) { if (__builtin_amdgcn_readfirstlane(__hip_atomic_load(tmo, __ATOMIC_RELAXED, __HIP_MEMORY_SCOPE_AGENT)) != 0u) break;
                    if (polls > (1u << 22)) { if (lane == 0) atomicAdd(tmo, 1u); break; } }
                __builtin_amdgcn_s_sleep(2); }
            asm volatile("s_waitcnt vmcnt(0)" ::: "memory");
        }
        asm volatile("" ::: "memory"); __builtin_amdgcn_s_barrier(); asm volatile("" ::: "memory");
    }
    __device__ __forceinline__ bool next(int i, pg8::GUnit& u) const {
        if (i >= maxr) return false;
        const int T = __builtin_amdgcn_readfirstlane(tab[0]); const int L = unit_of(i, 4 * T); if (L >= 4 * T) return false;
        const int tile = L >> 2, pn = L & 3; const int e = __builtin_amdgcn_readfirstlane(tab[40 + tile]);
        u.pm = tile; u.pn = pn; u.x0 = e;
        u.B = Wbase + (size_t)e * wstride + (size_t)pn * 256 * K * 2;
        if (elist) { u.A = Abase; u.list = elist + (size_t)e * S; u.l0 = 256 * (tile - __builtin_amdgcn_readfirstlane(tab[1 + e])); u.nl = __builtin_amdgcn_readfirstlane(tab[216 + e]); }
        else { u.A = Abase + (size_t)tile * 256 * K * 2; u.list = nullptr; u.l0 = 0; u.nl = 0; }
        return true;
    }
};
struct EpiGU {
    bf16_t* H; unsigned* guc;
    __device__ __forceinline__ void operator()(const f32x4 (&acc)[2][2][4][2], const pg8::GUnit& u, int wr, int wc, int fr, int fq) const {
#pragma unroll
        for (int ai = 0; ai < 2; ++ai)
#pragma unroll
            for (int m = 0; m < 4; ++m) { bf16_t* rowp = H + (size_t)(256 * u.pm + ai * 128 + wr * 64 + m * 16 + fr) * DE + (256 * u.pn + wc * 32 + 8 * fq) / 2;
#pragma unroll
                for (int bj = 0; bj < 2; ++bj) { const f32x4 gt = acc[ai][bj][m][0], up = acc[ai][bj][m][1];
                    const unsigned long long w = (unsigned long long)pk2(siluf(gt[0]) * up[0], siluf(gt[1]) * up[1]) | ((unsigned long long)pk2(siluf(gt[2]) * up[2], siluf(gt[3]) * up[3]) << 32);
                    __hip_atomic_store((unsigned long long*)(rowp + bj * 64), w, __ATOMIC_RELAXED, __HIP_MEMORY_SCOPE_AGENT); } }
        asm volatile("s_waitcnt vmcnt(0)" ::: "memory");
        if (fr == 0 && fq == 0) (void)__hip_atomic_fetch_add(guc + 16 * u.pm, 1u, __ATOMIC_RELAXED, __HIP_MEMORY_SCOPE_AGENT);
    }
};
struct EpiY {
    bf16_t* Y;
    __device__ __forceinline__ void operator()(const f32x4 (&acc)[2][2][4][2], const pg8::GUnit& u, int wr, int wc, int fr, int fq) const {
#pragma unroll
        for (int ai = 0; ai < 2; ++ai)
#pragma unroll
            for (int m = 0; m < 4; ++m) { bf16_t* rowp = Y + (size_t)(256 * u.pm + ai * 128 + wr * 64 + m * 16 + fr) * DM + 256 * u.pn + wc * 32 + 8 * fq;
#pragma unroll
                for (int bj = 0; bj < 2; ++bj) { const f32x4 v0 = acc[ai][bj][m][0], v1 = acc[ai][bj][m][1];
                    u32x4 w; w.x = pk2(v0[0], v0[1]); w.y = pk2(v0[2], v0[3]); w.z = pk2(v1[0], v1[1]); w.w = pk2(v1[2], v1[3]);
                    *(u32x4*)(rowp + bj * 128) = w; } }
    }
};

constexpr int R6_WG = 0, R6_WE = 16384, R6_G = 16384 + 131072, R6_B = R6_G + 4096, R6_END = R6_B + 4096;
static_assert(R6_END <= LDS_TAB, "router weights fit under the table region");
__device__ __forceinline__ void ln1_router_load(const float* g1, const float* b1, const float* w_grp, const float* w_er, LAS unsigned char* lds, int tid) {
    LAS float* wgT = (LAS float*)(lds + R6_WG); LAS float* weT = (LAS float*)(lds + R6_WE); LAS float* gg = (LAS float*)(lds + R6_G); LAS float* bb = (LAS float*)(lds + R6_B);
    for (int i = tid; i < 1024; i += 512) { const f32x4 w = *(const f32x4*)(w_grp + 4 * i); wgT[i] = w.x; wgT[1024 + i] = w.y; wgT[2048 + i] = w.z; wgT[3072 + i] = w.w; gg[i] = g1[i]; bb[i] = b1[i]; }
    for (int i = tid; i < 1024 * 8; i += 512) { const int k = i >> 3, c4 = (i & 7) * 4; const f32x4 w = *(const f32x4*)(w_er + (size_t)k * 32 + c4);
        weT[(c4 + 0) * 1024 + k] = w.x; weT[(c4 + 1) * 1024 + k] = w.y; weT[(c4 + 2) * 1024 + k] = w.z; weT[(c4 + 3) * 1024 + k] = w.w; }
}
__device__ __forceinline__ void ln1_router_row(int t, unsigned char* ws, const LAS unsigned char* lds, const float* b_grp, const float* b_er, unsigned* ecnt, int lane) {
    const LAS float* wgT = (const LAS float*)(lds + R6_WG); const LAS float* weT = (const LAS float*)(lds + R6_WE); const LAS float* gg = (const LAS float*)(lds + R6_G); const LAS float* bb = (const LAS float*)(lds + R6_B);
    const bf16_t* p1 = (const bf16_t*)(ws + WS_ZT) + (size_t)t * DM;
    f32x4 v[4];
#pragma unroll
    for (int j = 0; j < 4; ++j) { const u32x2 w = *(const u32x2*)(p1 + 256 * j + 4 * lane); v[j] = (f32x4){bflo(w.x), bfhi(w.x), bflo(w.y), bfhi(w.y)}; }
    {
        float s = 0.f;
#pragma unroll
        for (int j = 0; j < 4; ++j) s += (v[j].x + v[j].y) + (v[j].z + v[j].w);
        const float mean = wave_sum(s) * (1.f / DM); float s2 = 0.f;
#pragma unroll
        for (int j = 0; j < 4; ++j) { v[j] = v[j] - mean; s2 += (v[j].x * v[j].x + v[j].y * v[j].y) + (v[j].z * v[j].z + v[j].w * v[j].w); }
        const float rstd = rsqrtf(wave_sum(s2) * (1.f / DM) + EPS);
#pragma unroll
        for (int j = 0; j < 4; ++j) { const f32x4 g = *(const LAS f32x4*)(gg + 256 * j + 4 * lane), b = *(const LAS f32x4*)(bb + 256 * j + 4 * lane); v[j] = v[j] * rstd * g + b; }
    }
    store_row_bf16(v, (bf16_t*)(ws + WS_ACTB) + (size_t)t * DM, lane);
    float gl[4];
#pragma unroll
    for (int q = 0; q < 4; ++q) { float s = 0.f;
#pragma unroll
        for (int j = 0; j < 4; ++j) { const f32x4 w = *(const LAS f32x4*)(wgT + q * 1024 + 256 * j + 4 * lane); s += (v[j].x * w.x + v[j].y * w.y) + (v[j].z * w.z + v[j].w * w.w); }
        gl[q] = wave_sum(s) + b_grp[q]; }
    int gs = 0; float gm = gl[0];
#pragma unroll
    for (int q = 1; q < 4; ++q) if (gl[q] > gm) { gm = gl[q]; gs = q; }
    float den = 0.f;
#pragma unroll
    for (int q = 0; q < 4; ++q) den += __expf(gl[q] - gm);
    const float pg = 1.f / den;
    float el[8];
#pragma unroll
    for (int q = 0; q < 8; ++q) { float s = 0.f; const LAS float* wc = weT + (gs * 8 + q) * 1024;
#pragma unroll
        for (int j = 0; j < 4; ++j) { const f32x4 w = *(const LAS f32x4*)(wc + 256 * j + 4 * lane); s += (v[j].x * w.x + v[j].y * w.y) + (v[j].z * w.z + v[j].w * w.w); }
        el[q] = wave_sum(s) + b_er[gs * 8 + q]; }
    int i0 = 0; float v0 = el[0];
#pragma unroll
    for (int q = 1; q < 8; ++q) if (el[q] > v0) { v0 = el[q]; i0 = q; }
    int i1 = -1; float v1 = -INFINITY;
#pragma unroll
    for (int q = 0; q < 8; ++q) if (q != i0 && el[q] > v1) { v1 = el[q]; i1 = q; }
    const float e1 = __expf(v1 - v0); const float w0g = pg / (1.f + e1), w1g = pg * e1 / (1.f + e1);
    if (lane < 2) {
        const int e = gs * 8 + (lane == 0 ? i0 : i1);
        const unsigned slot = atomicAdd(ecnt + e, 1u);
        ((int*)(ws + SM_ELIST))[(size_t)e * S + slot] = t;
        ((int*)(ws + SM_EID))[2 * t + lane] = e; ((int*)(ws + SM_SLOT))[2 * t + lane] = (int)slot; ((float*)(ws + SM_WT))[2 * t + lane] = lane == 0 ? w0g : w1g;
    }
}
__device__ __forceinline__ void ln2_row(int t, unsigned char* ws, const LAS int* tab, const LAS float* g2, const LAS float* b2, float* out, bool last,
                                        const LAS float* w12, const float* bff, const float* bmi, const float* bmf, int lane, int dbg = 0) {
    const bf16_t* x1 = (const bf16_t*)(ws + WS_ACTB) + (size_t)t * DM;
    const int e0 = ((const int*)(ws + SM_EID))[2 * t], e1 = ((const int*)(ws + SM_EID))[2 * t + 1];
    const int s0 = ((const int*)(ws + SM_SLOT))[2 * t], s1 = ((const int*)(ws + SM_SLOT))[2 * t + 1];
    const float w0 = ((const float*)(ws + SM_WT))[2 * t], w1 = ((const float*)(ws + SM_WT))[2 * t + 1];
    const bf16_t* y0 = (const bf16_t*)(ws + T_YE) + (size_t)(256 * tab[1 + e0] + s0) * DM; const bf16_t* y1 = (const bf16_t*)(ws + T_YE) + (size_t)(256 * tab[1 + e1] + s1) * DM;
    f32x4 v[4];
#pragma unroll
    for (int j = 0; j < 4; ++j) { const u32x2 xw = *(const u32x2*)(x1 + 256 * j + 4 * lane);
        const f32x4 x = {bflo(xw.x), bfhi(xw.x), bflo(xw.y), bfhi(xw.y)};
        const u32x2 a = *(const u32x2*)(y0 + 256 * j + 4 * lane), b = *(const u32x2*)(y1 + 256 * j + 4 * lane);
        const f32x4 ya = {bflo(a.x), bfhi(a.x), bflo(a.y), bfhi(a.y)}, yb = {bflo(b.x), bfhi(b.x), bflo(b.y), bfhi(b.y)};
        v[j] = x * ALPHA + ya * w0 + yb * w1; }
    {
        float s = 0.f;
#pragma unroll
        for (int j = 0; j < 4; ++j) s += (v[j].x + v[j].y) + (v[j].z + v[j].w);
        const float mean = wave_sum(s) * (1.f / DM); float s2 = 0.f;
#pragma unroll
        for (int j = 0; j < 4; ++j) { v[j] = v[j] - mean; s2 += (v[j].x * v[j].x + v[j].y * v[j].y) + (v[j].z * v[j].z + v[j].w * v[j].w); }
        const float rstd = rsqrtf(wave_sum(s2) * (1.f / DM) + EPS);
#pragma unroll
        for (int j = 0; j < 4; ++j) { const f32x4 g = *(const LAS f32x4*)(g2 + 256 * j + 4 * lane), b = *(const LAS f32x4*)(b2 + 256 * j + 4 * lane); v[j] = v[j] * rstd * g + b; }
    }
    if (dbg & 1) { if (!(dbg & 2) && !last) gates_row(v, w12, bff, bmi, bmf, (float*)(ws + WS_ROPE), (float*)(ws + WS_ROPE), (float*)(ws + WS_ROPE), -1, lane); return; }
    if (last) {
#pragma unroll
        for (int j = 0; j < 4; ++j) *(f32x4*)(out + (size_t)t * DM + 256 * j + 4 * lane) = v[j];
    } else {
        store_row_bf16(v, (bf16_t*)(ws + WS_ACTB) + (size_t)t * DM, lane);
        gates_row(v, w12, bff, bmi, bmf, (float*)(ws + SM_FLF), (float*)(ws + SM_MLI), (float*)(ws + SM_MLF), t, lane);
    }
}

__device__ __forceinline__ const void* ldarg(int k) { int kk = k; asm volatile("" : "+s"(kk)); return ((const void* const*)__builtin_amdgcn_kernarg_segment_ptr())[kk]; }
#ifndef PH_MASK
#define PH_MASK 0x7ff
#endif
#define PHM(k) (((PH_MASK) >> (k)) & 1)
#define IN(k) (lo <= (k) && (k) < hi)
#define SEAM(k) do { if (IN(k) && IN((k) + 1)) { XcdBarrier _b; _b.bar = (unsigned*)ldarg(23) + CW_BAR; _b.x = xb_xcc_id(); _b.st = (volatile LAS unsigned*)(lds + LDS_MISC); xcd_barrier(_b, wave0 == 0 && __builtin_amdgcn_mbcnt_hi(~0u, __builtin_amdgcn_mbcnt_lo(~0u, 0u)) == 0u); } } while (0)
#define VCU ((G % 8 == 0) ? (bid % 8) * (G / 8) + bid / 8 : bid)
#define PHASE_IDS unsigned char* ws = (unsigned char*)ldarg(23); unsigned* ctl = (unsigned*)ws; float* outp = (float*)ldarg(22); (void)ctl; (void)outp; int tid = wave0 * 64 + (int)__builtin_amdgcn_mbcnt_hi(~0u, __builtin_amdgcn_mbcnt_lo(~0u, 0u)); asm volatile("" : "+v"(tid)); const int lane = tid & 63, wave = __builtin_amdgcn_readfirstlane(tid >> 6); const int gw = bid * 8 + wave, NGW = G * 8; (void)lane; (void)gw; (void)NGW;
#define INP(k) ((const float*)ldarg(k))
template <int l>
__device__ __forceinline__ void layer_phases(LAS unsigned char* lds, const int wave0, const int bid, const int G, const int lo, const int hi, const int sub) {
    constexpr int P = 1 + 10 * l;

        if (PHM(0) && IN(P + 0)) { PHASE_IDS;
            SchedDenseIn Sd{(const char*)(ws + WS_ACTB), (const char*)(ws + WS_WIN) + (size_t)l * NZ * DM * 2, G, bid};
            EpiZ E{(bf16_t*)(ws + WS_ZR), (bf16_t*)(ws + WS_ZT), (sub >> 12) & 1};
            pg8::gemm_phase<EpiZ, SchedDenseIn>(lds, DM, Sd, E, tid);
            if (G == 256 && bid >= 128 && !((sub >> 13) & 1))
                moe_weights(INP(17) + (size_t)l * NE * DM * DE, INP(18) + (size_t)l * NE * DM * DE, INP(19) + (size_t)l * NE * DE * DM, ws, lds, lane, wave, (bid - 128) * 8 + wave, 128 * 8, 0, MOE_FILL);
        }
        SEAM(P + 0);
        if (PHM(1) && IN(P + 1)) { PHASE_IDS;
            if (sub & 1) for (int u = bid; u < 256; u += G) mix1_unit(u, ws, ctl + CW_KMAX(l), lds, tid, lane, wave);
            if (sub & 2) { const bool split = (G == 256);
                moe_weights(INP(17) + (size_t)l * NE * DM * DE, INP(18) + (size_t)l * NE * DM * DE, INP(19) + (size_t)l * NE * DE * DM, ws, lds, lane, wave, gw, NGW, split ? MOE_FILL : 0, MOE_ITEMS); }
        }
        SEAM(P + 1);
        if (PHM(2) && IN(P + 2)) { PHASE_IDS;
            for (int u = VCU; u < 1536; u += G) {
                const int ty = u >> 9, r = u & 511, h = r >> 7, q = r & 127;
                if (!((sub >> ty) & 1)) continue;
                if (ty == 0) { const float kmaxn = sqrtf(__builtin_bit_cast(float, xb_ld(ctl + CW_KMAX(l) + h))); fox_unit(h, q, ws, kmaxn, INP(7) + l * 256, lds, tid, lane, wave, (sub & 256) ? 1 : ((sub & 512) ? 3 : (1 << 30)), (sub & 768) ? (bf16_t*)(ws + WS_X1) : nullptr); }
                else if (ty == 1) mlstm_local_unit(h, q, ws, INP(6) + (size_t)l * 4 * 1024, lds, tid, lane, wave);
                else moba_gate_unit(h, q, ws, lds, tid, lane, wave);
            }
        }
        SEAM(P + 2);
        if (PHM(3) && IN(P + 3)) { PHASE_IDS;
            if (sub & 1) for (int vb = bid; vb < 256; vb += G) mlstm_scan(ws, lds, tid, lane, wave, vb);
            LAS unsigned char* ltab = lds + LDS_TAB;
            LAS int* tot = (LAS int*)ltab;
            LAS int* pre = (LAS int*)(ltab + 1024);
            __syncthreads();
            if (tid < 256) { const int* cq = (const int*)(ws + SM_CNTQ) + (size_t)tid * 128; int a = 0;
                for (int i = 0; i < 128; i += 4) { const u32x4 v = *(const u32x4*)(cq + i); a += (int)(v.x + v.y + v.z + v.w); }
                tot[tid] = a; pre[tid] = (a + 255) >> 8; }
            __syncthreads();
            if (tid < 64) {
                const int c0 = pre[4 * tid], c1 = pre[4 * tid + 1], c2 = pre[4 * tid + 2], c3 = pre[4 * tid + 3]; const int tsum = c0 + c1 + c2 + c3; int inc = tsum;
#pragma unroll
                for (int o = 1; o < 64; o <<= 1) { const int v = __shfl_up(inc, o); if (tid >= o) inc += v; }
                const int exc = inc - tsum;
                pre[4 * tid] = exc; pre[4 * tid + 1] = exc + c0; pre[4 * tid + 2] = exc + c0 + c1; pre[4 * tid + 3] = exc + c0 + c1 + c2;
                if (tid == 63) pre[256] = inc;
            }
            __syncthreads();
            const int total = (sub & 2) ? pre[256] : 0;
            const int per = (total + G - 1) / G; const int u0 = VCU * per, u1 = (u0 + per < total) ? u0 + per : total;
            int prev = -1;
            for (int u = u0; u < u1; ++u) {
                int loi = 0, hii = 255;
                while (loi < hii) { const int mid = (loi + hii + 1) >> 1; if (pre[mid] <= u) loi = mid; else hii = mid - 1; }
                moba_part_unit(loi >> 6, loi & 63, u - pre[loi], tot[loi], ws, lds, ltab, tid, lane, wave, (sub >> 10) & 3, loi == prev);
                prev = loi;
            }
        }
        SEAM(P + 3);
        if (PHM(4) && IN(P + 4)) { PHASE_IDS;
            for (int u = VCU; u < 768; u += G) {
                if (u < 512) { if (sub & 1) mlstm_out_unit(u >> 7, u & 127, ws, INP(8) + l * 512, lds, tid, lane, wave); }
                else if (sub & 2) { const int r = u - 512; moba_own_unit(r >> 6, r & 63, ws, INP(9) + l * 256, lds, tid, lane, wave); }
            }
        }
        SEAM(P + 4);
        if (PHM(5) && IN(P + 5)) { PHASE_IDS;
            SchedDense4 Sd{(const char*)(ws + WS_Y), (const char*)(ws + WS_WOUT) + (size_t)l * DM * DM * 2, DM, G, (G % 8 == 0) ? (bid % 8) * (G / 8) + bid / 8 : bid};
            EpiPre1<(l > 0)> E{l == 0 ? (const void*)INP(0) : (const void*)(ws + WS_ACTB), (bf16_t*)(ws + WS_ZT)};
            pg8::gemm_phase<EpiPre1<(l > 0)>, SchedDense4>(lds, DM, Sd, E, tid);
        }
        SEAM(P + 5);
        if (PHM(6) && IN(P + 6)) { PHASE_IDS;
            ln1_router_load(INP(11) + l * DM, INP(12) + l * DM, INP(13) + (size_t)l * DM * 4, INP(15) + (size_t)l * DM * 32, lds, tid);
            __syncthreads();
            const float* bgp = INP(14) + l * 4; const float* bep = INP(16) + l * 32;
#pragma unroll 8
            for (int t = gw; t < S; t += NGW)
                ln1_router_row(t, ws, lds, bgp, bep, ctl + CW_ECNT(l), lane);
            __syncthreads();
        }
        SEAM(P + 6);
        if (PHM(7) && IN(P + 7)) { PHASE_IDS;
            LAS int* tab = (LAS int*)(lds + LDS_TAB);
            moe_table(ctl + CW_ECNT(l), tab, tid);
            SchedMoE Sm{(const char*)(ws + WS_ACTB), (const char*)(ws + WS_WGU), tab, (size_t)DM * DM * 2, DM, G, (G % 8 == 0) ? (bid % 8) * (G / 8) + bid / 8 : bid, (sub & 16) ? 1 : ((sub & 32) ? 2 : 1000), (const int*)(ws + SM_ELIST), nullptr, nullptr};
            EpiGU E{(bf16_t*)(ws + T_H), ctl + CW_GUC(l)};
            pg8::gemm_phase<EpiGU, SchedMoE, true>(lds, DM, Sm, E, tid, (LAS unsigned*)(lds + LDS_TAB + 1024));
        }
        if (PHM(8) && IN(P + 8)) { PHASE_IDS;
            LAS int* tab = (LAS int*)(lds + LDS_TAB);
            moe_table(ctl + CW_ECNT(l), tab, tid);
            SchedMoE Sm{(const char*)(ws + T_H), (const char*)(ws + WS_WD), tab, (size_t)DM * DE * 2, DE, G, (G % 8 == 0) ? (bid % 8) * (G / 8) + bid / 8 : bid, (sub & 16) ? 1 : ((sub & 32) ? 2 : 1000), nullptr, ctl + CW_GUC(l), ctl + CW_BAR + XB_TMO};
            EpiY E{(bf16_t*)(ws + T_YE)};
            pg8::gemm_phase<EpiY, SchedMoE, false, true>(lds, DE, Sm, E, tid);
        }
        SEAM(P + 8);
        if (PHM(9) && IN(P + 9)) { PHASE_IDS;
            LAS int* tab = (LAS int*)(lds + LDS_TAB);
            moe_table(ctl + CW_ECNT(l), tab, tid);
            const bool last = (l == NL - 1);
            LAS float* w12 = (LAS float*)lds;
            if (!last) { load_w12(INP(2) + (size_t)(l + 1) * DM * INW, w12, tid); __syncthreads(); }
            LAS float* g2l = (LAS float*)(lds + 49152); LAS float* b2l = g2l + 1024;
            { const float* g2p = INP(20) + l * DM; const float* b2p = INP(21) + l * DM; for (int i = tid; i < 1024; i += 512) { g2l[i] = g2p[i]; b2l[i] = b2p[i]; } }
            __syncthreads();
            const float* bffp = INP(3) + (l + 1) * 4; const float* bmip = INP(4) + (l + 1) * 4; const float* bmfp = INP(5) + (l + 1) * 4;
#pragma unroll 8
            for (int t = gw; t < S; t += NGW)
                ln2_row(t, ws, tab, g2l, b2l, outp, last, w12, bffp, bmip, bmfp, lane, (sub >> 14) & 3);
            __syncthreads();
        }
        SEAM(P + 9);
}
struct Args { const void* in[22]; float* out; unsigned char* ws; int ph_lo, ph_hi, sub, pad; };
__global__ void __launch_bounds__(512, 2) fwd(Args args) {
    extern __shared__ __attribute__((aligned(16))) unsigned char lds_raw[];
    LAS unsigned char* lds = (LAS unsigned char*)lds_raw;
    const int tid0 = threadIdx.x; const int wave0 = __builtin_amdgcn_readfirstlane(tid0 >> 6);
    const int bid = blockIdx.x, G = gridDim.x;
    if (tid0 < 4) ((LAS unsigned*)(lds + LDS_MISC))[tid0] = 0u;
    __syncthreads();
    const int lo = args.ph_lo, hi = args.ph_hi;
    if (hi - lo > 1 && lo != 99) (void)xcd_barrier_post((unsigned*)ldarg(23) + CW_BAR, (volatile LAS unsigned*)(lds + LDS_MISC));
    if (PHM(10) && IN(0)) { PHASE_IDS; p0_prologue(INP(0), (const int*)ldarg(1), INP(2), INP(10), INP(3), INP(4), INP(5), ws, lds, tid, lane, wave, bid, G); }
    SEAM(0);
    layer_phases<0>(lds, wave0, bid, G, lo, hi, args.sub);
    layer_phases<1>(lds, wave0, bid, G, lo, hi, args.sub);
#undef IN
#undef SEAM
}

extern "C" void kernel_launch(void* const* d_in, const int* in_sizes, int n_in, void* d_out, int out_size, void* d_ws, size_t ws_size, hipStream_t stream) {
    static int grid = 0;
    if (grid == 0) {
        if (n_in != 22 || out_size != S * DM || ws_size < WS_END) { fprintf(stderr, "kernel_launch: unexpected shapes (n_in %d, out %d, ws %zu < %zu); nothing launched\n", n_in, out_size, ws_size, (size_t)WS_END); grid = -1; return; }
        int dev = 0, cus = 0;
        if (hipGetDevice(&dev) != hipSuccess || hipDeviceGetAttribute(&cus, hipDeviceAttributeMultiprocessorCount, dev) != hipSuccess) { grid = -1; return; }
        if (hipFuncSetAttribute((const void*)fwd, hipFuncAttributeMaxDynamicSharedMemorySize, LDS_BYTES) != hipSuccess) { fprintf(stderr, "kernel_launch: hipFuncSetAttribute failed\n"); grid = -1; return; }
        int per_cu = 0;
        (void)hipOccupancyMaxActiveBlocksPerMultiprocessor(&per_cu, (const void*)fwd, 512, LDS_BYTES);
        (void)hipGetLastError();
        if (per_cu < 1) fprintf(stderr, "kernel_launch: occupancy query reports %d blocks per CU\n", per_cu);
        grid = cus > 0 ? cus : 256;
    }
    if (grid < 0) return;
    (void)hipMemsetAsync((char*)d_ws + WS_CTL, 0, CTL_BYTES, stream);
    Args a{};
    for (int i = 0; i < 22; ++i) a.in[i] = d_in[i];
    a.out = (float*)d_out; a.ws = (unsigned char*)d_ws; a.sub = 7;
    if (N_LAUNCHES == 1) {
        a.ph_lo = 0; a.ph_hi = NPH;
        hipLaunchKernelGGL(fwd, dim3(grid), dim3(512), LDS_BYTES, stream, a);
    } else {
        for (int p = 0; p < NPH; ++p) { a.ph_lo = p; a.ph_hi = p + 1; hipLaunchKernelGGL(fwd, dim3(grid), dim3(512), LDS_BYTES, stream, a);
#ifdef DUP_MASK
            if (((unsigned long long)(DUP_MASK) >> p) & 1ull) { a.sub = DUP_SUB; hipLaunchKernelGGL(fwd, dim3(grid), dim3(512), LDS_BYTES, stream, a); a.sub = 7; }
#endif
        }
    }
}
```

```cpp
#include <hip/hip_runtime.h>
#include <cstdio>
#include <cstdint>

#define LAS __attribute__((address_space(3)))
#define GAS __attribute__((address_space(1)))
typedef unsigned short bf16_t;
typedef short bf16x8 __attribute__((ext_vector_type(8)));
typedef short bf16x4 __attribute__((ext_vector_type(4)));
typedef float f32x4 __attribute__((ext_vector_type(4)));
typedef float f32x2 __attribute__((ext_vector_type(2)));
typedef unsigned u32x4 __attribute__((ext_vector_type(4)));
typedef unsigned u32x2 __attribute__((ext_vector_type(2)));

#ifndef N_LAUNCHES
#define N_LAUNCHES 1
#endif

constexpr int S = 16384, DM = 1024, INW = 3596, NL = 2;
constexpr int NZ = 3584;
constexpr int ZRW = 2560;
constexpr int ZR_FQ = 0, ZR_FK = 256, ZR_MQ = 512, ZR_MK = 1024, ZR_MO = 1536, ZR_BQ = 2048, ZR_BK = 2304;
constexpr int ZT_FV = 0, ZT_MV = 256, ZT_BV = 768;
constexpr int ZTP = S + 136;
constexpr int NE = 32, DE = 512, MAXT = 160, PROWS = MAXT * 256;
constexpr float ALPHA = 1.41421356237309515f;
constexpr float EPS = 1e-5f;
constexpr int NPH = 21;

constexpr size_t MiB = 1u << 20;
constexpr size_t WS_CTL = 0, CTL_BYTES = 1 * MiB;
constexpr size_t WS_WIN = 1 * MiB;
constexpr size_t WS_ROPE = 16 * MiB;
constexpr size_t WS_WOUT = 17 * MiB;
constexpr size_t WS_WGU = 21 * MiB;
constexpr size_t WS_WD = 85 * MiB;
constexpr size_t WS_ACTB = 117 * MiB;
constexpr size_t WS_Y = 149 * MiB;
constexpr size_t WS_X1 = 181 * MiB;
constexpr size_t WS_ZR = 245 * MiB;
constexpr size_t WS_ZT = 325 * MiB;
constexpr size_t WS_TMP = 359 * MiB;
constexpr size_t WS_SMALL = 481 * MiB;
constexpr size_t WS_END = 489 * MiB;
constexpr size_t T_QC = WS_TMP, T_KC = WS_TMP + 16 * MiB, T_U = WS_TMP + 32 * MiB, T_CST = WS_TMP + 64 * MiB,
                 T_MPO = WS_TMP + 80 * MiB, T_MPML = WS_TMP + 104 * MiB, T_QIDX = WS_TMP + 106 * MiB;
constexpr size_t T_H = WS_TMP, T_YE = WS_TMP + 40 * MiB;
constexpr size_t SM_FLF = WS_SMALL, SM_FCL = SM_FLF + 256 * 1024, SM_MLI = SM_FCL + 256 * 1024, SM_MLF = SM_MLI + 256 * 1024,
                 SM_MB = SM_MLF + 256 * 1024, SM_MA = SM_MB + 256 * 1024, SM_MPX = SM_MA + 256 * 1024,
                 SM_FTS = SM_MPX + 256 * 1024, SM_KMEAN = SM_FTS + 4096, SM_EID = SM_KMEAN + 65536, SM_SLOT = SM_EID + 131072,
                 SM_WT = SM_SLOT + 131072, SM_ELIST = SM_WT + 131072, SM_MLSC = SM_ELIST + 2 * MiB, SM_NLOC = SM_MLSC + 16384,
                 SM_NST = SM_NLOC + 262144, SM_MSEL = SM_NST + 262144, SM_CNTQ = SM_MSEL + 262144, SM_END = SM_CNTQ + 131072;
static_assert(SM_END <= WS_END, "small region");
static_assert(WS_ZT + (size_t)1024 * ZTP * 2 <= WS_TMP, "transposed z buffer");
constexpr int CW_BAR = 4096;
__host__ __device__ constexpr int CW_ECNT(int l) { return 8192 + 64 * l; }
__host__ __device__ constexpr int CW_KMAX(int l) { return 9216 + 16 * l; }
__host__ __device__ constexpr int CW_GUC(int l) { return 12288 + 4096 * l; }

constexpr int RING_BYTES = 131072;
constexpr int LDS_BYTES = 163840;
constexpr int LDS_MISC = LDS_BYTES - 64;
constexpr int LDS_TAB = LDS_MISC - 4096;

__device__ __forceinline__ unsigned f2bf(float f) { unsigned u = __builtin_bit_cast(unsigned, f); return (u + 0x7fffu + ((u >> 16) & 1u)) >> 16; }
typedef __bf16 bf16x2_t __attribute__((ext_vector_type(2)));
__device__ __forceinline__ unsigned pk2(float lo, float hi) { const f32x2 v = {lo, hi}; const bf16x2_t b = __builtin_convertvector(v, bf16x2_t); return __builtin_bit_cast(unsigned, b); }
__device__ __forceinline__ float bf2f(unsigned h) { return __builtin_bit_cast(float, h << 16); }
__device__ __forceinline__ float bflo(unsigned w) { return __builtin_bit_cast(float, w << 16); }
__device__ __forceinline__ float bfhi(unsigned w) { return __builtin_bit_cast(float, w & 0xffff0000u); }
typedef unsigned u32x2v __attribute__((ext_vector_type(2)));
template <int CTRL> __device__ __forceinline__ float dpp_f(float v) { return __builtin_bit_cast(float, __builtin_amdgcn_update_dpp(0, __builtin_bit_cast(int, v), CTRL, 0xf, 0xf, true)); }
#ifndef RED_MODE
#define RED_MODE 7
#endif
__device__ __forceinline__ float x32f(float v) { if (RED_MODE & 2) { unsigned a = __builtin_bit_cast(unsigned, v), b = a; asm volatile("s_nop 1\n\tv_permlane32_swap_b32 %0, %1" : "+v"(a), "+v"(b));
        return (__builtin_amdgcn_mbcnt_hi(~0u, __builtin_amdgcn_mbcnt_lo(~0u, 0u)) < 32u) ? __builtin_bit_cast(float, b) : __builtin_bit_cast(float, a); } return __shfl_xor(v, 32); }
__device__ __forceinline__ float x16f(float v) { if (RED_MODE & 4) { unsigned a = __builtin_bit_cast(unsigned, v), b = a; asm volatile("s_nop 1\n\tv_permlane16_swap_b32 %0, %1" : "+v"(a), "+v"(b));
        return ((__builtin_amdgcn_mbcnt_hi(~0u, __builtin_amdgcn_mbcnt_lo(~0u, 0u)) >> 4) & 1u) ? __builtin_bit_cast(float, a) : __builtin_bit_cast(float, b); } return __shfl_xor(v, 16); }
__device__ __forceinline__ float grp_sum(float v) { v += x32f(v); v += x16f(v); return v; }
__device__ __forceinline__ float grp_max(float v) { v = fmaxf(v, x32f(v)); v = fmaxf(v, x16f(v)); return v; }
__device__ __forceinline__ float row_sum16(float v) { v += dpp_f<0xB1>(v); v += dpp_f<0x4E>(v); v += dpp_f<0x141>(v); v += dpp_f<0x140>(v); return v; }
__device__ __forceinline__ float row_max16(float v) { v = fmaxf(v, dpp_f<0xB1>(v)); v = fmaxf(v, dpp_f<0x4E>(v)); v = fmaxf(v, dpp_f<0x141>(v)); v = fmaxf(v, dpp_f<0x140>(v)); return v; }
__device__ __forceinline__ float wave_sum(float v) {
    if (RED_MODE & 1) v = row_sum16(v); else { v += __shfl_xor(v, 1); v += __shfl_xor(v, 2); v += __shfl_xor(v, 4); v += __shfl_xor(v, 8); }
    return grp_sum(v); }
__device__ __forceinline__ float wave_max(float v) {
    if (RED_MODE & 1) v = row_max16(v); else { v = fmaxf(v, __shfl_xor(v, 1)); v = fmaxf(v, __shfl_xor(v, 2)); v = fmaxf(v, __shfl_xor(v, 4)); v = fmaxf(v, __shfl_xor(v, 8)); }
    return grp_max(v); }
__device__ __forceinline__ float log_sigmoid(float x) { return fminf(x, 0.f) - log1pf(__expf(-fabsf(x))); }
__device__ __forceinline__ float sigmoidf(float x) { return 1.f / (1.f + __expf(-x)); }
__device__ __forceinline__ float siluf(float x) { return x / (1.f + __expf(-x)); }
#define MFMA16(a, b, c) __builtin_amdgcn_mfma_f32_16x16x32_bf16((a), (b), (c), 0, 0, 0)
#define VM_WAIT() asm volatile("s_waitcnt vmcnt(0)" ::: "memory")

#define XB_TMO      128
#define XB_XCNT(j)  (256  + 64 * (j))
#define XB_XSUB(j)  (1280 + 64 * (j))
#define XB_XGEN(j)  (2304 + 64 * (j))
#define XB_TOP      3328
#define XB_TOPGEN   3392
#define XCD_BAR_WORDS 3456
#define XB_SPIN_CAP (1u << 24)
__device__ __forceinline__ unsigned xb_ld(unsigned* p)              { return __hip_atomic_load(p, __ATOMIC_RELAXED, __HIP_MEMORY_SCOPE_AGENT); }
__device__ __forceinline__ unsigned xb_add(unsigned* p, unsigned v) { return __hip_atomic_fetch_add(p, v, __ATOMIC_RELAXED, __HIP_MEMORY_SCOPE_AGENT); }
__device__ __forceinline__ unsigned xb_xcc_id() { return (unsigned)__builtin_amdgcn_s_getreg((3 << 11) | 20) & 0xFu; }
#define XB_SPIN(cond, bar) do { unsigned _sp = 0; while (cond) { __builtin_amdgcn_s_sleep(1); \
    if ((++_sp & 255u) == 0u) { if (xb_ld(&(bar)[XB_TMO])) break; if (_sp > XB_SPIN_CAP) { atomicAdd(&(bar)[XB_TMO], 1u); break; } } } } while (0)
struct XcdBarrier { unsigned* bar; unsigned x; volatile LAS unsigned* st; };
__device__ __forceinline__ XcdBarrier xcd_barrier_post(unsigned* bar, volatile LAS unsigned* st) {
    XcdBarrier b; b.bar = bar; b.x = xb_xcc_id(); b.st = st;
    if (threadIdx.x == 0) (void)xb_add(&bar[XB_XCNT(b.x)], 1u);
    return b;
}
__device__ __forceinline__ void xcd_barrier_complete(unsigned* bar, unsigned x, unsigned& nloc, unsigned& nx) {
    const unsigned G = gridDim.x * gridDim.y * gridDim.z;
    unsigned sum, cnt, mine, sp = 0u;
    for (;;) {
        sum = 0u; cnt = 0u; mine = 0u;
#pragma unroll
        for (unsigned j = 0; j < 16; ++j) { const unsigned c = xb_ld(&bar[XB_XCNT(j)]); sum += c; cnt += (c > 0u) ? 1u : 0u; mine = (j == x) ? c : mine; }
        if (sum == G) break;
        __builtin_amdgcn_s_sleep(1);
        if ((++sp & 255u) == 0u) { if (xb_ld(&bar[XB_TMO])) break; if (sp > XB_SPIN_CAP) { atomicAdd(&bar[XB_TMO], 1u); break; } }
    }
    nloc = mine > 0u ? mine : 1u; nx = cnt > 0u ? cnt : 1u;
}
__device__ __forceinline__ void xcd_barrier(const XcdBarrier& b, const bool thread0) {
    asm volatile("s_waitcnt vmcnt(0)" ::: "memory");
    __syncthreads();
    if (thread0) {
        unsigned* bar = b.bar;
        __builtin_amdgcn_s_waitcnt(0);
        unsigned nloc = b.st[0], nx = b.st[1];
        if (nloc == 0u) { xcd_barrier_complete(bar, b.x, nloc, nx); b.st[0] = nloc; b.st[1] = nx; }
        const unsigned old = xb_add(&bar[XB_XSUB(b.x)], 1u);
        const unsigned gen = old / nloc;
        if (old + 1u == (gen + 1u) * nloc) {
            __builtin_amdgcn_fence(__ATOMIC_RELEASE, "agent");
            asm volatile("s_waitcnt vmcnt(0)" ::: "memory");
            const unsigned og = xb_add(&bar[XB_TOP], 1u);
            const unsigned tg = og / nx;
            if (og + 1u == (tg + 1u) * nx) xb_add(&bar[XB_TOPGEN], 1u);
            else XB_SPIN(xb_ld(&bar[XB_TOPGEN]) == tg, bar);
            __builtin_amdgcn_fence(__ATOMIC_ACQUIRE, "agent");
            xb_add(&bar[XB_XGEN(b.x)], 1u);
            asm volatile("s_waitcnt vmcnt(0)" ::: "memory");
        } else {
            XB_SPIN(xb_ld(&bar[XB_XGEN(b.x)]) == gen, bar);
            __builtin_amdgcn_fence(__ATOMIC_ACQUIRE, "agent");
            asm volatile("s_waitcnt vmcnt(0)" ::: "memory");
        }
    }
    __syncthreads();
}
namespace pg8 {
constexpr int BM = 256, BK = 64, HALF = 128, HTB = HALF * BK * 2, STAGE_BYTES = 8 * HTB, NXCD = 8, WGM = 8;
__host__ __device__ __forceinline__ int lds_byte(int r, int c) { const int st = (r >> 4) * 2 + (c >> 5), rr = r & 15, cc = c & 31, ob = rr * 64 + cc * 2; return st * 1024 + (ob ^ (((ob >> 9) & 1) << 5)); }
__host__ __device__ __forceinline__ void stage_rc(int b, int& R, int& C) { const int st = b / 1024, sb = b % 1024, swz = sb ^ (((sb >> 9) & 1) << 5); R = (st >> 1) * 16 + swz / 64; C = (st & 1) * 32 + (swz % 64) / 2; }
__host__ __device__ __forceinline__ int perm32(int rho) { const int n = rho >> 4, i = rho & 15; return 8 * (i >> 2) + 4 * n + (i & 3); }

struct GUnit {
    const char* A;
    const char* B;
    int pm, pn, x0;
    const int* list;
    int l0, nl;
};

template <class Epi, class Sched, bool GATHER = false, bool HOOK = false>
__device__ __forceinline__ void gemm_phase(LAS unsigned char* lds, const int K, const Sched& S, const Epi& E, const int tid, LAS unsigned* rtab = nullptr) {
    const int wid = __builtin_amdgcn_readfirstlane(tid >> 6), lane = tid & 63, wr = wid >> 2, wc = wid & 3, fr = lane & 15, fq = lane >> 4;
    const int nt = K / BK;
    unsigned voffA[2], voffB[2];
#pragma unroll
    for (int i = 0; i < 2; ++i) { int R, C; stage_rc(tid * 16 + i * 8192, R, C); const int Rb = (R & ~31) + perm32(R & 31); voffA[i] = (unsigned)(R * K + C) * 2u; voffB[i] = (unsigned)(Rb * K + C) * 2u; }
    const size_t kstep = (size_t)(BK * 2);
    const size_t hstep = (size_t)HALF * K * 2;
    const unsigned ldsw = (unsigned)wid * 1024u;
    const int aoff = lds_byte(wr * 64 + fr, fq * 8), boff = lds_byte(wc * 32 + fr, fq * 8);
#define PG8_SA(b, h) (((b) * 2 + (h)) * HTB)
#define PG8_SB(b, h) ((4 + (b) * 2 + (h)) * HTB)
#define PG8_STAGE(bufoff, gbase, voff) do { _Pragma("unroll") for (int _i = 0; _i < 2; ++_i) \
        __builtin_amdgcn_global_load_lds((const unsigned*)((const char*)(gbase) + (voff)[_i]), (LAS unsigned*)(lds + (bufoff) + ldsw + _i * 8192), 16, 0, 0); } while (0)
#define PG8_STAGE_A(bufoff, gbase, voff) do { _Pragma("unroll") for (int _i = 0; _i < 2; ++_i) \
        __builtin_amdgcn_global_load_lds((const unsigned*)((const char*)(gbase) + (voff)[_i]), (LAS unsigned*)(lds + (bufoff) + ldsw + _i * 8192), 16, 0, HOOK ? 16 : 0); } while (0)
#define PG8_LDA(dst, b, h) do { _Pragma("unroll") for (int m = 0; m < 4; ++m) _Pragma("unroll") for (int k = 0; k < 2; ++k) dst[m][k] = *(const LAS bf16x8*)(lds + PG8_SA(b, h) + aoff + m * 2048 + k * 1024); } while (0)
#define PG8_LDB(dst, b, h) do { _Pragma("unroll") for (int n = 0; n < 2; ++n) _Pragma("unroll") for (int k = 0; k < 2; ++k) dst[n][k] = *(const LAS bf16x8*)(lds + PG8_SB(b, h) + boff + n * 2048 + k * 1024); } while (0)
#define PG8_MMA(ai, bj, At, Bt) do { __builtin_amdgcn_s_setprio(1); _Pragma("unroll") for (int m = 0; m < 4; ++m) _Pragma("unroll") for (int n = 0; n < 2; ++n) _Pragma("unroll") for (int k = 0; k < 2; ++k) \
        acc[ai][bj][m][n] = __builtin_amdgcn_mfma_f32_16x16x32_bf16(Bt[n][k], At[m][k], acc[ai][bj][m][n], 0, 0, 0); __builtin_amdgcn_s_setprio(0); } while (0)
#define PG8_WAIT_V(n) asm volatile("s_waitcnt vmcnt(" #n ")" ::: "memory")
#define PG8_WAIT_L(n) asm volatile("s_waitcnt lgkmcnt(" #n ")" ::: "memory")
#define PG8_BAR __builtin_amdgcn_s_barrier()
#define PG8_SCHED __builtin_amdgcn_sched_barrier(0)
#define PG8_STAGE_G(bufoff, gbase, vo) do { _Pragma("unroll") for (int _i = 0; _i < 2; ++_i) \
        __builtin_amdgcn_global_load_lds((const unsigned*)((const char*)(gbase) + (vo)[_i]), (LAS unsigned*)(lds + (bufoff) + ldsw + _i * 8192), 16, 0, 0); } while (0)
#define PG8_ROWTAB(u, slot) do { if (tid < 256) { int _x = (u).l0 + tid; _x = _x < (u).nl ? _x : (u).nl - 1; rtab[(slot) * 256 + tid] = (unsigned)(u).list[_x] * (unsigned)(K * 2); } } while (0)
#define PG8_LOADCV(slot) do { _Pragma("unroll") for (int _h = 0; _h < 2; ++_h) _Pragma("unroll") for (int _i = 0; _i < 2; ++_i) { int _R, _C; stage_rc(tid * 16 + _i * 8192, _R, _C); \
        cv[_h][_i] = rtab[(slot) * 256 + _h * HALF + _R] + (unsigned)(_C * 2); } } while (0)
    GUnit cur, nxt; int ui = 0;
    if (!S.next(0, cur)) return;
    unsigned cv[2][2]; int par = 0;
    if constexpr (GATHER) { PG8_ROWTAB(cur, 0); __syncthreads(); PG8_LOADCV(0); }
    f32x4 acc[2][2][4][2];
#pragma unroll
    for (int a = 0; a < 2; ++a)
#pragma unroll
        for (int b = 0; b < 2; ++b)
#pragma unroll
            for (int m = 0; m < 4; ++m)
#pragma unroll
                for (int n = 0; n < 2; ++n) acc[a][b][m][n] = (f32x4){0.f, 0.f, 0.f, 0.f};
    bf16x8 At[4][2], B0[2][2], B1[2][2];
    const char* cA = cur.A; const char* cB = cur.B;
    if constexpr (HOOK) S.a_ready(cur, wid, lane);
    PG8_STAGE(PG8_SB(0, 0), cB, voffB); PG8_STAGE(PG8_SB(0, 1), cB + hstep, voffB);
    if constexpr (GATHER) { PG8_STAGE_G(PG8_SA(0, 0), cA, cv[0]); PG8_STAGE_G(PG8_SA(0, 1), cA, cv[1]); } else { PG8_STAGE_A(PG8_SA(0, 0), cA, voffA); PG8_STAGE_A(PG8_SA(0, 1), cA + hstep, voffA); }
    if (wr == 1) PG8_BAR;
    PG8_WAIT_V(2); PG8_BAR;
    PG8_STAGE(PG8_SB(1, 0), cB + kstep, voffB); if constexpr (GATHER) PG8_STAGE_G(PG8_SA(1, 0), cA + kstep, cv[0]); else PG8_STAGE_A(PG8_SA(1, 0), cA + kstep, voffA); PG8_STAGE(PG8_SB(1, 1), cB + hstep + kstep, voffB);
    PG8_WAIT_V(6); PG8_BAR;
    for (;;) {
        const bool has_next = S.next(ui + 1, nxt);
        const char* nA = has_next ? nxt.A : cA; const char* nB = has_next ? nxt.B : cB;
        if constexpr (GATHER) { if (has_next) PG8_ROWTAB(nxt, par ^ 1); }
        for (int t = 0; t < nt; t += 2) {
            const bool last = (t == nt - 2);
            const char* a1 = cA + (size_t)(t + 1) * kstep;
            const char* a2 = last ? nA : cA + (size_t)(t + 2) * kstep; const char* b2 = last ? nB : cB + (size_t)(t + 2) * kstep;
            const char* a3 = a2 + kstep; const char* b3 = b2 + kstep;
            if constexpr (HOOK) { if (last && has_next) S.a_ready(nxt, wid, lane); }
            PG8_LDB(B0, 0, 0); PG8_LDB(B1, 0, 1); PG8_SCHED; PG8_LDA(At, 0, 0);
            if constexpr (GATHER) { PG8_STAGE_G(PG8_SA(1, 1), a1, cv[1]); if (last && has_next) PG8_LOADCV(par ^ 1); } else PG8_STAGE_A(PG8_SA(1, 1), a1 + hstep, voffA);
            PG8_WAIT_V(8); PG8_WAIT_L(0); PG8_BAR; PG8_MMA(0, 0, At, B0); PG8_MMA(0, 1, At, B1); PG8_BAR; PG8_SCHED;
            PG8_LDA(At, 0, 1); PG8_STAGE(PG8_SB(0, 0), b2, voffB); PG8_STAGE(PG8_SB(0, 1), b2 + hstep, voffB); if constexpr (GATHER) PG8_STAGE_G(PG8_SA(0, 0), a2, cv[0]); else PG8_STAGE_A(PG8_SA(0, 0), a2, voffA);
            PG8_WAIT_V(8); PG8_WAIT_L(0); PG8_BAR; PG8_MMA(1, 0, At, B0); PG8_MMA(1, 1, At, B1); PG8_BAR; PG8_SCHED;
            PG8_LDB(B0, 1, 0); PG8_LDB(B1, 1, 1); PG8_SCHED; PG8_LDA(At, 1, 0); if constexpr (GATHER) PG8_STAGE_G(PG8_SA(0, 1), a2, cv[1]); else PG8_STAGE_A(PG8_SA(0, 1), a2 + hstep, voffA);
            PG8_WAIT_V(8); PG8_WAIT_L(0); PG8_BAR; PG8_MMA(0, 0, At, B0); PG8_MMA(0, 1, At, B1); PG8_BAR; PG8_SCHED;
            PG8_LDA(At, 1, 1); PG8_STAGE(PG8_SB(1, 0), b3, voffB); PG8_STAGE(PG8_SB(1, 1), b3 + hstep, voffB); if constexpr (GATHER) PG8_STAGE_G(PG8_SA(1, 0), a3, cv[0]); else PG8_STAGE_A(PG8_SA(1, 0), a3, voffA);
            PG8_WAIT_V(8); PG8_WAIT_L(0); PG8_BAR; PG8_MMA(1, 0, At, B0); PG8_MMA(1, 1, At, B1); PG8_BAR; PG8_SCHED;
        }
        if (wr == 0) PG8_BAR;
        E(acc, cur, wr, wc, fr, fq);
        if (!has_next) break;
#pragma unroll
        for (int a = 0; a < 2; ++a)
#pragma unroll
            for (int b = 0; b < 2; ++b)
#pragma unroll
                for (int m = 0; m < 4; ++m)
#pragma unroll
                    for (int n = 0; n < 2; ++n) acc[a][b][m][n] = (f32x4){0.f, 0.f, 0.f, 0.f};
        cur = nxt; cA = nA; cB = nB; ++ui; par ^= 1;
        if (wr == 1) PG8_BAR;
    }
    PG8_WAIT_V(0);
    PG8_BAR;
#undef PG8_SA
#undef PG8_SB
#undef PG8_STAGE
#undef PG8_STAGE_A
#undef PG8_LDA
#undef PG8_LDB
#undef PG8_MMA
#undef PG8_WAIT_V
#undef PG8_WAIT_L
#undef PG8_BAR
#undef PG8_SCHED
#undef PG8_STAGE_G
#undef PG8_ROWTAB
#undef PG8_LOADCV
}
}
__device__ __forceinline__ int win_srccol(int n) {
    if (n < 256) return n;
    if (n < 512) return n;
    if (n < 1024) return 772 + (n - 512);
    if (n < 1536) return 1284 + (n - 1024);
    if (n < 2048) return 2316 + (n - 1536);
    if (n < 2304) return 2828 + (n - 2048);
    if (n < 2560) return 3084 + (n - 2304);
    if (n < 2816) return 512 + (n - 2560);
    if (n < 3328) return 1796 + (n - 2816);
    return 3340 + (n - 3328);
}
__device__ __forceinline__ void transpose_item(const float* cp, int ld, bf16_t* WT, int Kd, int k0, int n0, LAS float* scr, int lane) {
    float tmp[32];
#pragma unroll
    for (int i = 0; i < 32; ++i) tmp[i] = cp[(size_t)(k0 + 2 * i + (lane >> 5)) * ld];
#pragma unroll
    for (int i = 0; i < 32; ++i) scr[(2 * i + (lane >> 5)) * 33 + (lane & 31)] = tmp[i];
    asm volatile("s_waitcnt vmcnt(0) lgkmcnt(0)" ::: "memory");
    const int c = lane & 7;
#pragma unroll
    for (int j = 0; j < 4; ++j) { const int n = (lane >> 3) + 8 * j; const LAS float* s = scr + (8 * c) * 33 + n;
        u32x4 o; o.x = pk2(s[0 * 33], s[1 * 33]); o.y = pk2(s[2 * 33], s[3 * 33]); o.z = pk2(s[4 * 33], s[5 * 33]); o.w = pk2(s[6 * 33], s[7 * 33]);
        *(u32x4*)(WT + (size_t)(n0 + n) * Kd + k0 + 8 * c) = o; }
    asm volatile("s_waitcnt lgkmcnt(0)" ::: "memory");
}
__device__ __forceinline__ void load_w12(const float* w_in_l, LAS float* w12, int tid) {
    for (int idx = tid; idx < 3 * 1024; idx += 512) { const int k = idx & 1023, q = idx >> 10; const int col = q == 0 ? 768 : (q == 1 ? 2308 : 2312);
        const f32x4 w = *(const f32x4*)(w_in_l + (size_t)k * INW + col);
        w12[(4 * q + 0) * 1024 + k] = w.x; w12[(4 * q + 1) * 1024 + k] = w.y; w12[(4 * q + 2) * 1024 + k] = w.z; w12[(4 * q + 3) * 1024 + k] = w.w; }
}
__device__ __forceinline__ void gates_row(const f32x4 (&v)[4], const LAS float* w12, const float* bff, const float* bmi, const float* bmf, float* flf, float* mli, float* mlf, int t, int lane) {
    float d[12];
#pragma unroll
    for (int c = 0; c < 12; ++c) { float s = 0.f;
#pragma unroll
        for (int j = 0; j < 4; ++j) { const f32x4 w = *(const LAS f32x4*)(w12 + c * 1024 + 256 * j + 4 * lane); s += (v[j].x * w.x + v[j].y * w.y) + (v[j].z * w.z + v[j].w * w.w); }
        d[c] = wave_sum(s); }
    if (lane < 4 && t >= 0) {
        float a = d[0], b = d[4], c = d[8];
#pragma unroll
        for (int h = 1; h < 4; ++h) { if (lane == h) { a = d[h]; b = d[4 + h]; c = d[8 + h]; } }
        flf[lane * S + t] = log_sigmoid(a + bff[lane]);
        mli[lane * S + t] = b + bmi[lane];
        mlf[lane * S + t] = log_sigmoid(c + bmf[lane]);
    }
}
__device__ __forceinline__ void ln_row(f32x4 (&v)[4], const float* gam, const float* bet, int lane) {
    float s = 0.f;
#pragma unroll
    for (int j = 0; j < 4; ++j) s += (v[j].x + v[j].y) + (v[j].z + v[j].w);
    const float mean = wave_sum(s) * (1.f / DM); float s2 = 0.f;
#pragma unroll
    for (int j = 0; j < 4; ++j) { v[j] = v[j] - mean; s2 += (v[j].x * v[j].x + v[j].y * v[j].y) + (v[j].z * v[j].z + v[j].w * v[j].w); }
    const float rstd = rsqrtf(wave_sum(s2) * (1.f / DM) + EPS);
#pragma unroll
    for (int j = 0; j < 4; ++j) { const f32x4 g = *(const f32x4*)(gam + 256 * j + 4 * lane), b = *(const f32x4*)(bet + 256 * j + 4 * lane); v[j] = v[j] * rstd * g + b; }
}
__device__ __forceinline__ void store_row_bf16(const f32x4 (&v)[4], bf16_t* orow, int lane) {
#pragma unroll
    for (int j = 0; j < 4; ++j) { u32x2 o; o.x = pk2(v[j].x, v[j].y); o.y = pk2(v[j].z, v[j].w); *(u32x2*)(orow + 256 * j + 4 * lane) = o; }
}

__device__ __forceinline__ void p0_prologue(const float* x, const int* pos, const float* w_in, const float* w_out, const float* bff, const float* bmi, const float* bmf,
                                            unsigned char* ws, LAS unsigned char* lds, int tid, int lane, int wave, int bid, int G) {
    LAS float* scr = (LAS float*)(lds + wave * 16384);
    const int gw = bid * 8 + wave, NGW = G * 8;
    constexpr int I_IN = 16 * (NZ / 32), I_OUT = 16 * 32;
    for (int it = gw; it < NL * (I_IN + I_OUT); it += NGW) {
        const int l = it / (I_IN + I_OUT); int r = it % (I_IN + I_OUT);
        if (r < I_IN) { const int kb = r / (NZ / 32), nb = r % (NZ / 32); const int n0 = nb * 32;
            const float* cp = w_in + (size_t)l * DM * INW + win_srccol(n0 + (lane & 31));
            transpose_item(cp, INW, (bf16_t*)(ws + WS_WIN) + (size_t)l * NZ * DM, DM, kb * 64, n0, scr, lane);
        } else { r -= I_IN; const int kb = r / 32, nb = r % 32; const int n0 = nb * 32;
            const float* cp = w_out + (size_t)l * DM * DM + n0 + (lane & 31);
            transpose_item(cp, DM, (bf16_t*)(ws + WS_WOUT) + (size_t)l * DM * DM, DM, kb * 64, n0, scr, lane); }
    }
    {
        const double inv[8] = {1.0, 0.19392274474868576, 0.03760603093086393, 0.007292664737217109, 0.001414213562373095, 0.0002742481756762073, 5.318295896944988e-05, 1.031338537721246e-05};
        float* rt = (float*)(ws + WS_ROPE);
        for (int idx = bid * 512 + tid; idx < S * 8; idx += G * 512) { const int t = idx >> 3, i = idx & 7; double iv = inv[0];
#pragma unroll
            for (int q = 1; q < 8; ++q) iv = (i == q) ? inv[q] : iv;
            const double ang = (double)pos[t] * iv; rt[2 * idx] = (float)cos(ang); rt[2 * idx + 1] = (float)sin(ang); }
    }
    __syncthreads();
    LAS float* w12 = (LAS float*)lds;
    load_w12(w_in, w12, tid);
    __syncthreads();
    float* flf = (float*)(ws + SM_FLF); float* mli = (float*)(ws + SM_MLI); float* mlf = (float*)(ws + SM_MLF);
    bf16_t* xb = (bf16_t*)(ws + WS_ACTB);
#pragma unroll 2
    for (int t = gw; t < S; t += NGW) {
        f32x4 v[4];
#pragma unroll
        for (int j = 0; j < 4; ++j) v[j] = *(const f32x4*)(x + (size_t)t * DM + 256 * j + 4 * lane);
        store_row_bf16(v, xb + (size_t)t * DM, lane);
        gates_row(v, w12, bff, bmi, bmf, flf, mli, mlf, t, lane);
    }
    __syncthreads();
}

__device__ __forceinline__ void moe_weights(const float* w_gate_l, const float* w_up_l, const float* w_down_l, unsigned char* ws, LAS unsigned char* lds, int lane, int wave, int gw, int NGW, int it0, int it1) {
    LAS float* scr = (LAS float*)(lds + wave * 16384);
    constexpr int I_GU = 16 * 32, I_D = 8 * 32;
    for (int it = it0 + gw; it < it1; it += NGW) {
        const int e = it / (I_GU + I_D); int r = it % (I_GU + I_D);
        if (r < I_GU) { const int kb = r / 32, nb = r % 32, n0 = nb * 32; const int n = n0 + (lane & 31); const int a = n >> 3, b = n & 7; const int hid = 4 * a + (b & 3);
            const float* cp = ((b >> 2) ? w_up_l : w_gate_l) + (size_t)e * DM * DE + hid;
            transpose_item(cp, DE, (bf16_t*)(ws + WS_WGU) + (size_t)e * DM * DM, DM, kb * 64, n0, scr, lane);
        } else { r -= I_GU; const int kb = r / 32, nb = r % 32, n0 = nb * 32;
            const float* cp = w_down_l + (size_t)e * DE * DM + n0 + (lane & 31);
            transpose_item(cp, DM, (bf16_t*)(ws + WS_WD) + (size_t)e * DM * DE, DE, kb * 64, n0, scr, lane); }
    }
}
constexpr int MOE_ITEMS = NE * (16 * 32 + 8 * 32);
constexpr int MOE_FILL = 6144;
__device__ __forceinline__ void mix1_unit(int u, unsigned char* ws, unsigned* ctl_kmax, LAS unsigned char* lds, int tid, int lane, int wave) {
    const int blk = u >> 2, h = u & 3, t0 = blk * 256;
    bf16_t* ZR = (bf16_t*)(ws + WS_ZR);
    const float* rope = (const float*)(ws + WS_ROPE);
    LAS float* kr = (LAS float*)lds;
    LAS float* part = (LAS float*)(lds + 16384);
    LAS float* sq = (LAS float*)(lds + 16384 + 2048);
    {
        const int tl = tid & 255, which = tid >> 8; const int t = t0 + tl;
        bf16_t* p = ZR + (size_t)t * ZRW + (which ? ZR_BK : ZR_BQ) + h * 64;
        const u32x4 w0 = *(const u32x4*)p, w1 = *(const u32x4*)(p + 8);
        float u1[8], u2[8];
        u1[0] = bflo(w0.x); u1[1] = bfhi(w0.x); u1[2] = bflo(w0.y); u1[3] = bfhi(w0.y); u1[4] = bflo(w0.z); u1[5] = bfhi(w0.z); u1[6] = bflo(w0.w); u1[7] = bfhi(w0.w);
        u2[0] = bflo(w1.x); u2[1] = bfhi(w1.x); u2[2] = bflo(w1.y); u2[3] = bfhi(w1.y); u2[4] = bflo(w1.z); u2[5] = bfhi(w1.z); u2[6] = bflo(w1.w); u2[7] = bfhi(w1.w);
        float o1[8], o2[8];
#pragma unroll
        for (int i = 0; i < 8; ++i) { const f32x2 cs = *(const f32x2*)(rope + ((size_t)t * 8 + i) * 2); o1[i] = u1[i] * cs.x - u2[i] * cs.y; o2[i] = u1[i] * cs.y + u2[i] * cs.x; }
        u32x4 r0, r1;
        r0.x = pk2(o1[0], o1[1]); r0.y = pk2(o1[2], o1[3]); r0.z = pk2(o1[4], o1[5]); r0.w = pk2(o1[6], o1[7]);
        r1.x = pk2(o2[0], o2[1]); r1.y = pk2(o2[2], o2[3]); r1.z = pk2(o2[4], o2[5]); r1.w = pk2(o2[6], o2[7]);
        *(u32x4*)p = r0; *(u32x4*)(p + 8) = r1;
        if (which) {
            LAS float* d = kr + tl * 16;
            d[0] = bflo(r0.x); d[1] = bfhi(r0.x); d[2] = bflo(r0.y); d[3] = bfhi(r0.y); d[4] = bflo(r0.z); d[5] = bfhi(r0.z); d[6] = bflo(r0.w); d[7] = bfhi(r0.w);
            d[8] = bflo(r1.x); d[9] = bfhi(r1.x); d[10] = bflo(r1.y); d[11] = bfhi(r1.y); d[12] = bflo(r1.z); d[13] = bfhi(r1.z); d[14] = bflo(r1.w); d[15] = bfhi(r1.w);
        }
    }
    {
        const int tl = tid & 255, half = tid >> 8;
        const bf16_t* p = ZR + (size_t)(t0 + tl) * ZRW + ZR_FK + h * 64 + half * 32;
        float s = 0.f;
#pragma unroll
        for (int j = 0; j < 4; ++j) { const u32x4 w = *(const u32x4*)(p + 8 * j);
            float a;
            a = bflo(w.x); s += a * a; a = bfhi(w.x); s += a * a; a = bflo(w.y); s += a * a; a = bfhi(w.y); s += a * a;
            a = bflo(w.z); s += a * a; a = bfhi(w.z); s += a * a; a = bflo(w.w); s += a * a; a = bfhi(w.w); s += a * a; }
        sq[tid] = s;
    }
    __syncthreads();
    {
        const int d = tid & 63, pp = tid >> 6; float s = 0.f;
        if (d < 16) { for (int i = 0; i < 32; ++i) s += kr[(pp * 32 + i) * 16 + d]; }
        else { const bf16_t* p = ZR + (size_t)(t0 + pp * 32) * ZRW + ZR_BK + h * 64 + d; for (int i = 0; i < 32; ++i) s += bf2f(p[(size_t)i * ZRW]); }
        part[pp * 64 + d] = s;
    }
    if (wave < 4) {
        const float* flf = (const float*)(ws + SM_FLF) + (size_t)h * S + t0 + wave * 64;
        float v = flf[lane];
#pragma unroll
        for (int o = 1; o < 64; o <<= 1) { const float n = __shfl_up(v, o); if (lane >= o) v += n; }
        ((float*)(ws + SM_FCL))[(size_t)h * S + t0 + wave * 64 + lane] = v;
        if (lane == 63) ((float*)(ws + SM_FTS))[h * 256 + blk * 4 + wave] = v;
    } else {
        const int i = tid - 256; float m = sq[i] + sq[i + 256];
        m = wave_max(m);
        if (lane == 0) atomicMax(ctl_kmax + h, __builtin_bit_cast(unsigned, m));
    }
    __syncthreads();
    if (tid < 64) { float s = 0.f;
#pragma unroll
        for (int pp = 0; pp < 8; ++pp) s += part[pp * 64 + tid];
        ((float*)(ws + SM_KMEAN))[((size_t)h * 64 + blk) * 64 + tid] = s * (1.f / 256.f); }
    __syncthreads();
}
struct RowState { f32x4 O[4]; float m, l; };
constexpr float LOG2E = 1.4426950408889634f, SC2 = 0.125f * LOG2E;

struct KVFrag { bf16x8 k[4]; u32x2 v[8]; };
__device__ __forceinline__ void kv_fetch(KVFrag& f, const bf16_t* krow, const bf16_t* vT, int kb, int lane) {
    const int qi = lane & 15, g = lane >> 4;
    const bf16_t* k0p = krow + (size_t)(kb + qi) * ZRW + 8 * g;
    const bf16_t* k1p = k0p + (size_t)16 * ZRW;
    f.k[0] = *(const bf16x8*)k0p; f.k[1] = *(const bf16x8*)(k0p + 32); f.k[2] = *(const bf16x8*)k1p; f.k[3] = *(const bf16x8*)(k1p + 32);
#pragma unroll
    for (int dt = 0; dt < 4; ++dt) { const bf16_t* vp = vT + (size_t)(16 * dt + qi) * ZTP + kb + 4 * g; f.v[2 * dt] = *(const u32x2*)vp; f.v[2 * dt + 1] = *(const u32x2*)(vp + 16); }
}
__device__ __forceinline__ void attn_compute32(RowState& st, const bf16x8 (&Qf)[2], const KVFrag& f, const f32x4 b0, const f32x4 b1) {
    f32x4 s0 = {0.f, 0.f, 0.f, 0.f}, s1 = {0.f, 0.f, 0.f, 0.f};
    s0 = MFMA16(f.k[0], Qf[0], s0); s0 = MFMA16(f.k[1], Qf[1], s0);
    s1 = MFMA16(f.k[2], Qf[0], s1); s1 = MFMA16(f.k[3], Qf[1], s1);
    float mx = -INFINITY;
#pragma unroll
    for (int r = 0; r < 4; ++r) { s0[r] = s0[r] * SC2 + b0[r]; s1[r] = s1[r] * SC2 + b1[r]; mx = fmaxf(mx, fmaxf(s0[r], s1[r])); }
    mx = grp_max(mx);
    float ps = 0.f; float p0[4], p1[4];
    if (__all(mx <= st.m)) {
#pragma unroll
        for (int r = 0; r < 4; ++r) { p0[r] = __builtin_amdgcn_exp2f(s0[r] - st.m); p1[r] = __builtin_amdgcn_exp2f(s1[r] - st.m); ps += p0[r] + p1[r]; }
        st.l += ps;
    } else {
        const float mn = fmaxf(st.m, mx);
        const float msafe = (mn == -INFINITY) ? 0.f : mn;
        const float alpha = __builtin_amdgcn_exp2f(st.m - msafe);
#pragma unroll
        for (int r = 0; r < 4; ++r) { p0[r] = __builtin_amdgcn_exp2f(s0[r] - msafe); p1[r] = __builtin_amdgcn_exp2f(s1[r] - msafe); ps += p0[r] + p1[r]; }
        st.l = st.l * alpha + ps; st.m = mn;
#pragma unroll
        for (int dt = 0; dt < 4; ++dt) st.O[dt] = st.O[dt] * alpha;
    }
    u32x4 pw; pw.x = pk2(p0[0], p0[1]); pw.y = pk2(p0[2], p0[3]); pw.z = pk2(p1[0], p1[1]); pw.w = pk2(p1[2], p1[3]);
    const bf16x8 pb = __builtin_bit_cast(bf16x8, pw);
#pragma unroll
    for (int dt = 0; dt < 4; ++dt) { u32x4 vw; vw.x = f.v[2 * dt].x; vw.y = f.v[2 * dt].y; vw.z = f.v[2 * dt + 1].x; vw.w = f.v[2 * dt + 1].y;
        st.O[dt] = MFMA16(__builtin_bit_cast(bf16x8, vw), pb, st.O[dt]); }
}
__device__ __forceinline__ void attn_finish(RowState& st, const float* gain, bf16_t* yrow, int lane) {
    const int g = lane >> 4;
    const float inv = 1.f / st.l; float ss = 0.f;
#pragma unroll
    for (int dt = 0; dt < 4; ++dt) { st.O[dt] = st.O[dt] * inv; ss += (st.O[dt].x * st.O[dt].x + st.O[dt].y * st.O[dt].y) + (st.O[dt].z * st.O[dt].z + st.O[dt].w * st.O[dt].w); }
    ss = grp_sum(ss);
    const float rs = rsqrtf(ss * (1.f / 64.f) + EPS);
#pragma unroll
    for (int dt = 0; dt < 4; ++dt) { const f32x4 gg = *(const f32x4*)(gain + 16 * dt + 4 * g); const f32x4 o = st.O[dt] * rs * gg;
        u32x2 w; w.x = pk2(o.x, o.y); w.y = pk2(o.z, o.w); *(u32x2*)(yrow + 16 * dt + 4 * g) = w; }
}

constexpr int KS_PITCH = 72, VS_PITCH = 264, KS_BYTES = 256 * KS_PITCH * 2, VS_BYTES = 64 * VS_PITCH * 2;
__device__ __forceinline__ void stage_kv_block(const bf16_t* krow  , const bf16_t* vT  , int key0, LAS unsigned char* lds, int tid) {
    LAS unsigned char* Ks = lds; LAS unsigned char* Vs = lds + KS_BYTES;
#pragma unroll
    for (int i = 0; i < 4; ++i) { const int c = tid + 512 * i; const int row = c >> 3, part = c & 7;
        const u32x4 v = *(const u32x4*)(krow + (size_t)(key0 + row) * ZRW + part * 8);
        *(LAS u32x4*)(Ks + row * (KS_PITCH * 2) + part * 16) = v; }
#pragma unroll
    for (int i = 0; i < 4; ++i) { const int c = tid + 512 * i; const int row = c >> 5, part = c & 31;
        const u32x4 v = *(const u32x4*)(vT + (size_t)row * ZTP + key0 + part * 8);
        *(LAS u32x4*)(Vs + row * (VS_PITCH * 2) + part * 16) = v; }
}
template <int VPB>
__device__ __forceinline__ void attn_step32_ldsp(RowState& st, const bf16x8 (&Qf)[2], LAS unsigned char* Ks, LAS unsigned char* Vs, int kb, const f32x4 b0, const f32x4 b1, int lane) {
    const int qi = lane & 15, g = lane >> 4;
    f32x4 s0 = {0.f, 0.f, 0.f, 0.f}, s1 = {0.f, 0.f, 0.f, 0.f};
    const LAS unsigned char* k0p = Ks + (kb + qi) * (KS_PITCH * 2) + 16 * g;
    const LAS unsigned char* k1p = k0p + 16 * (KS_PITCH * 2);
    s0 = MFMA16(*(const LAS bf16x8*)k0p, Qf[0], s0); s0 = MFMA16(*(const LAS bf16x8*)(k0p + 64), Qf[1], s0);
    s1 = MFMA16(*(const LAS bf16x8*)k1p, Qf[0], s1); s1 = MFMA16(*(const LAS bf16x8*)(k1p + 64), Qf[1], s1);
    float mx = -INFINITY;
#pragma unroll
    for (int r = 0; r < 4; ++r) { s0[r] = s0[r] * SC2 + b0[r]; s1[r] = s1[r] * SC2 + b1[r]; mx = fmaxf(mx, fmaxf(s0[r], s1[r])); }
    mx = grp_max(mx);
    float ps = 0.f; float p0[4], p1[4];
    if (__all(mx <= st.m)) {
#pragma unroll
        for (int r = 0; r < 4; ++r) { p0[r] = __builtin_amdgcn_exp2f(s0[r] - st.m); p1[r] = __builtin_amdgcn_exp2f(s1[r] - st.m); ps += p0[r] + p1[r]; }
        st.l += ps;
    } else {
        const float mn = fmaxf(st.m, mx);
        const float msafe = (mn == -INFINITY) ? 0.f : mn;
        const float alpha = __builtin_amdgcn_exp2f(st.m - msafe);
#pragma unroll
        for (int r = 0; r < 4; ++r) { p0[r] = __builtin_amdgcn_exp2f(s0[r] - msafe); p1[r] = __builtin_amdgcn_exp2f(s1[r] - msafe); ps += p0[r] + p1[r]; }
        st.l = st.l * alpha + ps; st.m = mn;
#pragma unroll
        for (int dt = 0; dt < 4; ++dt) st.O[dt] = st.O[dt] * alpha;
    }
    u32x4 pw; pw.x = pk2(p0[0], p0[1]); pw.y = pk2(p0[2], p0[3]); pw.z = pk2(p1[0], p1[1]); pw.w = pk2(p1[2], p1[3]);
    const bf16x8 pb = __builtin_bit_cast(bf16x8, pw);
#pragma unroll
    for (int dt = 0; dt < 4; ++dt) { const LAS unsigned char* vp = Vs + (16 * dt + qi) * VPB + (kb + 4 * g) * 2;
        u32x4 vw; const u32x2 lo = *(const LAS u32x2*)vp, hi = *(const LAS u32x2*)(vp + 32); vw.x = lo.x; vw.y = lo.y; vw.z = hi.x; vw.w = hi.y;
        st.O[dt] = MFMA16(__builtin_bit_cast(bf16x8, vw), pb, st.O[dt]); }
}

__device__ __forceinline__ void attn_step32_lds(RowState& st, const bf16x8 (&Qf)[2], LAS unsigned char* lds, int kb, const f32x4 b0, const f32x4 b1, int lane) {
    attn_step32_ldsp<VS_PITCH * 2>(st, Qf, lds, lds + KS_BYTES, kb, b0, b1, lane);
}

constexpr int FW_KEYS = 384, FW_VPB = (FW_KEYS + 8) * 2, FW_KBYTES = FW_KEYS * KS_PITCH * 2, FW_VBYTES = 64 * FW_VPB;
__device__ __forceinline__ void fox_unit(int h, int qt, unsigned char* ws, float kmaxn, const float* g_fox, LAS unsigned char* lds, int tid, int lane, int wave, int cap = 1 << 30, bf16_t* ydst = nullptr) {
    const int qi = lane & 15, g = lane >> 4;
    const int Q0 = qt * 128, q0 = Q0 + wave * 16, q = q0 + qi;
    const bf16_t* ZR = (const bf16_t*)(ws + WS_ZR); const bf16_t* ZT = (const bf16_t*)(ws + WS_ZT);
    const float* clh = (const float*)(ws + SM_FCL) + (size_t)h * S; const float* tsum = (const float*)(ws + SM_FTS) + h * 256;
    const bf16_t* krow = ZR + ZR_FK + h * 64; const bf16_t* vT = ZT + (size_t)(ZT_FV + h * 64) * ZTP;
    LAS unsigned char* Kw = lds; LAS unsigned char* Vw = lds + FW_KBYTES; LAS float* clw = (LAS float*)(lds + FW_KBYTES + FW_VBYTES);
    const int kw0 = Q0 >= 256 ? Q0 - 256 : 0, nk = Q0 + 128 - kw0;
    __syncthreads();
    for (int c = tid; c < nk * 8; c += 512) { const int row = c >> 3, part = c & 7;
        *(LAS u32x4*)(Kw + row * (KS_PITCH * 2) + part * 16) = *(const u32x4*)(krow + (size_t)(kw0 + row) * ZRW + part * 8); }
    { const int cpr = nk >> 3;
      for (int c = tid; c < 64 * cpr; c += 512) { const int row = c / cpr, part = c - row * cpr;
        *(LAS u32x4*)(Vw + row * FW_VPB + part * 16) = *(const u32x4*)(vT + (size_t)row * ZTP + kw0 + part * 8); } }
    for (int c = tid; c < nk; c += 512) clw[c] = clh[kw0 + c] * LOG2E;
    const bf16_t* qrow = ZR + (size_t)q * ZRW + ZR_FQ + h * 64;
    bf16x8 Qf[2]; Qf[0] = *(const bf16x8*)(qrow + 8 * g); Qf[1] = *(const bf16x8*)(qrow + 32 + 8 * g);
    float qs = 0.f;
#pragma unroll
    for (int k = 0; k < 2; ++k)
#pragma unroll
        for (int e = 0; e < 8; ++e) { const float v = bf2f((unsigned short)Qf[k][e]); qs += v * v; }
    const float qn = sqrtf(grp_sum(qs));
    const float cq = clh[q] * LOG2E;
    RowState st;
#pragma unroll
    for (int dt = 0; dt < 4; ++dt) st.O[dt] = (f32x4){0.f, 0.f, 0.f, 0.f};
    st.m = -INFINITY; st.l = 0.f;
    __syncthreads();
    float dT = 0.f; int ktile = q0 >> 6;
    int kb = q0 & ~31;
    bool more = true;
    for (; kb >= kw0; kb -= 32) {
        const int kt = kb >> 6;
        if (kt != ktile) { dT += tsum[kt] * LOG2E; ktile = kt; }
        const float bq = cq + dT; const int kl = kb - kw0;
        const f32x4 c0 = *(const LAS f32x4*)(clw + kl + 4 * g), c1 = *(const LAS f32x4*)(clw + kl + 16 + 4 * g);
        f32x4 b0, b1;
#pragma unroll
        for (int r = 0; r < 4; ++r) { b0[r] = (kb + 4 * g + r <= q) ? bq - c0[r] : -INFINITY; b1[r] = (kb + 16 + 4 * g + r <= q) ? bq - c1[r] : -INFINITY; }
        attn_step32_ldsp<FW_VPB>(st, Qf, Kw, Vw, kl, b0, b1, lane);
        if (kb == 0) { more = false; break; }
        const float bound = qn * kmaxn * SC2 + (bq - clw[kl]);
        if (__all(bound < st.m - 40.f * LOG2E)) { more = false; break; }
        if (--cap <= 0) { more = false; break; }
    }
    if (more) {
        KVFrag cur, nxt;
        kv_fetch(cur, krow, vT, kb, lane);
        for (; kb >= 0; kb -= 32) {
            if (kb >= 32) kv_fetch(nxt, krow, vT, kb - 32, lane);
            const int kt = kb >> 6;
            if (kt != ktile) { dT += tsum[kt] * LOG2E; ktile = kt; }
            const float bq = cq + dT;
            const f32x4 c0 = *(const f32x4*)(clh + kb + 4 * g), c1 = *(const f32x4*)(clh + kb + 16 + 4 * g);
            f32x4 b0, b1;
#pragma unroll
            for (int r = 0; r < 4; ++r) { b0[r] = bq - c0[r] * LOG2E; b1[r] = bq - c1[r] * LOG2E; }
            attn_compute32(st, Qf, cur, b0, b1);
            if (kb == 0) break;
            const float bound = qn * kmaxn * SC2 + (bq - clh[kb] * LOG2E);
            if (__all(bound < st.m - 40.f * LOG2E)) break;
            cur = nxt;
        }
    }
    st.l = grp_sum(st.l);
    attn_finish(st, g_fox + h * 64, (ydst ? ydst : (bf16_t*)(ws + WS_Y)) + (size_t)q * DM + h * 64, lane);
}

__device__ __forceinline__ void moba_gate_unit(int h, int qt, unsigned char* ws, LAS unsigned char* lds, int tid, int lane, int wave) {
    const int own = qt >> 1;
    unsigned* msel = (unsigned*)(ws + SM_MSEL) + (size_t)h * S;
    int* cntq = (int*)(ws + SM_CNTQ) + (size_t)h * 64 * 128;
    const int tq0 = qt * 128 + wave * 16;
    if (own == 0) { if (lane < 16) msel[tq0 + lane] = 0u; if (tid < 64) cntq[tid * 128 + qt] = 0; return; }
    LAS int* hist = (LAS int*)lds;
    __syncthreads();
    if (tid < 64) hist[tid] = 0;
    __syncthreads();
    const int qi = lane & 15, g = lane >> 4;
    const bf16_t* qrow = (const bf16_t*)(ws + WS_ZR) + (size_t)(tq0 + qi) * ZRW + ZR_BQ + h * 64;
    bf16x8 Qf[2]; Qf[0] = *(const bf16x8*)(qrow + 8 * g); Qf[1] = *(const bf16x8*)(qrow + 32 + 8 * g);
    const float* kmean = (const float*)(ws + SM_KMEAN) + (size_t)h * 64 * 64;
    float v[16];
#pragma unroll
    for (int tile = 0; tile < 4; ++tile) {
        f32x4 acc = {0.f, 0.f, 0.f, 0.f};
#pragma unroll
        for (int ks = 0; ks < 2; ++ks) {
            const float* kp = kmean + (size_t)(16 * tile + qi) * 64 + 32 * ks + 8 * g;
            const f32x4 a0 = *(const f32x4*)kp, a1 = *(const f32x4*)(kp + 4);
            u32x4 hi, lo;
            hi.x = pk2(a0.x, a0.y); hi.y = pk2(a0.z, a0.w); hi.z = pk2(a1.x, a1.y); hi.w = pk2(a1.z, a1.w);
            lo.x = pk2(a0.x - bflo(hi.x), a0.y - bfhi(hi.x)); lo.y = pk2(a0.z - bflo(hi.y), a0.w - bfhi(hi.y));
            lo.z = pk2(a1.x - bflo(hi.z), a1.y - bfhi(hi.z)); lo.w = pk2(a1.z - bflo(hi.w), a1.w - bfhi(hi.w));
            acc = MFMA16(__builtin_bit_cast(bf16x8, hi), Qf[ks], acc);
            acc = MFMA16(__builtin_bit_cast(bf16x8, lo), Qf[ks], acc);
        }
#pragma unroll
        for (int r = 0; r < 4; ++r) v[4 * tile + r] = (16 * tile + 4 * g + r < own) ? acc[r] : -INFINITY;
    }
    const int nv = own < 3 ? own : 3;
    unsigned sel = 0u;
#pragma unroll
    for (int k = 0; k < 3; ++k) {
        float lm = v[0]; int li = 4 * g;
#pragma unroll
        for (int e = 1; e < 16; ++e) { const int jj = 16 * (e >> 2) + 4 * g + (e & 3); if (v[e] > lm) { lm = v[e]; li = jj; } }
        const float gm = grp_max(lm);
        int cand = (lm == gm) ? li : 255;
        cand = min(cand, __shfl_xor(cand, 16)); cand = min(cand, __shfl_xor(cand, 32));
        sel |= (unsigned)cand << (8 * k);
#pragma unroll
        for (int e = 0; e < 16; ++e) { const int jj = 16 * (e >> 2) + 4 * g + (e & 3); if (jj == cand) v[e] = -INFINITY; }
    }
    if (g < nv) { const int j = (int)((sel >> (8 * g)) & 0xff);
        const int pos = __hip_atomic_fetch_add(hist + j, 1, __ATOMIC_RELAXED, __HIP_MEMORY_SCOPE_WORKGROUP);
        ((unsigned short*)(ws + T_QIDX))[(((size_t)h * 64 + j) * 128 + qt) * 128 + pos] = (unsigned short)((wave * 16 + qi) | (g << 7)); }
    if (g == 0) msel[tq0 + qi] = (sel & 0xffffffu) | ((unsigned)nv << 24);
    __syncthreads();
    if (tid < 64) cntq[tid * 128 + qt] = hist[tid];
}

__device__ __forceinline__ void moba_part_unit(int h, int j, int ch, int tot, unsigned char* ws, LAS unsigned char* lds, LAS unsigned char* ltab, int tid, int lane, int wave, int dbg = 0, bool staged = false) {
    LAS int* pfx = (LAS int*)(ltab + 2112);
    LAS unsigned* slice = (LAS unsigned*)(ltab + 2640);
    LAS int* wtot = (LAS int*)(ltab + 3664);
    const unsigned* msel = (const unsigned*)(ws + SM_MSEL) + (size_t)h * S;
    const int* cntq = (const int*)(ws + SM_CNTQ) + ((size_t)h * 64 + j) * 128;
    const bf16_t* ZR = (const bf16_t*)(ws + WS_ZR); const bf16_t* ZT = (const bf16_t*)(ws + WS_ZT);
    __syncthreads();
    if (!staged) stage_kv_block(ZR + ZR_BK + h * 64, ZT + (size_t)(ZT_BV + h * 64) * ZTP, j * 256, lds, tid);
    if (!staged && wave == 0) {
        int v0 = cntq[lane], v1 = cntq[64 + lane];
#pragma unroll
        for (int o = 1; o < 64; o <<= 1) { const int n0 = __shfl_up(v0, o), n1 = __shfl_up(v1, o); if (lane >= o) { v0 += n0; v1 += n1; } }
        v1 += __shfl(v0, 63);
        if (lane == 0) pfx[0] = 0;
        pfx[1 + lane] = v0; pfx[65 + lane] = v1;
    }
    __syncthreads();
    const int lo_pos = 256 * ch, hi_pos = (lo_pos + 256 < tot) ? lo_pos + 256 : tot;
    if (tid < hi_pos - lo_pos) {
        const int pos = lo_pos + tid;
        int a = 0, b = 127; while (a < b) { const int mid = (a + b + 1) >> 1; if (pfx[mid] <= pos) a = mid; else b = mid - 1; }
        const unsigned w = ((const unsigned short*)(ws + T_QIDX))[(((size_t)h * 64 + j) * 128 + a) * 128 + (pos - pfx[a])];
        slice[tid] = (unsigned)(a * 128 + (w & 127u)) | ((w >> 7) << 14);
    }
    __syncthreads();
    const int n = hi_pos - lo_pos;
    const int qi = lane & 15, g = lane >> 4;
    const int pA = wave * 16, pB = 128 + wave * 16;
    if (pA >= n) return;
    const bool hasB = pB < n;
    const bool vA = pA + qi < n, vB = pB + qi < n;
    const unsigned eA = slice[vA ? pA + qi : n - 1], eB = slice[vB ? pB + qi : n - 1];
    const int tA = eA & 0x3fff, rA = eA >> 14, tB = eB & 0x3fff, rB = eB >> 14;
    const bf16_t* qrA = ZR + (size_t)tA * ZRW + ZR_BQ + h * 64; const bf16_t* qrB = ZR + (size_t)tB * ZRW + ZR_BQ + h * 64;
    bf16x8 QA[2], QB[2]; QA[0] = *(const bf16x8*)(qrA + 8 * g); QA[1] = *(const bf16x8*)(qrA + 32 + 8 * g); QB[0] = *(const bf16x8*)(qrB + 8 * g); QB[1] = *(const bf16x8*)(qrB + 32 + 8 * g);
    RowState sA, sB;
#pragma unroll
    for (int dt = 0; dt < 4; ++dt) { sA.O[dt] = (f32x4){0.f, 0.f, 0.f, 0.f}; sB.O[dt] = (f32x4){0.f, 0.f, 0.f, 0.f}; }
    sA.m = -INFINITY; sA.l = 0.f; sB.m = -INFINITY; sB.l = 0.f;
    const f32x4 z = {0.f, 0.f, 0.f, 0.f};
    if (dbg & 1) { sA.l = 1.f; sB.l = 1.f; sA.m = 0.f; sB.m = 0.f; }
    else if (hasB) {
#pragma unroll 4
        for (int kb = 0; kb < 256; kb += 32) { attn_step32_lds(sA, QA, lds, kb, z, z, lane); attn_step32_lds(sB, QB, lds, kb, z, z, lane); } }
    else {
#pragma unroll 4
        for (int kb = 0; kb < 256; kb += 32) attn_step32_lds(sA, QA, lds, kb, z, z, lane); }
    if (dbg & 2) return;
    sA.l = grp_sum(sA.l);
    if (vA) {
        const float inv = 1.f / sA.l;
        bf16_t* po = (bf16_t*)(ws + T_MPO) + (((size_t)h * S + tA) * 3 + rA) * 64;
#pragma unroll
        for (int dt = 0; dt < 4; ++dt) { const f32x4 o = sA.O[dt] * inv; u32x2 w; w.x = pk2(o.x, o.y); w.y = pk2(o.z, o.w); *(u32x2*)(po + 16 * dt + 4 * g) = w; }
        if (g == 0) { float* pm = (float*)(ws + T_MPML) + (((size_t)h * S + tA) * 3 + rA) * 2; pm[0] = sA.m; pm[1] = sA.l; }
    }
    if (hasB) {
        sB.l = grp_sum(sB.l);
        if (vB) {
            const float inv = 1.f / sB.l;
            bf16_t* po = (bf16_t*)(ws + T_MPO) + (((size_t)h * S + tB) * 3 + rB) * 64;
#pragma unroll
            for (int dt = 0; dt < 4; ++dt) { const f32x4 o = sB.O[dt] * inv; u32x2 w; w.x = pk2(o.x, o.y); w.y = pk2(o.z, o.w); *(u32x2*)(po + 16 * dt + 4 * g) = w; }
            if (g == 0) { float* pm = (float*)(ws + T_MPML) + (((size_t)h * S + tB) * 3 + rB) * 2; pm[0] = sB.m; pm[1] = sB.l; }
        }
    }
}

__device__ __forceinline__ void moba_own_unit(int h, int ob, unsigned char* ws, const float* g_moba, LAS unsigned char* lds, int tid, int lane, int wave) {
    const int qi = lane & 15, g = lane >> 4;
    const bf16_t* ZR = (const bf16_t*)(ws + WS_ZR); const bf16_t* ZT = (const bf16_t*)(ws + WS_ZT);
    __syncthreads();
    stage_kv_block(ZR + ZR_BK + h * 64, ZT + (size_t)(ZT_BV + h * 64) * ZTP, ob * 256, lds, tid);
    __syncthreads();
    const int nv = ob < 3 ? ob : 3;
    for (int pass = 0; pass < 2; ++pass) {
        const int ql0 = pass * 128 + wave * 16, ql = ql0 + qi, q = ob * 256 + ql;
        const bf16_t* qrow = ZR + (size_t)q * ZRW + ZR_BQ + h * 64;
        bf16x8 Qf[2]; Qf[0] = *(const bf16x8*)(qrow + 8 * g); Qf[1] = *(const bf16x8*)(qrow + 32 + 8 * g);
        RowState st;
#pragma unroll
        for (int dt = 0; dt < 4; ++dt) st.O[dt] = (f32x4){0.f, 0.f, 0.f, 0.f};
        st.m = -INFINITY; st.l = 0.f;
        for (int kb = ql0 & ~31; kb >= 0; kb -= 32) {
            f32x4 b0, b1;
#pragma unroll
            for (int r = 0; r < 4; ++r) { b0[r] = (kb + 4 * g + r <= ql) ? 0.f : -INFINITY; b1[r] = (kb + 16 + 4 * g + r <= ql) ? 0.f : -INFINITY; }
            attn_step32_lds(st, Qf, lds, kb, b0, b1, lane);
        }
        st.l = grp_sum(st.l);
        for (int rk = 0; rk < nv; ++rk) {
            const float* pm = (const float*)(ws + T_MPML) + (((size_t)h * S + q) * 3 + rk) * 2;
            const float mk = pm[0], lk = pm[1];
            const float M = fmaxf(st.m, mk);
            const float a = __builtin_amdgcn_exp2f(st.m - M), b = lk * __builtin_amdgcn_exp2f(mk - M);
            const bf16_t* po = (const bf16_t*)(ws + T_MPO) + (((size_t)h * S + q) * 3 + rk) * 64;
#pragma unroll
            for (int dt = 0; dt < 4; ++dt) { const u32x2 w = *(const u32x2*)(po + 16 * dt + 4 * g);
                const f32x4 ok = {bflo(w.x), bfhi(w.x), bflo(w.y), bfhi(w.y)};
                st.O[dt] = st.O[dt] * a + ok * b; }
            st.l = st.l * a + b; st.m = M;
        }
        attn_finish(st, g_moba + h * 64, (bf16_t*)(ws + WS_Y) + (size_t)q * DM + 768 + h * 64, lane);
    }
}
constexpr int KT_PITCH = 136;

__device__ __forceinline__ void mlstm_local_unit(int h, int c, unsigned char* ws, const float* conv_w_l, LAS unsigned char* lds, int tid, int lane, int wave) {
    const int t0 = c * 128;
    LAS float* sws = (LAS float*)lds;
    LAS bf16_t* kT = (LAS bf16_t*)(lds + 1024);
    __syncthreads();
    if (wave == 0) {
        const float* mlf = (const float*)(ws + SM_MLF) + (size_t)h * S + t0; const float* mli = (const float*)(ws + SM_MLI) + (size_t)h * S + t0;
        float v0 = mlf[lane], v1 = mlf[64 + lane];
#pragma unroll
        for (int o = 1; o < 64; o <<= 1) { const float n0 = __shfl_up(v0, o), n1 = __shfl_up(v1, o); if (lane >= o) { v0 += n0; v1 += n1; } }
        const float tot0 = __shfl(v0, 63); v1 += tot0;
        const float blast = __shfl(v1, 63);
        const float li0 = mli[lane], li1 = mli[64 + lane];
        const float g0 = blast - v0 + li0, g1 = blast - v1 + li1;
        const float mloc = wave_max(fmaxf(g0, g1));
        sws[lane] = __expf(g0 - mloc); sws[64 + lane] = __expf(g1 - mloc);
        const float a0 = li0 - v0, a1 = li1 - v1;
        float p0 = a0, p1 = a1;
#pragma unroll
        for (int o = 1; o < 64; o <<= 1) { const float n0 = __shfl_up(p0, o), n1 = __shfl_up(p1, o); if (lane >= o) { p0 = fmaxf(p0, n0); p1 = fmaxf(p1, n1); } }
        p1 = fmaxf(p1, __shfl(p0, 63));
        float* mb = (float*)(ws + SM_MB) + (size_t)h * S + t0; float* ma = (float*)(ws + SM_MA) + (size_t)h * S + t0; float* mpx = (float*)(ws + SM_MPX) + (size_t)h * S + t0;
        mb[lane] = v0; mb[64 + lane] = v1; ma[lane] = a0; ma[64 + lane] = a1; mpx[lane] = p0; mpx[64 + lane] = p1;
        if (lane == 0) { float* sc = (float*)(ws + SM_MLSC); sc[h * 128 + c] = blast; sc[512 + h * 128 + c] = mloc; }
    }
    __syncthreads();
    {
        const bf16_t* ZR = (const bf16_t*)(ws + WS_ZR);
        bf16_t* QC = (bf16_t*)(ws + T_QC); bf16_t* KC = (bf16_t*)(ws + T_KC);
        const int r = tid & 31, which = r >> 4, cg = r & 15, tb = tid >> 5;
        const int ch = h * 128 + 8 * cg;
        float cw[4][8];
#pragma unroll
        for (int j = 0; j < 4; ++j) { const f32x4 c0 = *(const f32x4*)(conv_w_l + (size_t)j * 1024 + which * 512 + ch), c1 = *(const f32x4*)(conv_w_l + (size_t)j * 1024 + which * 512 + ch + 4);
            cw[j][0] = c0.x; cw[j][1] = c0.y; cw[j][2] = c0.z; cw[j][3] = c0.w; cw[j][4] = c1.x; cw[j][5] = c1.y; cw[j][6] = c1.z; cw[j][7] = c1.w; }
        const bf16_t* src = ZR + (which ? ZR_MK : ZR_MQ) + ch;
        u32x4 rw[11];
#pragma unroll
        for (int q = 0; q < 11; ++q) { const int tt = t0 + 8 * tb - 3 + q; rw[q] = (tt >= 0) ? *(const u32x4*)(src + (size_t)tt * ZRW) : (u32x4){0u, 0u, 0u, 0u}; }
        const float sc = which ? 0.08838834764831845f : 1.f;
#pragma unroll
        for (int q = 0; q < 8; ++q) {
            const int sl = 8 * tb + q;
            float acc[8];
#pragma unroll
            for (int e = 0; e < 8; ++e) acc[e] = 0.f;
#pragma unroll
            for (int j = 0; j < 4; ++j) { const u32x4 w = rw[q + j];
                acc[0] += bflo(w.x) * cw[j][0]; acc[1] += bfhi(w.x) * cw[j][1]; acc[2] += bflo(w.y) * cw[j][2]; acc[3] += bfhi(w.y) * cw[j][3];
                acc[4] += bflo(w.z) * cw[j][4]; acc[5] += bfhi(w.z) * cw[j][5]; acc[6] += bflo(w.w) * cw[j][6]; acc[7] += bfhi(w.w) * cw[j][7]; }
#pragma unroll
            for (int e = 0; e < 8; ++e) acc[e] = siluf(acc[e]) * sc;
            u32x4 o; o.x = pk2(acc[0], acc[1]); o.y = pk2(acc[2], acc[3]); o.z = pk2(acc[4], acc[5]); o.w = pk2(acc[6], acc[7]);
            *(u32x4*)((which ? KC : QC) + (size_t)(t0 + sl) * 512 + ch) = o;
            if (which) { const float w = sws[sl];
#pragma unroll
                for (int e = 0; e < 8; ++e) kT[(8 * cg + e) * KT_PITCH + sl] = (bf16_t)f2bf(acc[e] * w); }
        }
    }
    __syncthreads();
    {
        const int i = lane & 15, g = lane >> 4;
        const bf16_t* vT = (const bf16_t*)(ws + WS_ZT) + (size_t)(ZT_MV + h * 128 + 16 * wave + i) * ZTP + t0;
        f32x4 acc[8];
#pragma unroll
        for (int n = 0; n < 8; ++n) acc[n] = (f32x4){0.f, 0.f, 0.f, 0.f};
#pragma unroll
        for (int ks = 0; ks < 4; ++ks) {
            const bf16x8 a = *(const bf16x8*)(vT + 32 * ks + 8 * g);
#pragma unroll
            for (int n = 0; n < 8; ++n) { const bf16x8 b = *(const LAS bf16x8*)(kT + (16 * n + i) * KT_PITCH + 32 * ks + 8 * g); acc[n] = MFMA16(a, b, acc[n]); }
        }
        float* U = (float*)(ws + T_U) + ((size_t)(h * 128 + c) * 128) * 128;
#pragma unroll
        for (int n = 0; n < 8; ++n)
#pragma unroll
            for (int r = 0; r < 4; ++r) U[(size_t)(16 * wave + 4 * g + r) * 128 + 16 * n + i] = acc[n][r];
    }
    {
        const int i = lane & 15, g = lane >> 4;
        const bf16x8 ones = {(short)0x3f80, (short)0x3f80, (short)0x3f80, (short)0x3f80, (short)0x3f80, (short)0x3f80, (short)0x3f80, (short)0x3f80};
        f32x4 acc = {0.f, 0.f, 0.f, 0.f};
#pragma unroll
        for (int ks = 0; ks < 4; ++ks) { const bf16x8 b = *(const LAS bf16x8*)(kT + (16 * wave + i) * KT_PITCH + 32 * ks + 8 * g); acc = MFMA16(ones, b, acc); }
        if (g == 0) ((float*)(ws + SM_NLOC))[(size_t)(h * 128 + c) * 128 + 16 * wave + i] = acc[0];
    }
}

__device__ __forceinline__ void mlstm_scan(unsigned char* ws, LAS unsigned char* lds, int tid, int lane, int wave, int bid) {
    if (bid >= 256) return;
    const int h = bid >> 6;
    LAS float* dec = (LAS float*)lds; LAS float* scl = dec + 128;
    __syncthreads();
    if (wave == 0) {
        const float* sc = (const float*)(ws + SM_MLSC);
        const float bl0 = sc[h * 128 + lane], bl1 = sc[h * 128 + 64 + lane], ml0 = sc[512 + h * 128 + lane], ml1 = sc[512 + h * 128 + 64 + lane];
        float m = 0.f, mA = 0.f, mB = 0.f;
#pragma unroll 8
        for (int c = 0; c < 64; ++c) { if (lane == c) mA = m; m = fmaxf(__shfl(bl0, c) + m, __shfl(ml0, c)); }
#pragma unroll 8
        for (int c = 0; c < 64; ++c) { if (lane == c) mB = m; m = fmaxf(__shfl(bl1, c) + m, __shfl(ml1, c)); }
        const float mA1 = fmaxf(bl0 + mA, ml0), mB1 = fmaxf(bl1 + mB, ml1);
        dec[lane] = __expf(bl0 + mA - mA1); scl[lane] = __expf(ml0 - mA1); dec[64 + lane] = __expf(bl1 + mB - mB1); scl[64 + lane] = __expf(ml1 - mB1);
        if ((bid & 63) == 0) { float* mst = (float*)(ws + SM_MLSC) + 1024 + h * 128; mst[lane] = mA; mst[64 + lane] = mB; }
    }
    __syncthreads();
    if (tid < 256) {
        const int el = (bid & 63) * 256 + tid;
        const float* U = (const float*)(ws + T_U) + (size_t)h * 128 * 16384 + el;
        bf16_t* CS = (bf16_t*)(ws + T_CST) + (size_t)h * 128 * 16384 + el;
        float C = 0.f;
        for (int c0 = 0; c0 < 128; c0 += 32) { float u[32];
#pragma unroll
            for (int q = 0; q < 32; ++q) u[q] = U[(size_t)(c0 + q) * 16384];
#pragma unroll
            for (int q = 0; q < 32; ++q) { CS[(size_t)(c0 + q) * 16384] = (bf16_t)f2bf(C); C = dec[c0 + q] * C + scl[c0 + q] * u[q]; } }
    } else if (tid < 258) {
        const int el = (bid & 63) * 2 + (tid - 256);
        const float* NL_ = (const float*)(ws + SM_NLOC) + (size_t)h * 128 * 128 + el;
        float* NS = (float*)(ws + SM_NST) + (size_t)h * 128 * 128 + el;
        float n = 0.f;
        for (int c0 = 0; c0 < 128; c0 += 32) { float u[32];
#pragma unroll
            for (int q = 0; q < 32; ++q) u[q] = NL_[(c0 + q) * 128];
#pragma unroll
            for (int q = 0; q < 32; ++q) { NS[(c0 + q) * 128] = n; n = dec[c0 + q] * n + scl[c0 + q] * u[q]; } }
    }
}

constexpr int ML_PITCHB = 272, ML_MAT = 128 * ML_PITCHB;
__device__ __forceinline__ void mlstm_out_unit(int h, int c, unsigned char* ws, const float* g_mlstm, LAS unsigned char* lds, int tid, int lane, int wave) {
    const int i = lane & 15, g = lane >> 4;
    const int t0 = c * 128, tl = 16 * wave + i, t = t0 + tl;
    const bf16_t* QC = (const bf16_t*)(ws + T_QC); const bf16_t* KC = (const bf16_t*)(ws + T_KC);
    const bf16_t* ZT = (const bf16_t*)(ws + WS_ZT); const bf16_t* ZR = (const bf16_t*)(ws + WS_ZR);
    LAS unsigned char* Cs = lds; LAS unsigned char* Ks = lds + ML_MAT; LAS unsigned char* Vs = lds + 2 * ML_MAT;
    __syncthreads();
    {
        const bf16_t* CS = (const bf16_t*)(ws + T_CST) + ((size_t)(h * 128 + c) * 128) * 128;
        const bf16_t* kc = KC + (size_t)t0 * 512 + h * 128;
        const bf16_t* vt = ZT + (size_t)(ZT_MV + h * 128) * ZTP + t0;
#pragma unroll
        for (int q = 0; q < 4; ++q) { const int cc = tid + 512 * q; const int row = cc >> 4, part = cc & 15;
            const u32x4 a = *(const u32x4*)(CS + (size_t)row * 128 + part * 8);
            const u32x4 b = *(const u32x4*)(kc + (size_t)row * 512 + part * 8);
            const u32x4 d = *(const u32x4*)(vt + (size_t)row * ZTP + part * 8);
            *(LAS u32x4*)(Cs + row * ML_PITCHB + part * 16) = a; *(LAS u32x4*)(Ks + row * ML_PITCHB + part * 16) = b; *(LAS u32x4*)(Vs + row * ML_PITCHB + part * 16) = d; }
    }
    const float* ma = (const float*)(ws + SM_MA) + (size_t)h * S + t0;
    const float mc = ((const float*)(ws + SM_MLSC))[1024 + h * 128 + c];
    const float bt = ((const float*)(ws + SM_MB))[(size_t)h * S + t];
    const float Mx = fmaxf(mc, ((const float*)(ws + SM_MPX))[(size_t)h * S + t]);
    const float w_inter = __expf(mc - Mx);
    bf16x8 Qf[4];
#pragma unroll
    for (int ks = 0; ks < 4; ++ks) Qf[ks] = *(const bf16x8*)(QC + (size_t)t * 512 + h * 128 + 32 * ks + 8 * g);
    float qn = 0.f;
    {
        const float* ns = (const float*)(ws + SM_NST) + (size_t)(h * 128 + c) * 128;
#pragma unroll
        for (int ks = 0; ks < 4; ++ks) { const f32x4 n0 = *(const f32x4*)(ns + 32 * ks + 8 * g), n1 = *(const f32x4*)(ns + 32 * ks + 8 * g + 4);
            qn += bf2f((unsigned short)Qf[ks][0]) * n0.x + bf2f((unsigned short)Qf[ks][1]) * n0.y + bf2f((unsigned short)Qf[ks][2]) * n0.z + bf2f((unsigned short)Qf[ks][3]) * n0.w
                + bf2f((unsigned short)Qf[ks][4]) * n1.x + bf2f((unsigned short)Qf[ks][5]) * n1.y + bf2f((unsigned short)Qf[ks][6]) * n1.z + bf2f((unsigned short)Qf[ks][7]) * n1.w; }
        qn = grp_sum(qn);
    }
    u32x2 mow[8];
    {
        const bf16_t* mo = ZR + (size_t)t * ZRW + ZR_MO + h * 128;
#pragma unroll
        for (int dt = 0; dt < 8; ++dt) mow[dt] = *(const u32x2*)(mo + 16 * dt + 4 * g);
    }
    __syncthreads();
    f32x4 On[8];
#pragma unroll
    for (int dt = 0; dt < 8; ++dt) On[dt] = (f32x4){0.f, 0.f, 0.f, 0.f};
#pragma unroll
    for (int ks = 0; ks < 4; ++ks)
#pragma unroll
        for (int dt = 0; dt < 8; ++dt) { const bf16x8 a = *(const LAS bf16x8*)(Cs + (16 * dt + i) * ML_PITCHB + (32 * ks + 8 * g) * 2); On[dt] = MFMA16(a, Qf[ks], On[dt]); }
#pragma unroll
    for (int dt = 0; dt < 8; ++dt) On[dt] = On[dt] * w_inter;
    float den = 0.f;
    for (int sp = 0; sp <= (wave >> 1); ++sp) {
        f32x4 s0 = {0.f, 0.f, 0.f, 0.f}, s1 = {0.f, 0.f, 0.f, 0.f};
        const LAS unsigned char* k0p = Ks + (32 * sp + i) * ML_PITCHB + 16 * g;
        const LAS unsigned char* k1p = k0p + 16 * ML_PITCHB;
#pragma unroll
        for (int ks = 0; ks < 4; ++ks) { s0 = MFMA16(*(const LAS bf16x8*)(k0p + 64 * ks), Qf[ks], s0); s1 = MFMA16(*(const LAS bf16x8*)(k1p + 64 * ks), Qf[ks], s1); }
        const f32x4 a0 = *(const f32x4*)(ma + 32 * sp + 4 * g), a1 = *(const f32x4*)(ma + 32 * sp + 16 + 4 * g);
        float p0[4], p1[4];
#pragma unroll
        for (int r = 0; r < 4; ++r) {
            const int sl0 = 32 * sp + 4 * g + r, sl1 = sl0 + 16;
            p0[r] = (sl0 <= tl) ? s0[r] * __expf(a0[r] - Mx) : 0.f;
            p1[r] = (sl1 <= tl) ? s1[r] * __expf(a1[r] - Mx) : 0.f;
            den += p0[r] + p1[r];
        }
        u32x4 pw; pw.x = pk2(p0[0], p0[1]); pw.y = pk2(p0[2], p0[3]); pw.z = pk2(p1[0], p1[1]); pw.w = pk2(p1[2], p1[3]);
        const bf16x8 pb = __builtin_bit_cast(bf16x8, pw);
#pragma unroll
        for (int dt = 0; dt < 8; ++dt) { const LAS unsigned char* vp = Vs + (16 * dt + i) * ML_PITCHB + (32 * sp + 4 * g) * 2;
            u32x4 vw; const u32x2 lo = *(const LAS u32x2*)vp, hi = *(const LAS u32x2*)(vp + 32); vw.x = lo.x; vw.y = lo.y; vw.z = hi.x; vw.w = hi.y;
            On[dt] = MFMA16(__builtin_bit_cast(bf16x8, vw), pb, On[dt]); }
    }
    den = grp_sum(den) + w_inter * qn;
    const float dn = fmaxf(fabsf(den), __expf(-(bt + Mx)));
    const float inv = 1.f / dn;
    float ss = 0.f;
#pragma unroll
    for (int dt = 0; dt < 8; ++dt) { const u32x2 w = mow[dt];
        const f32x4 og = {sigmoidf(bflo(w.x)), sigmoidf(bfhi(w.x)), sigmoidf(bflo(w.y)), sigmoidf(bfhi(w.y))};
        On[dt] = On[dt] * inv * og;
        ss += (On[dt].x * On[dt].x + On[dt].y * On[dt].y) + (On[dt].z * On[dt].z + On[dt].w * On[dt].w); }
    ss = grp_sum(ss);
    const float rs = rsqrtf(ss * (1.f / 128.f) + EPS);
    bf16_t* yrow = (bf16_t*)(ws + WS_Y) + (size_t)t * DM + 256 + h * 128;
#pragma unroll
    for (int dt = 0; dt < 8; ++dt) { const f32x4 gg = *(const f32x4*)(g_mlstm + h * 128 + 16 * dt + 4 * g); const f32x4 o = On[dt] * rs * gg;
        u32x2 w; w.x = pk2(o.x, o.y); w.y = pk2(o.z, o.w); *(u32x2*)(yrow + 16 * dt + 4 * g) = w; }
}
struct SchedDenseIn {
    const char* X; const char* W; int G, c;
    __device__ __forceinline__ bool next(int i, pg8::GUnit& u) const {
        constexpr int nM = 64, nN = 14, nwg = nM * nN;
        const long L = (long)i * G + c; if (L >= nwg) return false;
        int wgid = (int)L; { const int q = nwg / pg8::NXCD, r = nwg % pg8::NXCD, xcd = wgid % pg8::NXCD, off = wgid / pg8::NXCD; wgid = (xcd < r ? xcd * (q + 1) : r * (q + 1) + (xcd - r) * q) + off; }
        const int nig = pg8::WGM * nN, gid = wgid / nig, fm = gid * pg8::WGM, gsz = (nM - fm) < pg8::WGM ? (nM - fm) : pg8::WGM;
        const int pm = fm + ((wgid % nig) % gsz), pn = (wgid % nig) / gsz;
        u.pm = pm; u.pn = pn; u.x0 = 0;
        if (pn < 10) { u.A = X + (size_t)pm * 256 * DM * 2; u.B = W + (size_t)pn * 256 * DM * 2; }
        else { u.A = W + (size_t)pn * 256 * DM * 2; u.B = X + (size_t)pm * 256 * DM * 2; }
        return true;
    }
};
struct EpiZ {
    bf16_t* ZR; bf16_t* ZT; int nostore;
    __device__ __forceinline__ void operator()(const f32x4 (&acc)[2][2][4][2], const pg8::GUnit& u, int wr, int wc, int fr, int fq) const {
        if (nostore) return;
        const bool sw = u.pn >= 10;
        bf16_t* base; size_t pitch;
        if (!sw) { base = ZR + (size_t)(256 * u.pm) * ZRW + 256 * u.pn; pitch = ZRW; }
        else { base = ZT + (size_t)(256 * (u.pn - 10)) * ZTP + 256 * u.pm; pitch = ZTP; }
#pragma unroll
        for (int ai = 0; ai < 2; ++ai)
#pragma unroll
            for (int m = 0; m < 4; ++m) { bf16_t* rowp = base + (size_t)(ai * 128 + wr * 64 + m * 16 + fr) * pitch + wc * 32 + 8 * fq;
#pragma unroll
                for (int bj = 0; bj < 2; ++bj) { const f32x4 v0 = acc[ai][bj][m][0], v1 = acc[ai][bj][m][1];
                    u32x4 w; w.x = pk2(v0[0], v0[1]); w.y = pk2(v0[2], v0[3]); w.z = pk2(v1[0], v1[1]); w.w = pk2(v1[2], v1[3]);
                    *(u32x4*)(rowp + bj * 128) = w; } }
    }
};
struct SchedDense4 {
    const char* X; const char* W; int K; int G, c;
    __device__ __forceinline__ bool next(int i, pg8::GUnit& u) const {
        const int L = i * G + c; if (L >= 256) return false;
        const int pm = L >> 2, pn = L & 3;
        u.pm = pm; u.pn = pn; u.x0 = 0;
        u.A = X + (size_t)pm * 256 * K * 2; u.B = W + (size_t)pn * 256 * K * 2;
        return true;
    }
};
template <bool XBF16> struct EpiPre1 {
    const void* xin; bf16_t* out;
    __device__ __forceinline__ void operator()(const f32x4 (&acc)[2][2][4][2], const pg8::GUnit& u, int wr, int wc, int fr, int fq) const {
#pragma unroll
        for (int ai = 0; ai < 2; ++ai)
#pragma unroll
            for (int m = 0; m < 4; ++m) { const size_t off = (size_t)(256 * u.pm + ai * 128 + wr * 64 + m * 16 + fr) * DM + 256 * u.pn + wc * 32 + 8 * fq;
#pragma unroll
                for (int bj = 0; bj < 2; ++bj) {
                    f32x4 x0, x1;
                    if (XBF16) { const u32x4 xw = *(const u32x4*)((const bf16_t*)xin + off + bj * 128); x0 = (f32x4){bflo(xw.x), bfhi(xw.x), bflo(xw.y), bfhi(xw.y)}; x1 = (f32x4){bflo(xw.z), bfhi(xw.z), bflo(xw.w), bfhi(xw.w)}; }
                    else { x0 = *(const f32x4*)((const float*)xin + off + bj * 128); x1 = *(const f32x4*)((const float*)xin + off + bj * 128 + 4); }
                    const f32x4 v0 = x0 * ALPHA + acc[ai][bj][m][0], v1 = x1 * ALPHA + acc[ai][bj][m][1];
                    u32x4 w; w.x = pk2(v0[0], v0[1]); w.y = pk2(v0[2], v0[3]); w.z = pk2(v1[0], v1[1]); w.w = pk2(v1[2], v1[3]);
                    *(u32x4*)(out + off + bj * 128) = w; } }
    }
};
__device__ __forceinline__ void moe_table(const unsigned* ecnt, LAS int* tab, int tid) {
    __syncthreads();
    if (tid < 64) {
        const int e = tid; const unsigned cnt_e = e < NE ? xb_ld((unsigned*)ecnt + e) : 0u; const int n = (int)((cnt_e + 255u) >> 8);
        if (e < NE) tab[216 + e] = (int)cnt_e;
        int inc = n;
#pragma unroll
        for (int o = 1; o < 32; o <<= 1) { const int v = __shfl_up(inc, o); if (e >= o) inc += v; }
        const int exc = inc - n;
        if (e < NE) { tab[1 + e] = exc; for (int j = 0; j < n; ++j) tab[40 + exc + j] = e; }
        if (e == NE - 1) { tab[1 + NE] = inc; tab[0] = inc; }
    }
    __syncthreads();
}
struct SchedMoE {
    const char* Abase; const char* Wbase; const LAS int* tab; size_t wstride; int K; int G, c; int maxr; const int* elist; unsigned* guc; unsigned* tmo;
    __device__ __forceinline__ int unit_of(int i, int U) const {
        if (elist) return i * G + c;
        const int r = U % G; if (r == 0) return i * G + c;
        const int nl = G - r;
        if (c >= r) return i < 2 ? i * nl + (c - r) : 2 * nl + (i - 2) * G + c;
        return 2 * nl + i * G + c;
    }
    __device__ __forceinline__ void a_ready(const pg8::GUnit& u, int wid, int lane) const {
        if (wid == 0) {
            unsigned polls = 0;
            while ((unsigned)__builtin_amdgcn_readfirstlane(__hip_atomic_load(guc + 16 * u.pm, __ATOMIC_RELAXED, __HIP_MEMORY_SCOPE_AGENT)) < 32u) {
                if ((++polls & 255u) == 0u) { if (__builtin_amdgcn_readfirstlane(__hip_atomic_load(tmo, __ATOMIC_RELAXED, __HIP_MEMORY_SCOPE_AGENT)) != 0u) break;
                    if (polls > (1u << 22)) { if (lane == 0) atomicAdd(tmo, 1u); break; } }
                __builtin_amdgcn_s_sleep(2); }
            asm volatile("s_waitcnt vmcnt(0)" ::: "memory");
        }
        asm volatile("" ::: "memory"); __builtin_amdgcn_s_barrier(); asm volatile("" ::: "memory");
    }
    __device__ __forceinline__ bool next(int i, pg8::GUnit& u) const {
        if (i >= maxr) return false;
        const int T = __builtin_amdgcn_readfirstlane(tab[0]); const int L = unit_of(i, 4 * T); if (L >= 4 * T) return false;
        const int tile = L >> 2, pn = L & 3; const int e = __builtin_amdgcn_readfirstlane(tab[40 + tile]);
        u.pm = tile; u.pn = pn; u.x0 = e;
        u.B = Wbase + (size_t)e * wstride + (size_t)pn * 256 * K * 2;
        if (elist) { u.A = Abase; u.list = elist + (size_t)e * S; u.l0 = 256 * (tile - __builtin_amdgcn_readfirstlane(tab[1 + e])); u.nl = __builtin_amdgcn_readfirstlane(tab[216 + e]); }
        else { u.A = Abase + (size_t)tile * 256 * K * 2; u.list = nullptr; u.l0 = 0; u.nl = 0; }
        return true;
    }
};
struct EpiGU {
    bf16_t* H; unsigned* guc;
    __device__ __forceinline__ void operator()(const f32x4 (&acc)[2][2][4][2], const pg8::GUnit& u, int wr, int wc, int fr, int fq) const {
#pragma unroll
        for (int ai = 0; ai < 2; ++ai)
#pragma unroll
            for (int m = 0; m < 4; ++m) { bf16_t* rowp = H + (size_t)(256 * u.pm + ai * 128 + wr * 64 + m * 16 + fr) * DE + (256 * u.pn + wc * 32 + 8 * fq) / 2;
#pragma unroll
                for (int bj = 0; bj < 2; ++bj) { const f32x4 gt = acc[ai][bj][m][0], up = acc[ai][bj][m][1];
                    const unsigned long long w = (unsigned long long)pk2(siluf(gt[0]) * up[0], siluf(gt[1]) * up[1]) | ((unsigned long long)pk2(siluf(gt[2]) * up[2], siluf(gt[3]) * up[3]) << 32);
                    __hip_atomic_store((unsigned long long*)(rowp + bj * 64), w, __ATOMIC_RELAXED, __HIP_MEMORY_SCOPE_AGENT); } }
        asm volatile("s_waitcnt vmcnt(0)" ::: "memory");
        if (fr == 0 && fq == 0) (void)__hip_atomic_fetch_add(guc + 16 * u.pm, 1u, __ATOMIC_RELAXED, __HIP_MEMORY_SCOPE_AGENT);
    }
};
struct EpiY {
    bf16_t* Y;
    __device__ __forceinline__ void operator()(const f32x4 (&acc)[2][2][4][2], const pg8::GUnit& u, int wr, int wc, int fr, int fq) const {
#pragma unroll
        for (int ai = 0; ai < 2; ++ai)
#pragma unroll
            for (int m = 0; m < 4; ++m) { bf16_t* rowp = Y + (size_t)(256 * u.pm + ai * 128 + wr * 64 + m * 16 + fr) * DM + 256 * u.pn + wc * 32 + 8 * fq;
#pragma unroll
                for (int bj = 0; bj < 2; ++bj) { const f32x4 v0 = acc[ai][bj][m][0], v1 = acc[ai][bj][m][1];
                    u32x4 w; w.x = pk2(v0[0], v0[1]); w.y = pk2(v0[2], v0[3]); w.z = pk2(v1[0], v1[1]); w.w = pk2(v1[2], v1[3]);
                    *(u32x4*)(rowp + bj * 128) = w; } }
    }
};

constexpr int R6_WG = 0, R6_WE = 16384, R6_G = 16384 + 131072, R6_B = R6_G + 4096, R6_END = R6_B + 4096;
static_assert(R6_END <= LDS_TAB, "router weights fit under the table region");
__device__ __forceinline__ void ln1_router_load(const float* g1, const float* b1, const float* w_grp, const float* w_er, LAS unsigned char* lds, int tid) {
    LAS float* wgT = (LAS float*)(lds + R6_WG); LAS float* weT = (LAS float*)(lds + R6_WE); LAS float* gg = (LAS float*)(lds + R6_G); LAS float* bb = (LAS float*)(lds + R6_B);
    for (int i = tid; i < 1024; i += 512) { const f32x4 w = *(const f32x4*)(w_grp + 4 * i); wgT[i] = w.x; wgT[1024 + i] = w.y; wgT[2048 + i] = w.z; wgT[3072 + i] = w.w; gg[i] = g1[i]; bb[i] = b1[i]; }
    for (int i = tid; i < 1024 * 8; i += 512) { const int k = i >> 3, c4 = (i & 7) * 4; const f32x4 w = *(const f32x4*)(w_er + (size_t)k * 32 + c4);
        weT[(c4 + 0) * 1024 + k] = w.x; weT[(c4 + 1) * 1024 + k] = w.y; weT[(c4 + 2) * 1024 + k] = w.z; weT[(c4 + 3) * 1024 + k] = w.w; }
}
__device__ __forceinline__ void ln1_router_row(int t, unsigned char* ws, const LAS unsigned char* lds, const float* b_grp, const float* b_er, unsigned* ecnt, int lane) {
    const LAS float* wgT = (const LAS float*)(lds + R6_WG); const LAS float* weT = (const LAS float*)(lds + R6_WE); const LAS float* gg = (const LAS float*)(lds + R6_G); const LAS float* bb = (const LAS float*)(lds + R6_B);
    const bf16_t* p1 = (const bf16_t*)(ws + WS_ZT) + (size_t)t * DM;
    f32x4 v[4];
#pragma unroll
    for (int j = 0; j < 4; ++j) { const u32x2 w = *(const u32x2*)(p1 + 256 * j + 4 * lane); v[j] = (f32x4){bflo(w.x), bfhi(w.x), bflo(w.y), bfhi(w.y)}; }
    {
        float s = 0.f;
#pragma unroll
        for (int j = 0; j < 4; ++j) s += (v[j].x + v[j].y) + (v[j].z + v[j].w);
        const float mean = wave_sum(s) * (1.f / DM); float s2 = 0.f;
#pragma unroll
        for (int j = 0; j < 4; ++j) { v[j] = v[j] - mean; s2 += (v[j].x * v[j].x + v[j].y * v[j].y) + (v[j].z * v[j].z + v[j].w * v[j].w); }
        const float rstd = rsqrtf(wave_sum(s2) * (1.f / DM) + EPS);
#pragma unroll
        for (int j = 0; j < 4; ++j) { const f32x4 g = *(const LAS f32x4*)(gg + 256 * j + 4 * lane), b = *(const LAS f32x4*)(bb + 256 * j + 4 * lane); v[j] = v[j] * rstd * g + b; }
    }
    store_row_bf16(v, (bf16_t*)(ws + WS_ACTB) + (size_t)t * DM, lane);
    float gl[4];
#pragma unroll
    for (int q = 0; q < 4; ++q) { float s = 0.f;
#pragma unroll
        for (int j = 0; j < 4; ++j) { const f32x4 w = *(const LAS f32x4*)(wgT + q * 1024 + 256 * j + 4 * lane); s += (v[j].x * w.x + v[j].y * w.y) + (v[j].z * w.z + v[j].w * w.w); }
        gl[q] = wave_sum(s) + b_grp[q]; }
    int gs = 0; float gm = gl[0];
#pragma unroll
    for (int q = 1; q < 4; ++q) if (gl[q] > gm) { gm = gl[q]; gs = q; }
    float den = 0.f;
#pragma unroll
    for (int q = 0; q < 4; ++q) den += __expf(gl[q] - gm);
    const float pg = 1.f / den;
    float el[8];
#pragma unroll
    for (int q = 0; q < 8; ++q) { float s = 0.f; const LAS float* wc = weT + (gs * 8 + q) * 1024;
#pragma unroll
        for (int j = 0; j < 4; ++j) { const f32x4 w = *(const LAS f32x4*)(wc + 256 * j + 4 * lane); s += (v[j].x * w.x + v[j].y * w.y) + (v[j].z * w.z + v[j].w * w.w); }
        el[q] = wave_sum(s) + b_er[gs * 8 + q]; }
    int i0 = 0; float v0 = el[0];
#pragma unroll
    for (int q = 1; q < 8; ++q) if (el[q] > v0) { v0 = el[q]; i0 = q; }
    int i1 = -1; float v1 = -INFINITY;
#pragma unroll
    for (int q = 0; q < 8; ++q) if (q != i0 && el[q] > v1) { v1 = el[q]; i1 = q; }
    const float e1 = __expf(v1 - v0); const float w0g = pg / (1.f + e1), w1g = pg * e1 / (1.f + e1);
    if (lane < 2) {
        const int e = gs * 8 + (lane == 0 ? i0 : i1);
        const unsigned slot = atomicAdd(ecnt + e, 1u);
        ((int*)(ws + SM_ELIST))[(size_t)e * S + slot] = t;
        ((int*)(ws + SM_EID))[2 * t + lane] = e; ((int*)(ws + SM_SLOT))[2 * t + lane] = (int)slot; ((float*)(ws + SM_WT))[2 * t + lane] = lane == 0 ? w0g : w1g;
    }
}
__device__ __forceinline__ void ln2_row(int t, unsigned char* ws, const LAS int* tab, const LAS float* g2, const LAS float* b2, float* out, bool last,
                                        const LAS float* w12, const float* bff, const float* bmi, const float* bmf, int lane, int dbg = 0) {
    const bf16_t* x1 = (const bf16_t*)(ws + WS_ACTB) + (size_t)t * DM;
    const int e0 = ((const int*)(ws + SM_EID))[2 * t], e1 = ((const int*)(ws + SM_EID))[2 * t + 1];
    const int s0 = ((const int*)(ws + SM_SLOT))[2 * t], s1 = ((const int*)(ws + SM_SLOT))[2 * t + 1];
    const float w0 = ((const float*)(ws + SM_WT))[2 * t], w1 = ((const float*)(ws + SM_WT))[2 * t + 1];
    const bf16_t* y0 = (const bf16_t*)(ws + T_YE) + (size_t)(256 * tab[1 + e0] + s0) * DM; const bf16_t* y1 = (const bf16_t*)(ws + T_YE) + (size_t)(256 * tab[1 + e1] + s1) * DM;
    f32x4 v[4];
#pragma unroll
    for (int j = 0; j < 4; ++j) { const u32x2 xw = *(const u32x2*)(x1 + 256 * j + 4 * lane);
        const f32x4 x = {bflo(xw.x), bfhi(xw.x), bflo(xw.y), bfhi(xw.y)};
        const u32x2 a = *(const u32x2*)(y0 + 256 * j + 4 * lane), b = *(const u32x2*)(y1 + 256 * j + 4 * lane);
        const f32x4 ya = {bflo(a.x), bfhi(a.x), bflo(a.y), bfhi(a.y)}, yb = {bflo(b.x), bfhi(b.x), bflo(b.y), bfhi(b.y)};
        v[j] = x * ALPHA + ya * w0 + yb * w1; }
    {
        float s = 0.f;
#pragma unroll
        for (int j = 0; j < 4; ++j) s += (v[j].x + v[j].y) + (v[j].z + v[j].w);
        const float mean = wave_sum(s) * (1.f / DM); float s2 = 0.f;
#pragma unroll
        for (int j = 0; j < 4; ++j) { v[j] = v[j] - mean; s2 += (v[j].x * v[j].x + v[j].y * v[j].y) + (v[j].z * v[j].z + v[j].w * v[j].w); }
        const float rstd = rsqrtf(wave_sum(s2) * (1.f / DM) + EPS);
#pragma unroll
        for (int j = 0; j < 4; ++j) { const f32x4 g = *(const LAS f32x4*)(g2 + 256 * j + 4 * lane), b = *(const LAS f32x4*)(b2 + 256 * j + 4 * lane); v[j] = v[j] * rstd * g + b; }
    }
    if (dbg & 1) { if (!(dbg & 2) && !last) gates_row(v, w12, bff, bmi, bmf, (float*)(ws + WS_ROPE), (float*)(ws + WS_ROPE), (float*)(ws + WS_ROPE), -1, lane); return; }
    if (last) {
#pragma unroll
        for (int j = 0; j < 4; ++j) *(f32x4*)(out + (size_t)t * DM + 256 * j + 4 * lane) = v[j];
    } else {
        store_row_bf16(v, (bf16_t*)(ws + WS_ACTB) + (size_t)t * DM, lane);
        gates_row(v, w12, bff, bmi, bmf, (float*)(ws + SM_FLF), (float*)(ws + SM_MLI), (float*)(ws + SM_MLF), t, lane);
    }
}

__device__ __forceinline__ const void* ldarg(int k) { int kk = k; asm volatile("" : "+s"(kk)); return ((const void* const*)__builtin_amdgcn_kernarg_segment_ptr())[kk]; }
#ifndef PH_MASK
#define PH_MASK 0x7ff
#endif
#define PHM(k) (((PH_MASK) >> (k)) & 1)
#define IN(k) (lo <= (k) && (k) < hi)
#define SEAM(k) do { if (IN(k) && IN((k) + 1)) { XcdBarrier _b; _b.bar = (unsigned*)ldarg(23) + CW_BAR; _b.x = xb_xcc_id(); _b.st = (volatile LAS unsigned*)(lds + LDS_MISC); xcd_barrier(_b, wave0 == 0 && __builtin_amdgcn_mbcnt_hi(~0u, __builtin_amdgcn_mbcnt_lo(~0u, 0u)) == 0u); } } while (0)
#define VCU ((G % 8 == 0) ? (bid % 8) * (G / 8) + bid / 8 : bid)
#define PHASE_IDS unsigned char* ws = (unsigned char*)ldarg(23); unsigned* ctl = (unsigned*)ws; float* outp = (float*)ldarg(22); (void)ctl; (void)outp; int tid = wave0 * 64 + (int)__builtin_amdgcn_mbcnt_hi(~0u, __builtin_amdgcn_mbcnt_lo(~0u, 0u)); asm volatile("" : "+v"(tid)); const int lane = tid & 63, wave = __builtin_amdgcn_readfirstlane(tid >> 6); const int gw = bid * 8 + wave, NGW = G * 8; (void)lane; (void)gw; (void)NGW;
#define INP(k) ((const float*)ldarg(k))
template <int l>
__device__ __forceinline__ void layer_phases(LAS unsigned char* lds, const int wave0, const int bid, const int G, const int lo, const int hi, const int sub) {
    constexpr int P = 1 + 10 * l;

        if (PHM(0) && IN(P + 0)) { PHASE_IDS;
            SchedDenseIn Sd{(const char*)(ws + WS_ACTB), (const char*)(ws + WS_WIN) + (size_t)l * NZ * DM * 2, G, bid};
            EpiZ E{(bf16_t*)(ws + WS_ZR), (bf16_t*)(ws + WS_ZT), (sub >> 12) & 1};
            pg8::gemm_phase<EpiZ, SchedDenseIn>(lds, DM, Sd, E, tid);
            if (G == 256 && bid >= 128 && !((sub >> 13) & 1))
                moe_weights(INP(17) + (size_t)l * NE * DM * DE, INP(18) + (size_t)l * NE * DM * DE, INP(19) + (size_t)l * NE * DE * DM, ws, lds, lane, wave, (bid - 128) * 8 + wave, 128 * 8, 0, MOE_FILL);
        }
        SEAM(P + 0);
        if (PHM(1) && IN(P + 1)) { PHASE_IDS;
            if (sub & 1) for (int u = bid; u < 256; u += G) mix1_unit(u, ws, ctl + CW_KMAX(l), lds, tid, lane, wave);
            if (sub & 2) { const bool split = (G == 256);
                moe_weights(INP(17) + (size_t)l * NE * DM * DE, INP(18) + (size_t)l * NE * DM * DE, INP(19) + (size_t)l * NE * DE * DM, ws, lds, lane, wave, gw, NGW, split ? MOE_FILL : 0, MOE_ITEMS); }
        }
        SEAM(P + 1);
        if (PHM(2) && IN(P + 2)) { PHASE_IDS;
            for (int u = VCU; u < 1536; u += G) {
                const int ty = u >> 9, r = u & 511, h = r >> 7, q = r & 127;
                if (!((sub >> ty) & 1)) continue;
                if (ty == 0) { const float kmaxn = sqrtf(__builtin_bit_cast(float, xb_ld(ctl + CW_KMAX(l) + h))); fox_unit(h, q, ws, kmaxn, INP(7) + l * 256, lds, tid, lane, wave, (sub & 256) ? 1 : ((sub & 512) ? 3 : (1 << 30)), (sub & 768) ? (bf16_t*)(ws + WS_X1) : nullptr); }
                else if (ty == 1) mlstm_local_unit(h, q, ws, INP(6) + (size_t)l * 4 * 1024, lds, tid, lane, wave);
                else moba_gate_unit(h, q, ws, lds, tid, lane, wave);
            }
        }
        SEAM(P + 2);
        if (PHM(3) && IN(P + 3)) { PHASE_IDS;
            if (sub & 1) for (int vb = bid; vb < 256; vb += G) mlstm_scan(ws, lds, tid, lane, wave, vb);
            LAS unsigned char* ltab = lds + LDS_TAB;
            LAS int* tot = (LAS int*)ltab;
            LAS int* pre = (LAS int*)(ltab + 1024);
            __syncthreads();
            if (tid < 256) { const int* cq = (const int*)(ws + SM_CNTQ) + (size_t)tid * 128; int a = 0;
                for (int i = 0; i < 128; i += 4) { const u32x4 v = *(const u32x4*)(cq + i); a += (int)(v.x + v.y + v.z + v.w); }
                tot[tid] = a; pre[tid] = (a + 255) >> 8; }
            __syncthreads();
            if (tid < 64) {
                const int c0 = pre[4 * tid], c1 = pre[4 * tid + 1], c2 = pre[4 * tid + 2], c3 = pre[4 * tid + 3]; const int tsum = c0 + c1 + c2 + c3; int inc = tsum;
#pragma unroll
                for (int o = 1; o < 64; o <<= 1) { const int v = __shfl_up(inc, o); if (tid >= o) inc += v; }
                const int exc = inc - tsum;
                pre[4 * tid] = exc; pre[4 * tid + 1] = exc + c0; pre[4 * tid + 2] = exc + c0 + c1; pre[4 * tid + 3] = exc + c0 + c1 + c2;
                if (tid == 63) pre[256] = inc;
            }
            __syncthreads();
            const int total = (sub & 2) ? pre[256] : 0;
            const int per = (total + G - 1) / G; const int u0 = VCU * per, u1 = (u0 + per < total) ? u0 + per : total;
            int prev = -1;
            for (int u = u0; u < u1; ++u) {
                int loi = 0, hii = 255;
                while (loi < hii) { const int mid = (loi + hii + 1) >> 1; if (pre[mid] <= u) loi = mid; else hii = mid - 1; }
                moba_part_unit(loi >> 6, loi & 63, u - pre[loi], tot[loi], ws, lds, ltab, tid, lane, wave, (sub >> 10) & 3, loi == prev);
                prev = loi;
            }
        }
        SEAM(P + 3);
        if (PHM(4) && IN(P + 4)) { PHASE_IDS;
            for (int u = VCU; u < 768; u += G) {
                if (u < 512) { if (sub & 1) mlstm_out_unit(u >> 7, u & 127, ws, INP(8) + l * 512, lds, tid, lane, wave); }
                else if (sub & 2) { const int r = u - 512; moba_own_unit(r >> 6, r & 63, ws, INP(9) + l * 256, lds, tid, lane, wave); }
            }
        }
        SEAM(P + 4);
        if (PHM(5) && IN(P + 5)) { PHASE_IDS;
            SchedDense4 Sd{(const char*)(ws + WS_Y), (const char*)(ws + WS_WOUT) + (size_t)l * DM * DM * 2, DM, G, (G % 8 == 0) ? (bid % 8) * (G / 8) + bid / 8 : bid};
            EpiPre1<(l > 0)> E{l == 0 ? (const void*)INP(0) : (const void*)(ws + WS_ACTB), (bf16_t*)(ws + WS_ZT)};
            pg8::gemm_phase<EpiPre1<(l > 0)>, SchedDense4>(lds, DM, Sd, E, tid);
        }
        SEAM(P + 5);
        if (PHM(6) && IN(P + 6)) { PHASE_IDS;
            ln1_router_load(INP(11) + l * DM, INP(12) + l * DM, INP(13) + (size_t)l * DM * 4, INP(15) + (size_t)l * DM * 32, lds, tid);
            __syncthreads();
            const float* bgp = INP(14) + l * 4; const float* bep = INP(16) + l * 32;
#pragma unroll 8
            for (int t = gw; t < S; t += NGW)
                ln1_router_row(t, ws, lds, bgp, bep, ctl + CW_ECNT(l), lane);
            __syncthreads();
        }
        SEAM(P + 6);
        if (PHM(7) && IN(P + 7)) { PHASE_IDS;
            LAS int* tab = (LAS int*)(lds + LDS_TAB);
            moe_table(ctl + CW_ECNT(l), tab, tid);
            SchedMoE Sm{(const char*)(ws + WS_ACTB), (const char*)(ws + WS_WGU), tab, (size_t)DM * DM * 2, DM, G, (G % 8 == 0) ? (bid % 8) * (G / 8) + bid / 8 : bid, (sub & 16) ? 1 : ((sub & 32) ? 2 : 1000), (const int*)(ws + SM_ELIST), nullptr, nullptr};
            EpiGU E{(bf16_t*)(ws + T_H), ctl + CW_GUC(l)};
            pg8::gemm_phase<EpiGU, SchedMoE, true>(lds, DM, Sm, E, tid, (LAS unsigned*)(lds + LDS_TAB + 1024));
        }
        if (PHM(8) && IN(P + 8)) { PHASE_IDS;
            LAS int* tab = (LAS int*)(lds + LDS_TAB);
            if (!IN(P + 7)) moe_table(ctl + CW_ECNT(l), tab, tid);
            SchedMoE Sm{(const char*)(ws + T_H), (const char*)(ws + WS_WD), tab, (size_t)DM * DE * 2, DE, G, (G % 8 == 0) ? (bid % 8) * (G / 8) + bid / 8 : bid, (sub & 16) ? 1 : ((sub & 32) ? 2 : 1000), nullptr, ctl + CW_GUC(l), ctl + CW_BAR + XB_TMO};
            EpiY E{(bf16_t*)(ws + T_YE)};
            pg8::gemm_phase<EpiY, SchedMoE, false, true>(lds, DE, Sm, E, tid);
        }
        SEAM(P + 8);
        if (PHM(9) && IN(P + 9)) { PHASE_IDS;
            LAS int* tab = (LAS int*)(lds + LDS_TAB);
            if (!IN(P + 7)) moe_table(ctl + CW_ECNT(l), tab, tid);
            const bool last = (l == NL - 1);
            LAS float* w12 = (LAS float*)lds;
            if (!last) { load_w12(INP(2) + (size_t)(l + 1) * DM * INW, w12, tid); __syncthreads(); }
            LAS float* g2l = (LAS float*)(lds + 49152); LAS float* b2l = g2l + 1024;
            { const float* g2p = INP(20) + l * DM; const float* b2p = INP(21) + l * DM; for (int i = tid; i < 1024; i += 512) { g2l[i] = g2p[i]; b2l[i] = b2p[i]; } }
            __syncthreads();
            const float* bffp = INP(3) + (l + 1) * 4; const float* bmip = INP(4) + (l + 1) * 4; const float* bmfp = INP(5) + (l + 1) * 4;
#pragma unroll 8
            for (int t = gw; t < S; t += NGW)
                ln2_row(t, ws, tab, g2l, b2l, outp, last, w12, bffp, bmip, bmfp, lane, (sub >> 14) & 3);
            __syncthreads();
        }
        SEAM(P + 9);
}
struct Args { const void* in[22]; float* out; unsigned char* ws; int ph_lo, ph_hi, sub, pad; };
__global__ void __launch_bounds__(512, 2) fwd(Args args) {
    extern __shared__ __attribute__((aligned(16))) unsigned char lds_raw[];
    LAS unsigned char* lds = (LAS unsigned char*)lds_raw;
    const int tid0 = threadIdx.x; const int wave0 = __builtin_amdgcn_readfirstlane(tid0 >> 6);
    const int bid = blockIdx.x, G = gridDim.x;
    if (tid0 < 4) ((LAS unsigned*)(lds + LDS_MISC))[tid0] = 0u;
    __syncthreads();
    const int lo = args.ph_lo, hi = args.ph_hi;
    if (hi - lo > 1 && lo != 99) (void)xcd_barrier_post((unsigned*)ldarg(23) + CW_BAR, (volatile LAS unsigned*)(lds + LDS_MISC));
    if (PHM(10) && IN(0)) { PHASE_IDS; p0_prologue(INP(0), (const int*)ldarg(1), INP(2), INP(10), INP(3), INP(4), INP(5), ws, lds, tid, lane, wave, bid, G); }
    SEAM(0);
    layer_phases<0>(lds, wave0, bid, G, lo, hi, args.sub);
    layer_phases<1>(lds, wave0, bid, G, lo, hi, args.sub);
#undef IN
#undef SEAM
}

extern "C" void kernel_launch(void* const* d_in, const int* in_sizes, int n_in, void* d_out, int out_size, void* d_ws, size_t ws_size, hipStream_t stream) {
    static int grid = 0;
    if (grid == 0) {
        if (n_in != 22 || out_size != S * DM || ws_size < WS_END) { fprintf(stderr, "kernel_launch: unexpected shapes (n_in %d, out %d, ws %zu < %zu); nothing launched\n", n_in, out_size, ws_size, (size_t)WS_END); grid = -1; return; }
        int dev = 0, cus = 0;
        if (hipGetDevice(&dev) != hipSuccess || hipDeviceGetAttribute(&cus, hipDeviceAttributeMultiprocessorCount, dev) != hipSuccess) { grid = -1; return; }
        if (hipFuncSetAttribute((const void*)fwd, hipFuncAttributeMaxDynamicSharedMemorySize, LDS_BYTES) != hipSuccess) { fprintf(stderr, "kernel_launch: hipFuncSetAttribute failed\n"); grid = -1; return; }
        int per_cu = 0;
        (void)hipOccupancyMaxActiveBlocksPerMultiprocessor(&per_cu, (const void*)fwd, 512, LDS_BYTES);
        (void)hipGetLastError();
        if (per_cu < 1) fprintf(stderr, "kernel_launch: occupancy query reports %d blocks per CU\n", per_cu);
        grid = cus > 0 ? cus : 256;
    }
    if (grid < 0) return;
    (void)hipMemsetAsync((char*)d_ws + WS_CTL, 0, CTL_BYTES, stream);
    Args a{};
    for (int i = 0; i < 22; ++i) a.in[i] = d_in[i];
    a.out = (float*)d_out; a.ws = (unsigned char*)d_ws; a.sub = 7;
    if (N_LAUNCHES == 1) {
        a.ph_lo = 0; a.ph_hi = NPH;
        hipLaunchKernelGGL(fwd, dim3(grid), dim3(512), LDS_BYTES, stream, a);
    } else {
        for (int p = 0; p < NPH; ++p) { a.ph_lo = p; a.ph_hi = p + 1; hipLaunchKernelGGL(fwd, dim3(grid), dim3(512), LDS_BYTES, stream, a);
#ifdef DUP_MASK
            if (((unsigned long long)(DUP_MASK) >> p) & 1ull) { a.sub = DUP_SUB; hipLaunchKernelGGL(fwd, dim3(grid), dim3(512), LDS_BYTES, stream, a); a.sub = 7; }
#endif
        }
    }
}
```

```cpp
#include <hip/hip_runtime.h>
#include <cstdio>
#include <cstdint>

#define LAS __attribute__((address_space(3)))
#define GAS __attribute__((address_space(1)))
typedef unsigned short bf16_t;
typedef short bf16x8 __attribute__((ext_vector_type(8)));
typedef short bf16x4 __attribute__((ext_vector_type(4)));
typedef float f32x4 __attribute__((ext_vector_type(4)));
typedef float f32x2 __attribute__((ext_vector_type(2)));
typedef unsigned u32x4 __attribute__((ext_vector_type(4)));
typedef unsigned u32x2 __attribute__((ext_vector_type(2)));

#ifndef N_LAUNCHES
#define N_LAUNCHES 1
#endif

constexpr int S = 16384, DM = 1024, INW = 3596, NL = 2;
constexpr int NZ = 3584;
constexpr int ZRW = 2560;
constexpr int ZR_FQ = 0, ZR_FK = 256, ZR_MQ = 512, ZR_MK = 1024, ZR_MO = 1536, ZR_BQ = 2048, ZR_BK = 2304;
constexpr int ZT_FV = 0, ZT_MV = 256, ZT_BV = 768;
constexpr int ZTP = S + 136;
constexpr int NE = 32, DE = 512, MAXT = 160, PROWS = MAXT * 256;
constexpr float ALPHA = 1.41421356237309515f;
constexpr float EPS = 1e-5f;
constexpr int NPH = 21;

constexpr size_t MiB = 1u << 20;
constexpr size_t WS_CTL = 0, CTL_BYTES = 1 * MiB;
constexpr size_t WS_WIN = 1 * MiB;
constexpr size_t WS_ROPE = 16 * MiB;
constexpr size_t WS_WOUT = 17 * MiB;
constexpr size_t WS_WGU = 21 * MiB;
constexpr size_t WS_WD = 85 * MiB;
constexpr size_t WS_ACTB = 117 * MiB;
constexpr size_t WS_Y = 149 * MiB;
constexpr size_t WS_X1 = 181 * MiB;
constexpr size_t WS_ZR = 245 * MiB;
constexpr size_t WS_ZT = 325 * MiB;
constexpr size_t WS_TMP = 359 * MiB;
constexpr size_t WS_SMALL = 481 * MiB;
constexpr size_t WS_END = 489 * MiB;
constexpr size_t T_QC = WS_TMP, T_KC = WS_TMP + 16 * MiB, T_U = WS_TMP + 32 * MiB, T_CST = WS_TMP + 64 * MiB,
                 T_MPO = WS_TMP + 80 * MiB, T_MPML = WS_TMP + 104 * MiB, T_QIDX = WS_TMP + 106 * MiB;
constexpr size_t T_H = WS_TMP, T_YE = WS_TMP + 40 * MiB;
constexpr size_t SM_FLF = WS_SMALL, SM_FCL = SM_FLF + 256 * 1024, SM_MLI = SM_FCL + 256 * 1024, SM_MLF = SM_MLI + 256 * 1024,
                 SM_MB = SM_MLF + 256 * 1024, SM_MA = SM_MB + 256 * 1024, SM_MPX = SM_MA + 256 * 1024,
                 SM_FTS = SM_MPX + 256 * 1024, SM_KMEAN = SM_FTS + 4096, SM_EID = SM_KMEAN + 65536, SM_SLOT = SM_EID + 131072,
                 SM_WT = SM_SLOT + 131072, SM_ELIST = SM_WT + 131072, SM_MLSC = SM_ELIST + 2 * MiB, SM_NLOC = SM_MLSC + 16384,
                 SM_NST = SM_NLOC + 262144, SM_MSEL = SM_NST + 262144, SM_CNTQ = SM_MSEL + 262144, SM_END = SM_CNTQ + 131072;
static_assert(SM_END <= WS_END, "small region");
static_assert(WS_ZT + (size_t)1024 * ZTP * 2 <= WS_TMP, "transposed z buffer");
constexpr int CW_BAR = 4096;
__host__ __device__ constexpr int CW_ECNT(int l) { return 8192 + 64 * l; }
__host__ __device__ constexpr int CW_KMAX(int l) { return 9216 + 16 * l; }
__host__ __device__ constexpr int CW_GUC(int l) { return 12288 + 4096 * l; }

constexpr int RING_BYTES = 131072;
constexpr int LDS_BYTES = 163840;
constexpr int LDS_MISC = LDS_BYTES - 64;
constexpr int LDS_TAB = LDS_MISC - 4096;

__device__ __forceinline__ unsigned f2bf(float f) { unsigned u = __builtin_bit_cast(unsigned, f); return (u + 0x7fffu + ((u >> 16) & 1u)) >> 16; }
typedef __bf16 bf16x2_t __attribute__((ext_vector_type(2)));
__device__ __forceinline__ unsigned pk2(float lo, float hi) { const f32x2 v = {lo, hi}; const bf16x2_t b = __builtin_convertvector(v, bf16x2_t); return __builtin_bit_cast(unsigned, b); }
__device__ __forceinline__ float bf2f(unsigned h) { return __builtin_bit_cast(float, h << 16); }
__device__ __forceinline__ float bflo(unsigned w) { return __builtin_bit_cast(float, w << 16); }
__device__ __forceinline__ float bfhi(unsigned w) { return __builtin_bit_cast(float, w & 0xffff0000u); }
typedef unsigned u32x2v __attribute__((ext_vector_type(2)));
template <int CTRL> __device__ __forceinline__ float dpp_f(float v) { return __builtin_bit_cast(float, __builtin_amdgcn_update_dpp(0, __builtin_bit_cast(int, v), CTRL, 0xf, 0xf, true)); }
#ifndef RED_MODE
#define RED_MODE 7
#endif
__device__ __forceinline__ float x32f(float v) { if (RED_MODE & 2) { unsigned a = __builtin_bit_cast(unsigned, v), b = a; asm volatile("s_nop 1\n\tv_permlane32_swap_b32 %0, %1" : "+v"(a), "+v"(b));
        return (__builtin_amdgcn_mbcnt_hi(~0u, __builtin_amdgcn_mbcnt_lo(~0u, 0u)) < 32u) ? __builtin_bit_cast(float, b) : __builtin_bit_cast(float, a); } return __shfl_xor(v, 32); }
__device__ __forceinline__ float x16f(float v) { if (RED_MODE & 4) { unsigned a = __builtin_bit_cast(unsigned, v), b = a; asm volatile("s_nop 1\n\tv_permlane16_swap_b32 %0, %1" : "+v"(a), "+v"(b));
        return ((__builtin_amdgcn_mbcnt_hi(~0u, __builtin_amdgcn_mbcnt_lo(~0u, 0u)) >> 4) & 1u) ? __builtin_bit_cast(float, a) : __builtin_bit_cast(float, b); } return __shfl_xor(v, 16); }
__device__ __forceinline__ float grp_sum(float v) { v += x32f(v); v += x16f(v); return v; }
__device__ __forceinline__ float grp_max(float v) { v = fmaxf(v, x32f(v)); v = fmaxf(v, x16f(v)); return v; }
__device__ __forceinline__ float row_sum16(float v) { v += dpp_f<0xB1>(v); v += dpp_f<0x4E>(v); v += dpp_f<0x141>(v); v += dpp_f<0x140>(v); return v; }
__device__ __forceinline__ float row_max16(float v) { v = fmaxf(v, dpp_f<0xB1>(v)); v = fmaxf(v, dpp_f<0x4E>(v)); v = fmaxf(v, dpp_f<0x141>(v)); v = fmaxf(v, dpp_f<0x140>(v)); return v; }
__device__ __forceinline__ float wave_sum(float v) {
    if (RED_MODE & 1) v = row_sum16(v); else { v += __shfl_xor(v, 1); v += __shfl_xor(v, 2); v += __shfl_xor(v, 4); v += __shfl_xor(v, 8); }
    return grp_sum(v); }
__device__ __forceinline__ float wave_max(float v) {
    if (RED_MODE & 1) v = row_max16(v); else { v = fmaxf(v, __shfl_xor(v, 1)); v = fmaxf(v, __shfl_xor(v, 2)); v = fmaxf(v, __shfl_xor(v, 4)); v = fmaxf(v, __shfl_xor(v, 8)); }
    return grp_max(v); }
__device__ __forceinline__ float log_sigmoid(float x) { return fminf(x, 0.f) - log1pf(__expf(-fabsf(x))); }
__device__ __forceinline__ float sigmoidf(float x) { return 1.f / (1.f + __expf(-x)); }
__device__ __forceinline__ float siluf(float x) { return x / (1.f + __expf(-x)); }
#define MFMA16(a, b, c) __builtin_amdgcn_mfma_f32_16x16x32_bf16((a), (b), (c), 0, 0, 0)
#define VM_WAIT() asm volatile("s_waitcnt vmcnt(0)" ::: "memory")

#define XB_TMO      128
#define XB_XCNT(j)  (256  + 64 * (j))
#define XB_XSUB(j)  (1280 + 64 * (j))
#define XB_XGEN(j)  (2304 + 64 * (j))
#define XB_TOP      3328
#define XB_TOPGEN   3392
#define XCD_BAR_WORDS 3456
#define XB_SPIN_CAP (1u << 24)
__device__ __forceinline__ unsigned xb_ld(unsigned* p)              { return __hip_atomic_load(p, __ATOMIC_RELAXED, __HIP_MEMORY_SCOPE_AGENT); }
__device__ __forceinline__ unsigned xb_add(unsigned* p, unsigned v) { return __hip_atomic_fetch_add(p, v, __ATOMIC_RELAXED, __HIP_MEMORY_SCOPE_AGENT); }
__device__ __forceinline__ unsigned xb_xcc_id() { return (unsigned)__builtin_amdgcn_s_getreg((3 << 11) | 20) & 0xFu; }
#define XB_SPIN(cond, bar) do { unsigned _sp = 0; while (cond) { __builtin_amdgcn_s_sleep(1); \
    if ((++_sp & 255u) == 0u) { if (xb_ld(&(bar)[XB_TMO])) break; if (_sp > XB_SPIN_CAP) { atomicAdd(&(bar)[XB_TMO], 1u); break; } } } } while (0)
struct XcdBarrier { unsigned* bar; unsigned x; volatile LAS unsigned* st; };
__device__ __forceinline__ XcdBarrier xcd_barrier_post(unsigned* bar, volatile LAS unsigned* st) {
    XcdBarrier b; b.bar = bar; b.x = xb_xcc_id(); b.st = st;
    if (threadIdx.x == 0) (void)xb_add(&bar[XB_XCNT(b.x)], 1u);
    return b;
}
__device__ __forceinline__ void xcd_barrier_complete(unsigned* bar, unsigned x, unsigned& nloc, unsigned& nx) {
    const unsigned G = gridDim.x * gridDim.y * gridDim.z;
    unsigned sum, cnt, mine, sp = 0u;
    for (;;) {
        sum = 0u; cnt = 0u; mine = 0u;
#pragma unroll
        for (unsigned j = 0; j < 16; ++j) { const unsigned c = xb_ld(&bar[XB_XCNT(j)]); sum += c; cnt += (c > 0u) ? 1u : 0u; mine = (j == x) ? c : mine; }
        if (sum == G) break;
        __builtin_amdgcn_s_sleep(1);
        if ((++sp & 255u) == 0u) { if (xb_ld(&bar[XB_TMO])) break; if (sp > XB_SPIN_CAP) { atomicAdd(&bar[XB_TMO], 1u); break; } }
    }
    nloc = mine > 0u ? mine : 1u; nx = cnt > 0u ? cnt : 1u;
}
__device__ __forceinline__ void xcd_barrier(const XcdBarrier& b, const bool thread0) {
    asm volatile("s_waitcnt vmcnt(0)" ::: "memory");
    __syncthreads();
    if (thread0) {
        unsigned* bar = b.bar;
        __builtin_amdgcn_s_waitcnt(0);
        unsigned nloc = b.st[0], nx = b.st[1];
        if (nloc == 0u) { xcd_barrier_complete(bar, b.x, nloc, nx); b.st[0] = nloc; b.st[1] = nx; }
        const unsigned old = xb_add(&bar[XB_XSUB(b.x)], 1u);
        const unsigned gen = old / nloc;
        if (old + 1u == (gen + 1u) * nloc) {
            __builtin_amdgcn_fence(__ATOMIC_RELEASE, "agent");
            asm volatile("s_waitcnt vmcnt(0)" ::: "memory");
            const unsigned og = xb_add(&bar[XB_TOP], 1u);
            const unsigned tg = og / nx;
            if (og + 1u == (tg + 1u) * nx) xb_add(&bar[XB_TOPGEN], 1u);
            else XB_SPIN(xb_ld(&bar[XB_TOPGEN]) == tg, bar);
            __builtin_amdgcn_fence(__ATOMIC_ACQUIRE, "agent");
            xb_add(&bar[XB_XGEN(b.x)], 1u);
            asm volatile("s_waitcnt vmcnt(0)" ::: "memory");
        } else {
            XB_SPIN(xb_ld(&bar[XB_XGEN(b.x)]) == gen, bar);
            __builtin_amdgcn_fence(__ATOMIC_ACQUIRE, "agent");
            asm volatile("s_waitcnt vmcnt(0)" ::: "memory");
        }
    }
    __syncthreads();
}
namespace pg8 {
constexpr int BM = 256, BK = 64, HALF = 128, HTB = HALF * BK * 2, STAGE_BYTES = 8 * HTB, NXCD = 8, WGM = 8;
__host__ __device__ __forceinline__ int lds_byte(int r, int c) { const int st = (r >> 4) * 2 + (c >> 5), rr = r & 15, cc = c & 31, ob = rr * 64 + cc * 2; return st * 1024 + (ob ^ (((ob >> 9) & 1) << 5)); }
__host__ __device__ __forceinline__ void stage_rc(int b, int& R, int& C) { const int st = b / 1024, sb = b % 1024, swz = sb ^ (((sb >> 9) & 1) << 5); R = (st >> 1) * 16 + swz / 64; C = (st & 1) * 32 + (swz % 64) / 2; }
__host__ __device__ __forceinline__ int perm32(int rho) { const int n = rho >> 4, i = rho & 15; return 8 * (i >> 2) + 4 * n + (i & 3); }

struct GUnit {
    const char* A;
    const char* B;
    int pm, pn, x0;
    const int* list;
    int l0, nl;
};

template <class Epi, class Sched, bool GATHER = false, bool HOOK = false>
__device__ __forceinline__ void gemm_phase(LAS unsigned char* lds, const int K, const Sched& S, const Epi& E, const int tid, LAS unsigned* rtab = nullptr) {
    const int wid = __builtin_amdgcn_readfirstlane(tid >> 6), lane = tid & 63, wr = wid >> 2, wc = wid & 3, fr = lane & 15, fq = lane >> 4;
    const int nt = K / BK;
    unsigned voffA[2], voffB[2];
#pragma unroll
    for (int i = 0; i < 2; ++i) { int R, C; stage_rc(tid * 16 + i * 8192, R, C); const int Rb = (R & ~31) + perm32(R & 31); voffA[i] = (unsigned)(R * K + C) * 2u; voffB[i] = (unsigned)(Rb * K + C) * 2u; }
    const size_t kstep = (size_t)(BK * 2);
    const size_t hstep = (size_t)HALF * K * 2;
    const unsigned ldsw = (unsigned)wid * 1024u;
    const int aoff = lds_byte(wr * 64 + fr, fq * 8), boff = lds_byte(wc * 32 + fr, fq * 8);
#define PG8_SA(b, h) (((b) * 2 + (h)) * HTB)
#define PG8_SB(b, h) ((4 + (b) * 2 + (h)) * HTB)
#define PG8_STAGE(bufoff, gbase, voff) do { _Pragma("unroll") for (int _i = 0; _i < 2; ++_i) \
        __builtin_amdgcn_global_load_lds((const unsigned*)((const char*)(gbase) + (voff)[_i]), (LAS unsigned*)(lds + (bufoff) + ldsw + _i * 8192), 16, 0, 0); } while (0)
#define PG8_STAGE_A(bufoff, gbase, voff) do { _Pragma("unroll") for (int _i = 0; _i < 2; ++_i) \
        __builtin_amdgcn_global_load_lds((const unsigned*)((const char*)(gbase) + (voff)[_i]), (LAS unsigned*)(lds + (bufoff) + ldsw + _i * 8192), 16, 0, HOOK ? 16 : 0); } while (0)
#define PG8_LDA(dst, b, h) do { _Pragma("unroll") for (int m = 0; m < 4; ++m) _Pragma("unroll") for (int k = 0; k < 2; ++k) dst[m][k] = *(const LAS bf16x8*)(lds + PG8_SA(b, h) + aoff + m * 2048 + k * 1024); } while (0)
#define PG8_LDB(dst, b, h) do { _Pragma("unroll") for (int n = 0; n < 2; ++n) _Pragma("unroll") for (int k = 0; k < 2; ++k) dst[n][k] = *(const LAS bf16x8*)(lds + PG8_SB(b, h) + boff + n * 2048 + k * 1024); } while (0)
#define PG8_MMA(ai, bj, At, Bt) do { __builtin_amdgcn_s_setprio(1); _Pragma("unroll") for (int m = 0; m < 4; ++m) _Pragma("unroll") for (int n = 0; n < 2; ++n) _Pragma("unroll") for (int k = 0; k < 2; ++k) \
        acc[ai][bj][m][n] = __builtin_amdgcn_mfma_f32_16x16x32_bf16(Bt[n][k], At[m][k], acc[ai][bj][m][n], 0, 0, 0); __builtin_amdgcn_s_setprio(0); } while (0)
#define PG8_WAIT_V(n) asm volatile("s_waitcnt vmcnt(" #n ")" ::: "memory")
#define PG8_WAIT_L(n) asm volatile("s_waitcnt lgkmcnt(" #n ")" ::: "memory")
#define PG8_BAR __builtin_amdgcn_s_barrier()
#define PG8_SCHED __builtin_amdgcn_sched_barrier(0)
#define PG8_STAGE_G(bufoff, gbase, vo) do { _Pragma("unroll") for (int _i = 0; _i < 2; ++_i) \
        __builtin_amdgcn_global_load_lds((const unsigned*)((const char*)(gbase) + (vo)[_i]), (LAS unsigned*)(lds + (bufoff) + ldsw + _i * 8192), 16, 0, 0); } while (0)
#define PG8_ROWTAB(u, slot) do { if (tid < 256) { int _x = (u).l0 + tid; _x = _x < (u).nl ? _x : (u).nl - 1; rtab[(slot) * 256 + tid] = (unsigned)(u).list[_x] * (unsigned)(K * 2); } } while (0)
#define PG8_LOADCV(slot) do { _Pragma("unroll") for (int _h = 0; _h < 2; ++_h) _Pragma("unroll") for (int _i = 0; _i < 2; ++_i) { int _R, _C; stage_rc(tid * 16 + _i * 8192, _R, _C); \
        cv[_h][_i] = rtab[(slot) * 256 + _h * HALF + _R] + (unsigned)(_C * 2); } } while (0)
    GUnit cur, nxt; int ui = 0;
    if (!S.next(0, cur)) return;
    unsigned cv[2][2]; int par = 0;
    if constexpr (GATHER) { PG8_ROWTAB(cur, 0); __syncthreads(); PG8_LOADCV(0); }
    f32x4 acc[2][2][4][2];
#pragma unroll
    for (int a = 0; a < 2; ++a)
#pragma unroll
        for (int b = 0; b < 2; ++b)
#pragma unroll
            for (int m = 0; m < 4; ++m)
#pragma unroll
                for (int n = 0; n < 2; ++n) acc[a][b][m][n] = (f32x4){0.f, 0.f, 0.f, 0.f};
    bf16x8 At[4][2], B0[2][2], B1[2][2];
    const char* cA = cur.A; const char* cB = cur.B;
    if constexpr (HOOK) S.a_ready(cur, wid, lane);
    PG8_STAGE(PG8_SB(0, 0), cB, voffB); PG8_STAGE(PG8_SB(0, 1), cB + hstep, voffB);
    if constexpr (GATHER) { PG8_STAGE_G(PG8_SA(0, 0), cA, cv[0]); PG8_STAGE_G(PG8_SA(0, 1), cA, cv[1]); } else { PG8_STAGE_A(PG8_SA(0, 0), cA, voffA); PG8_STAGE_A(PG8_SA(0, 1), cA + hstep, voffA); }
    if (wr == 1) PG8_BAR;
    PG8_WAIT_V(2); PG8_BAR;
    PG8_STAGE(PG8_SB(1, 0), cB + kstep, voffB); if constexpr (GATHER) PG8_STAGE_G(PG8_SA(1, 0), cA + kstep, cv[0]); else PG8_STAGE_A(PG8_SA(1, 0), cA + kstep, voffA); PG8_STAGE(PG8_SB(1, 1), cB + hstep + kstep, voffB);
    PG8_WAIT_V(6); PG8_BAR;
    for (;;) {
        const bool has_next = S.next(ui + 1, nxt);
        const char* nA = has_next ? nxt.A : cA; const char* nB = has_next ? nxt.B : cB;
        if constexpr (GATHER) { if (has_next) PG8_ROWTAB(nxt, par ^ 1); }
        for (int t = 0; t < nt; t += 2) {
            const bool last = (t == nt - 2);
            const char* a1 = cA + (size_t)(t + 1) * kstep;
            const char* a2 = last ? nA : cA + (size_t)(t + 2) * kstep; const char* b2 = last ? nB : cB + (size_t)(t + 2) * kstep;
            const char* a3 = a2 + kstep; const char* b3 = b2 + kstep;
            if constexpr (HOOK) { if (last && has_next) S.a_ready(nxt, wid, lane); }
            PG8_LDB(B0, 0, 0); PG8_LDB(B1, 0, 1); PG8_SCHED; PG8_LDA(At, 0, 0);
            if constexpr (GATHER) { PG8_STAGE_G(PG8_SA(1, 1), a1, cv[1]); if (last && has_next) PG8_LOADCV(par ^ 1); } else PG8_STAGE_A(PG8_SA(1, 1), a1 + hstep, voffA);
            PG8_WAIT_V(8); PG8_WAIT_L(0); PG8_BAR; PG8_MMA(0, 0, At, B0); PG8_MMA(0, 1, At, B1); PG8_BAR; PG8_SCHED;
            PG8_LDA(At, 0, 1); PG8_STAGE(PG8_SB(0, 0), b2, voffB); PG8_STAGE(PG8_SB(0, 1), b2 + hstep, voffB); if constexpr (GATHER) PG8_STAGE_G(PG8_SA(0, 0), a2, cv[0]); else PG8_STAGE_A(PG8_SA(0, 0), a2, voffA);
            PG8_WAIT_V(8); PG8_WAIT_L(0); PG8_BAR; PG8_MMA(1, 0, At, B0); PG8_MMA(1, 1, At, B1); PG8_BAR; PG8_SCHED;
            PG8_LDB(B0, 1, 0); PG8_LDB(B1, 1, 1); PG8_SCHED; PG8_LDA(At, 1, 0); if constexpr (GATHER) PG8_STAGE_G(PG8_SA(0, 1), a2, cv[1]); else PG8_STAGE_A(PG8_SA(0, 1), a2 + hstep, voffA);
            PG8_WAIT_V(8); PG8_WAIT_L(0); PG8_BAR; PG8_MMA(0, 0, At, B0); PG8_MMA(0, 1, At, B1); PG8_BAR; PG8_SCHED;
            PG8_LDA(At, 1, 1); PG8_STAGE(PG8_SB(1, 0), b3, voffB); PG8_STAGE(PG8_SB(1, 1), b3 + hstep, voffB); if constexpr (GATHER) PG8_STAGE_G(PG8_SA(1, 0), a3, cv[0]); else PG8_STAGE_A(PG8_SA(1, 0), a3, voffA);
            PG8_WAIT_V(8); PG8_WAIT_L(0); PG8_BAR; PG8_MMA(1, 0, At, B0); PG8_MMA(1, 1, At, B1); PG8_BAR; PG8_SCHED;
        }
        if (wr == 0) PG8_BAR;
        E(acc, cur, wr, wc, fr, fq);
        if (!has_next) break;
#pragma unroll
        for (int a = 0; a < 2; ++a)
#pragma unroll
            for (int b = 0; b < 2; ++b)
#pragma unroll
                for (int m = 0; m < 4; ++m)
#pragma unroll
                    for (int n = 0; n < 2; ++n) acc[a][b][m][n] = (f32x4){0.f, 0.f, 0.f, 0.f};
        cur = nxt; cA = nA; cB = nB; ++ui; par ^= 1;
        if (wr == 1) PG8_BAR;
    }
    PG8_WAIT_V(0);
    PG8_BAR;
#undef PG8_SA
#undef PG8_SB
#undef PG8_STAGE
#undef PG8_STAGE_A
#undef PG8_LDA
#undef PG8_LDB
#undef PG8_MMA
#undef PG8_WAIT_V
#undef PG8_WAIT_L
#undef PG8_BAR
#undef PG8_SCHED
#undef PG8_STAGE_G
#undef PG8_ROWTAB
#undef PG8_LOADCV
}
}
__device__ __forceinline__ int win_srccol(int n) {
    if (n < 256) return n;
    if (n < 512) return n;
    if (n < 1024) return 772 + (n - 512);
    if (n < 1536) return 1284 + (n - 1024);
    if (n < 2048) return 2316 + (n - 1536);
    if (n < 2304) return 2828 + (n - 2048);
    if (n < 2560) return 3084 + (n - 2304);
    if (n < 2816) return 512 + (n - 2560);
    if (n < 3328) return 1796 + (n - 2816);
    return 3340 + (n - 3328);
}
__device__ __forceinline__ void transpose_item(const float* cp, int ld, bf16_t* WT, int Kd, int k0, int n0, LAS float* scr, int lane) {
    float tmp[32];
#pragma unroll
    for (int i = 0; i < 32; ++i) tmp[i] = cp[(size_t)(k0 + 2 * i + (lane >> 5)) * ld];
#pragma unroll
    for (int i = 0; i < 32; ++i) scr[(2 * i + (lane >> 5)) * 33 + (lane & 31)] = tmp[i];
    asm volatile("s_waitcnt vmcnt(0) lgkmcnt(0)" ::: "memory");
    const int c = lane & 7;
#pragma unroll
    for (int j = 0; j < 4; ++j) { const int n = (lane >> 3) + 8 * j; const LAS float* s = scr + (8 * c) * 33 + n;
        u32x4 o; o.x = pk2(s[0 * 33], s[1 * 33]); o.y = pk2(s[2 * 33], s[3 * 33]); o.z = pk2(s[4 * 33], s[5 * 33]); o.w = pk2(s[6 * 33], s[7 * 33]);
        *(u32x4*)(WT + (size_t)(n0 + n) * Kd + k0 + 8 * c) = o; }
    asm volatile("s_waitcnt lgkmcnt(0)" ::: "memory");
}
__device__ __forceinline__ void load_w12(const float* w_in_l, LAS float* w12, int tid) {
    for (int idx = tid; idx < 3 * 1024; idx += 512) { const int k = idx & 1023, q = idx >> 10; const int col = q == 0 ? 768 : (q == 1 ? 2308 : 2312);
        const f32x4 w = *(const f32x4*)(w_in_l + (size_t)k * INW + col);
        w12[(4 * q + 0) * 1024 + k] = w.x; w12[(4 * q + 1) * 1024 + k] = w.y; w12[(4 * q + 2) * 1024 + k] = w.z; w12[(4 * q + 3) * 1024 + k] = w.w; }
}
__device__ __forceinline__ void gates_row(const f32x4 (&v)[4], const LAS float* w12, const float* bff, const float* bmi, const float* bmf, float* flf, float* mli, float* mlf, int t, int lane) {
    float d[12];
#pragma unroll
    for (int c = 0; c < 12; ++c) { float s = 0.f;
#pragma unroll
        for (int j = 0; j < 4; ++j) { const f32x4 w = *(const LAS f32x4*)(w12 + c * 1024 + 256 * j + 4 * lane); s += (v[j].x * w.x + v[j].y * w.y) + (v[j].z * w.z + v[j].w * w.w); }
        d[c] = wave_sum(s); }
    if (lane < 4 && t >= 0) {
        float a = d[0], b = d[4], c = d[8];
#pragma unroll
        for (int h = 1; h < 4; ++h) { if (lane == h) { a = d[h]; b = d[4 + h]; c = d[8 + h]; } }
        flf[lane * S + t] = log_sigmoid(a + bff[lane]);
        mli[lane * S + t] = b + bmi[lane];
        mlf[lane * S + t] = log_sigmoid(c + bmf[lane]);
    }
}
__device__ __forceinline__ void ln_row(f32x4 (&v)[4], const float* gam, const float* bet, int lane) {
    float s = 0.f;
#pragma unroll
    for (int j = 0; j < 4; ++j) s += (v[j].x + v[j].y) + (v[j].z + v[j].w);
    const float mean = wave_sum(s) * (1.f / DM); float s2 = 0.f;
#pragma unroll
    for (int j = 0; j < 4; ++j) { v[j] = v[j] - mean; s2 += (v[j].x * v[j].x + v[j].y * v[j].y) + (v[j].z * v[j].z + v[j].w * v[j].w); }
    const float rstd = rsqrtf(wave_sum(s2) * (1.f / DM) + EPS);
#pragma unroll
    for (int j = 0; j < 4; ++j) { const f32x4 g = *(const f32x4*)(gam + 256 * j + 4 * lane), b = *(const f32x4*)(bet + 256 * j + 4 * lane); v[j] = v[j] * rstd * g + b; }
}
__device__ __forceinline__ void store_row_bf16(const f32x4 (&v)[4], bf16_t* orow, int lane) {
#pragma unroll
    for (int j = 0; j < 4; ++j) { u32x2 o; o.x = pk2(v[j].x, v[j].y); o.y = pk2(v[j].z, v[j].w); *(u32x2*)(orow + 256 * j + 4 * lane) = o; }
}

__device__ __forceinline__ void p0_prologue(const float* x, const int* pos, const float* w_in, const float* w_out, const float* bff, const float* bmi, const float* bmf,
                                            unsigned char* ws, LAS unsigned char* lds, int tid, int lane, int wave, int bid, int G) {
    LAS float* scr = (LAS float*)(lds + wave * 16384);
    const int gw = bid * 8 + wave, NGW = G * 8;
    constexpr int I_IN = 16 * (NZ / 32), I_OUT = 16 * 32;
    for (int it = gw; it < NL * (I_IN + I_OUT); it += NGW) {
        const int l = it / (I_IN + I_OUT); int r = it % (I_IN + I_OUT);
        if (r < I_IN) { const int kb = r / (NZ / 32), nb = r % (NZ / 32); const int n0 = nb * 32;
            const float* cp = w_in + (size_t)l * DM * INW + win_srccol(n0 + (lane & 31));
            transpose_item(cp, INW, (bf16_t*)(ws + WS_WIN) + (size_t)l * NZ * DM, DM, kb * 64, n0, scr, lane);
        } else { r -= I_IN; const int kb = r / 32, nb = r % 32; const int n0 = nb * 32;
            const float* cp = w_out + (size_t)l * DM * DM + n0 + (lane & 31);
            transpose_item(cp, DM, (bf16_t*)(ws + WS_WOUT) + (size_t)l * DM * DM, DM, kb * 64, n0, scr, lane); }
    }
    {
        const double inv[8] = {1.0, 0.19392274474868576, 0.03760603093086393, 0.007292664737217109, 0.001414213562373095, 0.0002742481756762073, 5.318295896944988e-05, 1.031338537721246e-05};
        float* rt = (float*)(ws + WS_ROPE);
        for (int idx = bid * 512 + tid; idx < S * 8; idx += G * 512) { const int t = idx >> 3, i = idx & 7; double iv = inv[0];
#pragma unroll
            for (int q = 1; q < 8; ++q) iv = (i == q) ? inv[q] : iv;
            const double ang = (double)pos[t] * iv; rt[2 * idx] = (float)cos(ang); rt[2 * idx + 1] = (float)sin(ang); }
    }
    __syncthreads();
    LAS float* w12 = (LAS float*)lds;
    load_w12(w_in, w12, tid);
    __syncthreads();
    float* flf = (float*)(ws + SM_FLF); float* mli = (float*)(ws + SM_MLI); float* mlf = (float*)(ws + SM_MLF);
    bf16_t* xb = (bf16_t*)(ws + WS_ACTB);
#pragma unroll 2
    for (int t = gw; t < S; t += NGW) {
        f32x4 v[4];
#pragma unroll
        for (int j = 0; j < 4; ++j) v[j] = *(const f32x4*)(x + (size_t)t * DM + 256 * j + 4 * lane);
        store_row_bf16(v, xb + (size_t)t * DM, lane);
        gates_row(v, w12, bff, bmi, bmf, flf, mli, mlf, t, lane);
    }
    __syncthreads();
}

__device__ __forceinline__ void moe_weights(const float* w_gate_l, const float* w_up_l, const float* w_down_l, unsigned char* ws, LAS unsigned char* lds, int lane, int wave, int gw, int NGW, int it0, int it1) {
    LAS float* scr = (LAS float*)(lds + wave * 16384);
    constexpr int I_GU = 16 * 32, I_D = 8 * 32;
    for (int it = it0 + gw; it < it1; it += NGW) {
        const int e = it / (I_GU + I_D); int r = it % (I_GU + I_D);
        if (r < I_GU) { const int kb = r / 32, nb = r % 32, n0 = nb * 32; const int n = n0 + (lane & 31); const int a = n >> 3, b = n & 7; const int hid = 4 * a + (b & 3);
            const float* cp = ((b >> 2) ? w_up_l : w_gate_l) + (size_t)e * DM * DE + hid;
            transpose_item(cp, DE, (bf16_t*)(ws + WS_WGU) + (size_t)e * DM * DM, DM, kb * 64, n0, scr, lane);
        } else { r -= I_GU; const int kb = r / 32, nb = r % 32, n0 = nb * 32;
            const float* cp = w_down_l + (size_t)e * DE * DM + n0 + (lane & 31);
            transpose_item(cp, DM, (bf16_t*)(ws + WS_WD) + (size_t)e * DM * DE, DE, kb * 64, n0, scr, lane); }
    }
}
constexpr int HSCR_OFF = 112640, HSCR_WAVE = 4224;
__device__ __forceinline__ void transpose_half(const float* cp, int ld, bf16_t* WT, int Kd, int k0, int n0, LAS float* scr, int lane) {
    float tmp[16];
#pragma unroll
    for (int i = 0; i < 16; ++i) tmp[i] = cp[(size_t)(k0 + 2 * i + (lane >> 5)) * ld];
#pragma unroll
    for (int i = 0; i < 16; ++i) scr[(2 * i + (lane >> 5)) * 33 + (lane & 31)] = tmp[i];
    asm volatile("s_waitcnt vmcnt(0) lgkmcnt(0)" ::: "memory");
    const int c = lane & 3;
#pragma unroll
    for (int j = 0; j < 2; ++j) { const int n = (lane >> 2) + 16 * j; const LAS float* s = scr + (8 * c) * 33 + n;
        u32x4 o; o.x = pk2(s[0 * 33], s[1 * 33]); o.y = pk2(s[2 * 33], s[3 * 33]); o.z = pk2(s[4 * 33], s[5 * 33]); o.w = pk2(s[6 * 33], s[7 * 33]);
        *(u32x4*)(WT + (size_t)(n0 + n) * Kd + k0 + 8 * c) = o; }
    asm volatile("s_waitcnt lgkmcnt(0)" ::: "memory");
}
__device__ __forceinline__ void moe_half_item(const float* w_gate_l, const float* w_up_l, const float* w_down_l, unsigned char* ws, LAS unsigned char* lds, int lane, int wave, int first_item, int hi) {
    LAS float* scr = (LAS float*)(lds + HSCR_OFF + wave * HSCR_WAVE);
    constexpr int I_GU = 16 * 32, I_D = 8 * 32;
    const int it = first_item + (hi >> 1), kh = 32 * (hi & 1);
    const int e = it / (I_GU + I_D); int r = it % (I_GU + I_D);
    if (r < I_GU) { const int kb = r / 32, nb = r % 32, n0 = nb * 32; const int n = n0 + (lane & 31); const int a = n >> 3, b = n & 7; const int hid = 4 * a + (b & 3);
        const float* cp = ((b >> 2) ? w_up_l : w_gate_l) + (size_t)e * DM * DE + hid;
        transpose_half(cp, DE, (bf16_t*)(ws + WS_WGU) + (size_t)e * DM * DM, DM, kb * 64 + kh, n0, scr, lane);
    } else { r -= I_GU; const int kb = r / 32, nb = r % 32, n0 = nb * 32;
        const float* cp = w_down_l + (size_t)e * DE * DM + n0 + (lane & 31);
        transpose_half(cp, DM, (bf16_t*)(ws + WS_WD) + (size_t)e * DM * DE, DE, kb * 64 + kh, n0, scr, lane); }
}
constexpr int MOE_ITEMS = NE * (16 * 32 + 8 * 32);
constexpr int MOE_FILL = 6144;
__device__ __forceinline__ void mix1_unit(int u, unsigned char* ws, unsigned* ctl_kmax, LAS unsigned char* lds, int tid, int lane, int wave) {
    const int blk = u >> 2, h = u & 3, t0 = blk * 256;
    bf16_t* ZR = (bf16_t*)(ws + WS_ZR);
    const float* rope = (const float*)(ws + WS_ROPE);
    LAS float* kr = (LAS float*)lds;
    LAS float* part = (LAS float*)(lds + 16384);
    LAS float* sq = (LAS float*)(lds + 16384 + 2048);
    {
        const int tl = tid & 255, which = tid >> 8; const int t = t0 + tl;
        bf16_t* p = ZR + (size_t)t * ZRW + (which ? ZR_BK : ZR_BQ) + h * 64;
        const u32x4 w0 = *(const u32x4*)p, w1 = *(const u32x4*)(p + 8);
        float u1[8], u2[8];
        u1[0] = bflo(w0.x); u1[1] = bfhi(w0.x); u1[2] = bflo(w0.y); u1[3] = bfhi(w0.y); u1[4] = bflo(w0.z); u1[5] = bfhi(w0.z); u1[6] = bflo(w0.w); u1[7] = bfhi(w0.w);
        u2[0] = bflo(w1.x); u2[1] = bfhi(w1.x); u2[2] = bflo(w1.y); u2[3] = bfhi(w1.y); u2[4] = bflo(w1.z); u2[5] = bfhi(w1.z); u2[6] = bflo(w1.w); u2[7] = bfhi(w1.w);
        float o1[8], o2[8];
#pragma unroll
        for (int i = 0; i < 8; ++i) { const f32x2 cs = *(const f32x2*)(rope + ((size_t)t * 8 + i) * 2); o1[i] = u1[i] * cs.x - u2[i] * cs.y; o2[i] = u1[i] * cs.y + u2[i] * cs.x; }
        u32x4 r0, r1;
        r0.x = pk2(o1[0], o1[1]); r0.y = pk2(o1[2], o1[3]); r0.z = pk2(o1[4], o1[5]); r0.w = pk2(o1[6], o1[7]);
        r1.x = pk2(o2[0], o2[1]); r1.y = pk2(o2[2], o2[3]); r1.z = pk2(o2[4], o2[5]); r1.w = pk2(o2[6], o2[7]);
        *(u32x4*)p = r0; *(u32x4*)(p + 8) = r1;
        if (which) {
            LAS float* d = kr + tl * 16;
            d[0] = bflo(r0.x); d[1] = bfhi(r0.x); d[2] = bflo(r0.y); d[3] = bfhi(r0.y); d[4] = bflo(r0.z); d[5] = bfhi(r0.z); d[6] = bflo(r0.w); d[7] = bfhi(r0.w);
            d[8] = bflo(r1.x); d[9] = bfhi(r1.x); d[10] = bflo(r1.y); d[11] = bfhi(r1.y); d[12] = bflo(r1.z); d[13] = bfhi(r1.z); d[14] = bflo(r1.w); d[15] = bfhi(r1.w);
        }
    }
    {
        const int tl = tid & 255, half = tid >> 8;
        const bf16_t* p = ZR + (size_t)(t0 + tl) * ZRW + ZR_FK + h * 64 + half * 32;
        float s = 0.f;
#pragma unroll
        for (int j = 0; j < 4; ++j) { const u32x4 w = *(const u32x4*)(p + 8 * j);
            float a;
            a = bflo(w.x); s += a * a; a = bfhi(w.x); s += a * a; a = bflo(w.y); s += a * a; a = bfhi(w.y); s += a * a;
            a = bflo(w.z); s += a * a; a = bfhi(w.z); s += a * a; a = bflo(w.w); s += a * a; a = bfhi(w.w); s += a * a; }
        sq[tid] = s;
    }
    __syncthreads();
    {
        const int d = tid & 63, pp = tid >> 6; float s = 0.f;
        if (d < 16) { for (int i = 0; i < 32; ++i) s += kr[(pp * 32 + i) * 16 + d]; }
        else { const bf16_t* p = ZR + (size_t)(t0 + pp * 32) * ZRW + ZR_BK + h * 64 + d; for (int i = 0; i < 32; ++i) s += bf2f(p[(size_t)i * ZRW]); }
        part[pp * 64 + d] = s;
    }
    if (wave < 4) {
        const float* flf = (const float*)(ws + SM_FLF) + (size_t)h * S + t0 + wave * 64;
        float v = flf[lane];
#pragma unroll
        for (int o = 1; o < 64; o <<= 1) { const float n = __shfl_up(v, o); if (lane >= o) v += n; }
        ((float*)(ws + SM_FCL))[(size_t)h * S + t0 + wave * 64 + lane] = v;
        if (lane == 63) ((float*)(ws + SM_FTS))[h * 256 + blk * 4 + wave] = v;
    } else {
        const int i = tid - 256; float m = sq[i] + sq[i + 256];
        m = wave_max(m);
        if (lane == 0) atomicMax(ctl_kmax + h, __builtin_bit_cast(unsigned, m));
    }
    __syncthreads();
    if (tid < 64) { float s = 0.f;
#pragma unroll
        for (int pp = 0; pp < 8; ++pp) s += part[pp * 64 + tid];
        ((float*)(ws + SM_KMEAN))[((size_t)h * 64 + blk) * 64 + tid] = s * (1.f / 256.f); }
    __syncthreads();
}
struct RowState { f32x4 O[4]; float m, l; };
constexpr float LOG2E = 1.4426950408889634f, SC2 = 0.125f * LOG2E;

struct KVFrag { bf16x8 k[4]; u32x2 v[8]; };
__device__ __forceinline__ void kv_fetch(KVFrag& f, const bf16_t* krow, const bf16_t* vT, int kb, int lane) {
    const int qi = lane & 15, g = lane >> 4;
    const bf16_t* k0p = krow + (size_t)(kb + qi) * ZRW + 8 * g;
    const bf16_t* k1p = k0p + (size_t)16 * ZRW;
    f.k[0] = *(const bf16x8*)k0p; f.k[1] = *(const bf16x8*)(k0p + 32); f.k[2] = *(const bf16x8*)k1p; f.k[3] = *(const bf16x8*)(k1p + 32);
#pragma unroll
    for (int dt = 0; dt < 4; ++dt) { const bf16_t* vp = vT + (size_t)(16 * dt + qi) * ZTP + kb + 4 * g; f.v[2 * dt] = *(const u32x2*)vp; f.v[2 * dt + 1] = *(const u32x2*)(vp + 16); }
}
__device__ __forceinline__ void attn_compute32(RowState& st, const bf16x8 (&Qf)[2], const KVFrag& f, const f32x4 b0, const f32x4 b1) {
    f32x4 s0 = {0.f, 0.f, 0.f, 0.f}, s1 = {0.f, 0.f, 0.f, 0.f};
    s0 = MFMA16(f.k[0], Qf[0], s0); s0 = MFMA16(f.k[1], Qf[1], s0);
    s1 = MFMA16(f.k[2], Qf[0], s1); s1 = MFMA16(f.k[3], Qf[1], s1);
    float mx = -INFINITY;
#pragma unroll
    for (int r = 0; r < 4; ++r) { s0[r] = s0[r] * SC2 + b0[r]; s1[r] = s1[r] * SC2 + b1[r]; mx = fmaxf(mx, fmaxf(s0[r], s1[r])); }
    mx = grp_max(mx);
    float ps = 0.f; float p0[4], p1[4];
    if (__all(mx <= st.m)) {
#pragma unroll
        for (int r = 0; r < 4; ++r) { p0[r] = __builtin_amdgcn_exp2f(s0[r] - st.m); p1[r] = __builtin_amdgcn_exp2f(s1[r] - st.m); ps += p0[r] + p1[r]; }
        st.l += ps;
    } else {
        const float mn = fmaxf(st.m, mx);
        const float msafe = (mn == -INFINITY) ? 0.f : mn;
        const float alpha = __builtin_amdgcn_exp2f(st.m - msafe);
#pragma unroll
        for (int r = 0; r < 4; ++r) { p0[r] = __builtin_amdgcn_exp2f(s0[r] - msafe); p1[r] = __builtin_amdgcn_exp2f(s1[r] - msafe); ps += p0[r] + p1[r]; }
        st.l = st.l * alpha + ps; st.m = mn;
#pragma unroll
        for (int dt = 0; dt < 4; ++dt) st.O[dt] = st.O[dt] * alpha;
    }
    u32x4 pw; pw.x = pk2(p0[0], p0[1]); pw.y = pk2(p0[2], p0[3]); pw.z = pk2(p1[0], p1[1]); pw.w = pk2(p1[2], p1[3]);
    const bf16x8 pb = __builtin_bit_cast(bf16x8, pw);
#pragma unroll
    for (int dt = 0; dt < 4; ++dt) { u32x4 vw; vw.x = f.v[2 * dt].x; vw.y = f.v[2 * dt].y; vw.z = f.v[2 * dt + 1].x; vw.w = f.v[2 * dt + 1].y;
        st.O[dt] = MFMA16(__builtin_bit_cast(bf16x8, vw), pb, st.O[dt]); }
}
__device__ __forceinline__ void attn_finish(RowState& st, const float* gain, bf16_t* yrow, int lane) {
    const int g = lane >> 4;
    const float inv = 1.f / st.l; float ss = 0.f;
#pragma unroll
    for (int dt = 0; dt < 4; ++dt) { st.O[dt] = st.O[dt] * inv; ss += (st.O[dt].x * st.O[dt].x + st.O[dt].y * st.O[dt].y) + (st.O[dt].z * st.O[dt].z + st.O[dt].w * st.O[dt].w); }
    ss = grp_sum(ss);
    const float rs = rsqrtf(ss * (1.f / 64.f) + EPS);
#pragma unroll
    for (int dt = 0; dt < 4; ++dt) { const f32x4 gg = *(const f32x4*)(gain + 16 * dt + 4 * g); const f32x4 o = st.O[dt] * rs * gg;
        u32x2 w; w.x = pk2(o.x, o.y); w.y = pk2(o.z, o.w); *(u32x2*)(yrow + 16 * dt + 4 * g) = w; }
}

constexpr int KS_PITCH = 72, VS_PITCH = 264, KS_BYTES = 256 * KS_PITCH * 2, VS_BYTES = 64 * VS_PITCH * 2;
__device__ __forceinline__ void stage_kv_block(const bf16_t* krow  , const bf16_t* vT  , int key0, LAS unsigned char* lds, int tid) {
    LAS unsigned char* Ks = lds; LAS unsigned char* Vs = lds + KS_BYTES;
#pragma unroll
    for (int i = 0; i < 4; ++i) { const int c = tid + 512 * i; const int row = c >> 3, part = c & 7;
        const u32x4 v = *(const u32x4*)(krow + (size_t)(key0 + row) * ZRW + part * 8);
        *(LAS u32x4*)(Ks + row * (KS_PITCH * 2) + part * 16) = v; }
#pragma unroll
    for (int i = 0; i < 4; ++i) { const int c = tid + 512 * i; const int row = c >> 5, part = c & 31;
        const u32x4 v = *(const u32x4*)(vT + (size_t)row * ZTP + key0 + part * 8);
        *(LAS u32x4*)(Vs + row * (VS_PITCH * 2) + part * 16) = v; }
}
template <int VPB>
__device__ __forceinline__ void attn_step32_ldsp(RowState& st, const bf16x8 (&Qf)[2], LAS unsigned char* Ks, LAS unsigned char* Vs, int kb, const f32x4 b0, const f32x4 b1, int lane) {
    const int qi = lane & 15, g = lane >> 4;
    f32x4 s0 = {0.f, 0.f, 0.f, 0.f}, s1 = {0.f, 0.f, 0.f, 0.f};
    const LAS unsigned char* k0p = Ks + (kb + qi) * (KS_PITCH * 2) + 16 * g;
    const LAS unsigned char* k1p = k0p + 16 * (KS_PITCH * 2);
    s0 = MFMA16(*(const LAS bf16x8*)k0p, Qf[0], s0); s0 = MFMA16(*(const LAS bf16x8*)(k0p + 64), Qf[1], s0);
    s1 = MFMA16(*(const LAS bf16x8*)k1p, Qf[0], s1); s1 = MFMA16(*(const LAS bf16x8*)(k1p + 64), Qf[1], s1);
    float mx = -INFINITY;
#pragma unroll
    for (int r = 0; r < 4; ++r) { s0[r] = s0[r] * SC2 + b0[r]; s1[r] = s1[r] * SC2 + b1[r]; mx = fmaxf(mx, fmaxf(s0[r], s1[r])); }
    mx = grp_max(mx);
    float ps = 0.f; float p0[4], p1[4];
    if (__all(mx <= st.m)) {
#pragma unroll
        for (int r = 0; r < 4; ++r) { p0[r] = __builtin_amdgcn_exp2f(s0[r] - st.m); p1[r] = __builtin_amdgcn_exp2f(s1[r] - st.m); ps += p0[r] + p1[r]; }
        st.l += ps;
    } else {
        const float mn = fmaxf(st.m, mx);
        const float msafe = (mn == -INFINITY) ? 0.f : mn;
        const float alpha = __builtin_amdgcn_exp2f(st.m - msafe);
#pragma unroll
        for (int r = 0; r < 4; ++r) { p0[r] = __builtin_amdgcn_exp2f(s0[r] - msafe); p1[r] = __builtin_amdgcn_exp2f(s1[r] - msafe); ps += p0[r] + p1[r]; }
        st.l = st.l * alpha + ps; st.m = mn;
#pragma unroll
        for (int dt = 0; dt < 4; ++dt) st.O[dt] = st.O[dt] * alpha;
    }
    u32x4 pw; pw.x = pk2(p0[0], p0[1]); pw.y = pk2(p0[2], p0[3]); pw.z = pk2(p1[0], p1[1]); pw.w = pk2(p1[2], p1[3]);
    const bf16x8 pb = __builtin_bit_cast(bf16x8, pw);
#pragma unroll
    for (int dt = 0; dt < 4; ++dt) { const LAS unsigned char* vp = Vs + (16 * dt + qi) * VPB + (kb + 4 * g) * 2;
        u32x4 vw; const u32x2 lo = *(const LAS u32x2*)vp, hi = *(const LAS u32x2*)(vp + 32); vw.x = lo.x; vw.y = lo.y; vw.z = hi.x; vw.w = hi.y;
        st.O[dt] = MFMA16(__builtin_bit_cast(bf16x8, vw), pb, st.O[dt]); }
}

__device__ __forceinline__ void attn_step32_lds(RowState& st, const bf16x8 (&Qf)[2], LAS unsigned char* lds, int kb, const f32x4 b0, const f32x4 b1, int lane) {
    attn_step32_ldsp<VS_PITCH * 2>(st, Qf, lds, lds + KS_BYTES, kb, b0, b1, lane);
}

constexpr int FW_KEYS = 384, FW_VPB = (FW_KEYS + 8) * 2, FW_KBYTES = FW_KEYS * KS_PITCH * 2, FW_VBYTES = 64 * FW_VPB;
__device__ __forceinline__ void fox_unit(int h, int qt, unsigned char* ws, float kmaxn, const float* g_fox, LAS unsigned char* lds, int tid, int lane, int wave, int cap = 1 << 30, bf16_t* ydst = nullptr) {
    const int qi = lane & 15, g = lane >> 4;
    const int Q0 = qt * 128, q0 = Q0 + wave * 16, q = q0 + qi;
    const bf16_t* ZR = (const bf16_t*)(ws + WS_ZR); const bf16_t* ZT = (const bf16_t*)(ws + WS_ZT);
    const float* clh = (const float*)(ws + SM_FCL) + (size_t)h * S; const float* tsum = (const float*)(ws + SM_FTS) + h * 256;
    const bf16_t* krow = ZR + ZR_FK + h * 64; const bf16_t* vT = ZT + (size_t)(ZT_FV + h * 64) * ZTP;
    LAS unsigned char* Kw = lds; LAS unsigned char* Vw = lds + FW_KBYTES; LAS float* clw = (LAS float*)(lds + FW_KBYTES + FW_VBYTES);
    const int kw0 = Q0 >= 256 ? Q0 - 256 : 0, nk = Q0 + 128 - kw0;
    __syncthreads();
    for (int c = tid; c < nk * 8; c += 512) { const int row = c >> 3, part = c & 7;
        *(LAS u32x4*)(Kw + row * (KS_PITCH * 2) + part * 16) = *(const u32x4*)(krow + (size_t)(kw0 + row) * ZRW + part * 8); }
    { const int cpr = nk >> 3;
      for (int c = tid; c < 64 * cpr; c += 512) { const int row = c / cpr, part = c - row * cpr;
        *(LAS u32x4*)(Vw + row * FW_VPB + part * 16) = *(const u32x4*)(vT + (size_t)row * ZTP + kw0 + part * 8); } }
    for (int c = tid; c < nk; c += 512) clw[c] = clh[kw0 + c] * LOG2E;
    const bf16_t* qrow = ZR + (size_t)q * ZRW + ZR_FQ + h * 64;
    bf16x8 Qf[2]; Qf[0] = *(const bf16x8*)(qrow + 8 * g); Qf[1] = *(const bf16x8*)(qrow + 32 + 8 * g);
    float qs = 0.f;
#pragma unroll
    for (int k = 0; k < 2; ++k)
#pragma unroll
        for (int e = 0; e < 8; ++e) { const float v = bf2f((unsigned short)Qf[k][e]); qs += v * v; }
    const float qn = sqrtf(grp_sum(qs));
    const float cq = clh[q] * LOG2E;
    RowState st;
#pragma unroll
    for (int dt = 0; dt < 4; ++dt) st.O[dt] = (f32x4){0.f, 0.f, 0.f, 0.f};
    st.m = -INFINITY; st.l = 0.f;
    __syncthreads();
    float dT = 0.f; int ktile = q0 >> 6;
    int kb = q0 & ~31;
    bool more = true;
    for (; kb >= kw0; kb -= 32) {
        const int kt = kb >> 6;
        if (kt != ktile) { dT += tsum[kt] * LOG2E; ktile = kt; }
        const float bq = cq + dT; const int kl = kb - kw0;
        const f32x4 c0 = *(const LAS f32x4*)(clw + kl + 4 * g), c1 = *(const LAS f32x4*)(clw + kl + 16 + 4 * g);
        f32x4 b0, b1;
#pragma unroll
        for (int r = 0; r < 4; ++r) { b0[r] = (kb + 4 * g + r <= q) ? bq - c0[r] : -INFINITY; b1[r] = (kb + 16 + 4 * g + r <= q) ? bq - c1[r] : -INFINITY; }
        attn_step32_ldsp<FW_VPB>(st, Qf, Kw, Vw, kl, b0, b1, lane);
        if (kb == 0) { more = false; break; }
        const float bound = qn * kmaxn * SC2 + (bq - clw[kl]);
        if (__all(bound < st.m - 40.f * LOG2E)) { more = false; break; }
        if (--cap <= 0) { more = false; break; }
    }
    if (more) {
        KVFrag cur, nxt;
        kv_fetch(cur, krow, vT, kb, lane);
        for (; kb >= 0; kb -= 32) {
            if (kb >= 32) kv_fetch(nxt, krow, vT, kb - 32, lane);
            const int kt = kb >> 6;
            if (kt != ktile) { dT += tsum[kt] * LOG2E; ktile = kt; }
            const float bq = cq + dT;
            const f32x4 c0 = *(const f32x4*)(clh + kb + 4 * g), c1 = *(const f32x4*)(clh + kb + 16 + 4 * g);
            f32x4 b0, b1;
#pragma unroll
            for (int r = 0; r < 4; ++r) { b0[r] = bq - c0[r] * LOG2E; b1[r] = bq - c1[r] * LOG2E; }
            attn_compute32(st, Qf, cur, b0, b1);
            if (kb == 0) break;
            const float bound = qn * kmaxn * SC2 + (bq - clh[kb] * LOG2E);
            if (__all(bound < st.m - 40.f * LOG2E)) break;
            cur = nxt;
        }
    }
    st.l = grp_sum(st.l);
    attn_finish(st, g_fox + h * 64, (ydst ? ydst : (bf16_t*)(ws + WS_Y)) + (size_t)q * DM + h * 64, lane);
}

__device__ __forceinline__ void moba_gate_unit(int h, int qt, unsigned char* ws, LAS unsigned char* lds, int tid, int lane, int wave) {
    const int own = qt >> 1;
    unsigned* msel = (unsigned*)(ws + SM_MSEL) + (size_t)h * S;
    int* cntq = (int*)(ws + SM_CNTQ) + (size_t)h * 64 * 128;
    const int tq0 = qt * 128 + wave * 16;
    if (own == 0) { if (lane < 16) msel[tq0 + lane] = 0u; if (tid < 64) cntq[tid * 128 + qt] = 0; return; }
    LAS int* hist = (LAS int*)lds;
    __syncthreads();
    if (tid < 64) hist[tid] = 0;
    __syncthreads();
    const int qi = lane & 15, g = lane >> 4;
    const bf16_t* qrow = (const bf16_t*)(ws + WS_ZR) + (size_t)(tq0 + qi) * ZRW + ZR_BQ + h * 64;
    bf16x8 Qf[2]; Qf[0] = *(const bf16x8*)(qrow + 8 * g); Qf[1] = *(const bf16x8*)(qrow + 32 + 8 * g);
    const float* kmean = (const float*)(ws + SM_KMEAN) + (size_t)h * 64 * 64;
    float v[16];
#pragma unroll
    for (int tile = 0; tile < 4; ++tile) {
        f32x4 acc = {0.f, 0.f, 0.f, 0.f};
#pragma unroll
        for (int ks = 0; ks < 2; ++ks) {
            const float* kp = kmean + (size_t)(16 * tile + qi) * 64 + 32 * ks + 8 * g;
            const f32x4 a0 = *(const f32x4*)kp, a1 = *(const f32x4*)(kp + 4);
            u32x4 hi, lo;
            hi.x = pk2(a0.x, a0.y); hi.y = pk2(a0.z, a0.w); hi.z = pk2(a1.x, a1.y); hi.w = pk2(a1.z, a1.w);
            lo.x = pk2(a0.x - bflo(hi.x), a0.y - bfhi(hi.x)); lo.y = pk2(a0.z - bflo(hi.y), a0.w - bfhi(hi.y));
            lo.z = pk2(a1.x - bflo(hi.z), a1.y - bfhi(hi.z)); lo.w = pk2(a1.z - bflo(hi.w), a1.w - bfhi(hi.w));
            acc = MFMA16(__builtin_bit_cast(bf16x8, hi), Qf[ks], acc);
            acc = MFMA16(__builtin_bit_cast(bf16x8, lo), Qf[ks], acc);
        }
#pragma unroll
        for (int r = 0; r < 4; ++r) v[4 * tile + r] = (16 * tile + 4 * g + r < own) ? acc[r] : -INFINITY;
    }
    const int nv = own < 3 ? own : 3;
    unsigned sel = 0u;
#pragma unroll
    for (int k = 0; k < 3; ++k) {
        float lm = v[0]; int li = 4 * g;
#pragma unroll
        for (int e = 1; e < 16; ++e) { const int jj = 16 * (e >> 2) + 4 * g + (e & 3); if (v[e] > lm) { lm = v[e]; li = jj; } }
        const float gm = grp_max(lm);
        int cand = (lm == gm) ? li : 255;
        cand = min(cand, __shfl_xor(cand, 16)); cand = min(cand, __shfl_xor(cand, 32));
        sel |= (unsigned)cand << (8 * k);
#pragma unroll
        for (int e = 0; e < 16; ++e) { const int jj = 16 * (e >> 2) + 4 * g + (e & 3); if (jj == cand) v[e] = -INFINITY; }
    }
    if (g < nv) { const int j = (int)((sel >> (8 * g)) & 0xff);
        const int pos = __hip_atomic_fetch_add(hist + j, 1, __ATOMIC_RELAXED, __HIP_MEMORY_SCOPE_WORKGROUP);
        ((unsigned short*)(ws + T_QIDX))[(((size_t)h * 64 + j) * 128 + qt) * 128 + pos] = (unsigned short)((wave * 16 + qi) | (g << 7)); }
    if (g == 0) msel[tq0 + qi] = (sel & 0xffffffu) | ((unsigned)nv << 24);
    __syncthreads();
    if (tid < 64) cntq[tid * 128 + qt] = hist[tid];
}

__device__ __forceinline__ void moba_part_unit(int h, int j, int ch, int tot, unsigned char* ws, LAS unsigned char* lds, LAS unsigned char* ltab, int tid, int lane, int wave, int dbg = 0, bool staged = false) {
    LAS int* pfx = (LAS int*)(ltab + 2112);
    LAS unsigned* slice = (LAS unsigned*)(ltab + 2640);
    LAS int* wtot = (LAS int*)(ltab + 3664);
    const unsigned* msel = (const unsigned*)(ws + SM_MSEL) + (size_t)h * S;
    const int* cntq = (const int*)(ws + SM_CNTQ) + ((size_t)h * 64 + j) * 128;
    const bf16_t* ZR = (const bf16_t*)(ws + WS_ZR); const bf16_t* ZT = (const bf16_t*)(ws + WS_ZT);
    __syncthreads();
    if (!staged) stage_kv_block(ZR + ZR_BK + h * 64, ZT + (size_t)(ZT_BV + h * 64) * ZTP, j * 256, lds, tid);
    if (!staged && wave == 0) {
        int v0 = cntq[lane], v1 = cntq[64 + lane];
#pragma unroll
        for (int o = 1; o < 64; o <<= 1) { const int n0 = __shfl_up(v0, o), n1 = __shfl_up(v1, o); if (lane >= o) { v0 += n0; v1 += n1; } }
        v1 += __shfl(v0, 63);
        if (lane == 0) pfx[0] = 0;
        pfx[1 + lane] = v0; pfx[65 + lane] = v1;
    }
    __syncthreads();
    const int lo_pos = 256 * ch, hi_pos = (lo_pos + 256 < tot) ? lo_pos + 256 : tot;
    if (tid < hi_pos - lo_pos) {
        const int pos = lo_pos + tid;
        int a = 0, b = 127; while (a < b) { const int mid = (a + b + 1) >> 1; if (pfx[mid] <= pos) a = mid; else b = mid - 1; }
        const unsigned w = ((const unsigned short*)(ws + T_QIDX))[(((size_t)h * 64 + j) * 128 + a) * 128 + (pos - pfx[a])];
        slice[tid] = (unsigned)(a * 128 + (w & 127u)) | ((w >> 7) << 14);
    }
    __syncthreads();
    const int n = hi_pos - lo_pos;
    const int qi = lane & 15, g = lane >> 4;
    const int pA = wave * 16, pB = 128 + wave * 16;
    if (pA >= n) return;
    const bool hasB = pB < n;
    const bool vA = pA + qi < n, vB = pB + qi < n;
    const unsigned eA = slice[vA ? pA + qi : n - 1], eB = slice[vB ? pB + qi : n - 1];
    const int tA = eA & 0x3fff, rA = eA >> 14, tB = eB & 0x3fff, rB = eB >> 14;
    const bf16_t* qrA = ZR + (size_t)tA * ZRW + ZR_BQ + h * 64; const bf16_t* qrB = ZR + (size_t)tB * ZRW + ZR_BQ + h * 64;
    bf16x8 QA[2], QB[2]; QA[0] = *(const bf16x8*)(qrA + 8 * g); QA[1] = *(const bf16x8*)(qrA + 32 + 8 * g); QB[0] = *(const bf16x8*)(qrB + 8 * g); QB[1] = *(const bf16x8*)(qrB + 32 + 8 * g);
    RowState sA, sB;
#pragma unroll
    for (int dt = 0; dt < 4; ++dt) { sA.O[dt] = (f32x4){0.f, 0.f, 0.f, 0.f}; sB.O[dt] = (f32x4){0.f, 0.f, 0.f, 0.f}; }
    sA.m = -INFINITY; sA.l = 0.f; sB.m = -INFINITY; sB.l = 0.f;
    const f32x4 z = {0.f, 0.f, 0.f, 0.f};
    if (dbg & 1) { sA.l = 1.f; sB.l = 1.f; sA.m = 0.f; sB.m = 0.f; }
    else if (hasB) {
#pragma unroll 4
        for (int kb = 0; kb < 256; kb += 32) { attn_step32_lds(sA, QA, lds, kb, z, z, lane); attn_step32_lds(sB, QB, lds, kb, z, z, lane); } }
    else {
#pragma unroll 4
        for (int kb = 0; kb < 256; kb += 32) attn_step32_lds(sA, QA, lds, kb, z, z, lane); }
    if (dbg & 2) return;
    sA.l = grp_sum(sA.l);
    if (vA) {
        const float inv = 1.f / sA.l;
        bf16_t* po = (bf16_t*)(ws + T_MPO) + (((size_t)h * S + tA) * 3 + rA) * 64;
#pragma unroll
        for (int dt = 0; dt < 4; ++dt) { const f32x4 o = sA.O[dt] * inv; u32x2 w; w.x = pk2(o.x, o.y); w.y = pk2(o.z, o.w); *(u32x2*)(po + 16 * dt + 4 * g) = w; }
        if (g == 0) { float* pm = (float*)(ws + T_MPML) + (((size_t)h * S + tA) * 3 + rA) * 2; pm[0] = sA.m; pm[1] = sA.l; }
    }
    if (hasB) {
        sB.l = grp_sum(sB.l);
        if (vB) {
            const float inv = 1.f / sB.l;
            bf16_t* po = (bf16_t*)(ws + T_MPO) + (((size_t)h * S + tB) * 3 + rB) * 64;
#pragma unroll
            for (int dt = 0; dt < 4; ++dt) { const f32x4 o = sB.O[dt] * inv; u32x2 w; w.x = pk2(o.x, o.y); w.y = pk2(o.z, o.w); *(u32x2*)(po + 16 * dt + 4 * g) = w; }
            if (g == 0) { float* pm = (float*)(ws + T_MPML) + (((size_t)h * S + tB) * 3 + rB) * 2; pm[0] = sB.m; pm[1] = sB.l; }
        }
    }
}

__device__ __forceinline__ void moba_own_unit(int h, int ob, unsigned char* ws, const float* g_moba, LAS unsigned char* lds, int tid, int lane, int wave) {
    const int qi = lane & 15, g = lane >> 4;
    const bf16_t* ZR = (const bf16_t*)(ws + WS_ZR); const bf16_t* ZT = (const bf16_t*)(ws + WS_ZT);
    __syncthreads();
    stage_kv_block(ZR + ZR_BK + h * 64, ZT + (size_t)(ZT_BV + h * 64) * ZTP, ob * 256, lds, tid);
    __syncthreads();
    const int nv = ob < 3 ? ob : 3;
    for (int pass = 0; pass < 2; ++pass) {
        const int ql0 = pass * 128 + wave * 16, ql = ql0 + qi, q = ob * 256 + ql;
        const bf16_t* qrow = ZR + (size_t)q * ZRW + ZR_BQ + h * 64;
        bf16x8 Qf[2]; Qf[0] = *(const bf16x8*)(qrow + 8 * g); Qf[1] = *(const bf16x8*)(qrow + 32 + 8 * g);
        RowState st;
#pragma unroll
        for (int dt = 0; dt < 4; ++dt) st.O[dt] = (f32x4){0.f, 0.f, 0.f, 0.f};
        st.m = -INFINITY; st.l = 0.f;
        for (int kb = ql0 & ~31; kb >= 0; kb -= 32) {
            f32x4 b0, b1;
#pragma unroll
            for (int r = 0; r < 4; ++r) { b0[r] = (kb + 4 * g + r <= ql) ? 0.f : -INFINITY; b1[r] = (kb + 16 + 4 * g + r <= ql) ? 0.f : -INFINITY; }
            attn_step32_lds(st, Qf, lds, kb, b0, b1, lane);
        }
        st.l = grp_sum(st.l);
        for (int rk = 0; rk < nv; ++rk) {
            const float* pm = (const float*)(ws + T_MPML) + (((size_t)h * S + q) * 3 + rk) * 2;
            const float mk = pm[0], lk = pm[1];
            const float M = fmaxf(st.m, mk);
            const float a = __builtin_amdgcn_exp2f(st.m - M), b = lk * __builtin_amdgcn_exp2f(mk - M);
            const bf16_t* po = (const bf16_t*)(ws + T_MPO) + (((size_t)h * S + q) * 3 + rk) * 64;
#pragma unroll
            for (int dt = 0; dt < 4; ++dt) { const u32x2 w = *(const u32x2*)(po + 16 * dt + 4 * g);
                const f32x4 ok = {bflo(w.x), bfhi(w.x), bflo(w.y), bfhi(w.y)};
                st.O[dt] = st.O[dt] * a + ok * b; }
            st.l = st.l * a + b; st.m = M;
        }
        attn_finish(st, g_moba + h * 64, (bf16_t*)(ws + WS_Y) + (size_t)q * DM + 768 + h * 64, lane);
    }
}
constexpr int KT_PITCH = 136;

__device__ __forceinline__ void mlstm_local_unit(int h, int c, unsigned char* ws, const float* conv_w_l, LAS unsigned char* lds, int tid, int lane, int wave) {
    const int t0 = c * 128;
    LAS float* sws = (LAS float*)lds;
    LAS bf16_t* kT = (LAS bf16_t*)(lds + 1024);
    __syncthreads();
    if (wave == 0) {
        const float* mlf = (const float*)(ws + SM_MLF) + (size_t)h * S + t0; const float* mli = (const float*)(ws + SM_MLI) + (size_t)h * S + t0;
        float v0 = mlf[lane], v1 = mlf[64 + lane];
#pragma unroll
        for (int o = 1; o < 64; o <<= 1) { const float n0 = __shfl_up(v0, o), n1 = __shfl_up(v1, o); if (lane >= o) { v0 += n0; v1 += n1; } }
        const float tot0 = __shfl(v0, 63); v1 += tot0;
        const float blast = __shfl(v1, 63);
        const float li0 = mli[lane], li1 = mli[64 + lane];
        const float g0 = blast - v0 + li0, g1 = blast - v1 + li1;
        const float mloc = wave_max(fmaxf(g0, g1));
        sws[lane] = __expf(g0 - mloc); sws[64 + lane] = __expf(g1 - mloc);
        const float a0 = li0 - v0, a1 = li1 - v1;
        float p0 = a0, p1 = a1;
#pragma unroll
        for (int o = 1; o < 64; o <<= 1) { const float n0 = __shfl_up(p0, o), n1 = __shfl_up(p1, o); if (lane >= o) { p0 = fmaxf(p0, n0); p1 = fmaxf(p1, n1); } }
        p1 = fmaxf(p1, __shfl(p0, 63));
        float* mb = (float*)(ws + SM_MB) + (size_t)h * S + t0; float* ma = (float*)(ws + SM_MA) + (size_t)h * S + t0; float* mpx = (float*)(ws + SM_MPX) + (size_t)h * S + t0;
        mb[lane] = v0; mb[64 + lane] = v1; ma[lane] = a0; ma[64 + lane] = a1; mpx[lane] = p0; mpx[64 + lane] = p1;
        if (lane == 0) { float* sc = (float*)(ws + SM_MLSC); sc[h * 128 + c] = blast; sc[512 + h * 128 + c] = mloc; }
    }
    __syncthreads();
    {
        const bf16_t* ZR = (const bf16_t*)(ws + WS_ZR);
        bf16_t* QC = (bf16_t*)(ws + T_QC); bf16_t* KC = (bf16_t*)(ws + T_KC);
        const int r = tid & 31, which = r >> 4, cg = r & 15, tb = tid >> 5;
        const int ch = h * 128 + 8 * cg;
        float cw[4][8];
#pragma unroll
        for (int j = 0; j < 4; ++j) { const f32x4 c0 = *(const f32x4*)(conv_w_l + (size_t)j * 1024 + which * 512 + ch), c1 = *(const f32x4*)(conv_w_l + (size_t)j * 1024 + which * 512 + ch + 4);
            cw[j][0] = c0.x; cw[j][1] = c0.y; cw[j][2] = c0.z; cw[j][3] = c0.w; cw[j][4] = c1.x; cw[j][5] = c1.y; cw[j][6] = c1.z; cw[j][7] = c1.w; }
        const bf16_t* src = ZR + (which ? ZR_MK : ZR_MQ) + ch;
        u32x4 rw[11];
#pragma unroll
        for (int q = 0; q < 11; ++q) { const int tt = t0 + 8 * tb - 3 + q; rw[q] = (tt >= 0) ? *(const u32x4*)(src + (size_t)tt * ZRW) : (u32x4){0u, 0u, 0u, 0u}; }
        const float sc = which ? 0.08838834764831845f : 1.f;
#pragma unroll
        for (int q = 0; q < 8; ++q) {
            const int sl = 8 * tb + q;
            float acc[8];
#pragma unroll
            for (int e = 0; e < 8; ++e) acc[e] = 0.f;
#pragma unroll
            for (int j = 0; j < 4; ++j) { const u32x4 w = rw[q + j];
                acc[0] += bflo(w.x) * cw[j][0]; acc[1] += bfhi(w.x) * cw[j][1]; acc[2] += bflo(w.y) * cw[j][2]; acc[3] += bfhi(w.y) * cw[j][3];
                acc[4] += bflo(w.z) * cw[j][4]; acc[5] += bfhi(w.z) * cw[j][5]; acc[6] += bflo(w.w) * cw[j][6]; acc[7] += bfhi(w.w) * cw[j][7]; }
#pragma unroll
            for (int e = 0; e < 8; ++e) acc[e] = siluf(acc[e]) * sc;
            u32x4 o; o.x = pk2(acc[0], acc[1]); o.y = pk2(acc[2], acc[3]); o.z = pk2(acc[4], acc[5]); o.w = pk2(acc[6], acc[7]);
            *(u32x4*)((which ? KC : QC) + (size_t)(t0 + sl) * 512 + ch) = o;
            if (which) { const float w = sws[sl];
#pragma unroll
                for (int e = 0; e < 8; ++e) kT[(8 * cg + e) * KT_PITCH + sl] = (bf16_t)f2bf(acc[e] * w); }
        }
    }
    __syncthreads();
    {
        const int i = lane & 15, g = lane >> 4;
        const bf16_t* vT = (const bf16_t*)(ws + WS_ZT) + (size_t)(ZT_MV + h * 128 + 16 * wave + i) * ZTP + t0;
        f32x4 acc[8];
#pragma unroll
        for (int n = 0; n < 8; ++n) acc[n] = (f32x4){0.f, 0.f, 0.f, 0.f};
#pragma unroll
        for (int ks = 0; ks < 4; ++ks) {
            const bf16x8 a = *(const bf16x8*)(vT + 32 * ks + 8 * g);
#pragma unroll
            for (int n = 0; n < 8; ++n) { const bf16x8 b = *(const LAS bf16x8*)(kT + (16 * n + i) * KT_PITCH + 32 * ks + 8 * g); acc[n] = MFMA16(a, b, acc[n]); }
        }
        float* U = (float*)(ws + T_U) + ((size_t)(h * 128 + c) * 128) * 128;
#pragma unroll
        for (int n = 0; n < 8; ++n)
#pragma unroll
            for (int r = 0; r < 4; ++r) U[(size_t)(16 * wave + 4 * g + r) * 128 + 16 * n + i] = acc[n][r];
    }
    {
        const int i = lane & 15, g = lane >> 4;
        const bf16x8 ones = {(short)0x3f80, (short)0x3f80, (short)0x3f80, (short)0x3f80, (short)0x3f80, (short)0x3f80, (short)0x3f80, (short)0x3f80};
        f32x4 acc = {0.f, 0.f, 0.f, 0.f};
#pragma unroll
        for (int ks = 0; ks < 4; ++ks) { const bf16x8 b = *(const LAS bf16x8*)(kT + (16 * wave + i) * KT_PITCH + 32 * ks + 8 * g); acc = MFMA16(ones, b, acc); }
        if (g == 0) ((float*)(ws + SM_NLOC))[(size_t)(h * 128 + c) * 128 + 16 * wave + i] = acc[0];
    }
}

__device__ __forceinline__ void mlstm_scan(unsigned char* ws, LAS unsigned char* lds, int tid, int lane, int wave, int bid) {
    if (bid >= 256) return;
    const int h = bid >> 6;
    LAS float* dec = (LAS float*)lds; LAS float* scl = dec + 128;
    __syncthreads();
    if (wave == 0) {
        const float* sc = (const float*)(ws + SM_MLSC);
        const float bl0 = sc[h * 128 + lane], bl1 = sc[h * 128 + 64 + lane], ml0 = sc[512 + h * 128 + lane], ml1 = sc[512 + h * 128 + 64 + lane];
        float m = 0.f, mA = 0.f, mB = 0.f;
#pragma unroll 8
        for (int c = 0; c < 64; ++c) { if (lane == c) mA = m; m = fmaxf(__shfl(bl0, c) + m, __shfl(ml0, c)); }
#pragma unroll 8
        for (int c = 0; c < 64; ++c) { if (lane == c) mB = m; m = fmaxf(__shfl(bl1, c) + m, __shfl(ml1, c)); }
        const float mA1 = fmaxf(bl0 + mA, ml0), mB1 = fmaxf(bl1 + mB, ml1);
        dec[lane] = __expf(bl0 + mA - mA1); scl[lane] = __expf(ml0 - mA1); dec[64 + lane] = __expf(bl1 + mB - mB1); scl[64 + lane] = __expf(ml1 - mB1);
        if ((bid & 63) == 0) { float* mst = (float*)(ws + SM_MLSC) + 1024 + h * 128; mst[lane] = mA; mst[64 + lane] = mB; }
    }
    __syncthreads();
    if (tid < 256) {
        const int el = (bid & 63) * 256 + tid;
        const float* U = (const float*)(ws + T_U) + (size_t)h * 128 * 16384 + el;
        bf16_t* CS = (bf16_t*)(ws + T_CST) + (size_t)h * 128 * 16384 + el;
        float C = 0.f;
        for (int c0 = 0; c0 < 128; c0 += 32) { float u[32];
#pragma unroll
            for (int q = 0; q < 32; ++q) u[q] = U[(size_t)(c0 + q) * 16384];
#pragma unroll
            for (int q = 0; q < 32; ++q) { CS[(size_t)(c0 + q) * 16384] = (bf16_t)f2bf(C); C = dec[c0 + q] * C + scl[c0 + q] * u[q]; } }
    } else if (tid < 258) {
        const int el = (bid & 63) * 2 + (tid - 256);
        const float* NL_ = (const float*)(ws + SM_NLOC) + (size_t)h * 128 * 128 + el;
        float* NS = (float*)(ws + SM_NST) + (size_t)h * 128 * 128 + el;
        float n = 0.f;
        for (int c0 = 0; c0 < 128; c0 += 32) { float u[32];
#pragma unroll
            for (int q = 0; q < 32; ++q) u[q] = NL_[(c0 + q) * 128];
#pragma unroll
            for (int q = 0; q < 32; ++q) { NS[(c0 + q) * 128] = n; n = dec[c0 + q] * n + scl[c0 + q] * u[q]; } }
    }
}

constexpr int ML_PITCHB = 272, ML_MAT = 128 * ML_PITCHB;
__device__ __forceinline__ void mlstm_out_unit(int h, int c, unsigned char* ws, const float* g_mlstm, LAS unsigned char* lds, int tid, int lane, int wave) {
    const int i = lane & 15, g = lane >> 4;
    const int t0 = c * 128, tl = 16 * wave + i, t = t0 + tl;
    const bf16_t* QC = (const bf16_t*)(ws + T_QC); const bf16_t* KC = (const bf16_t*)(ws + T_KC);
    const bf16_t* ZT = (const bf16_t*)(ws + WS_ZT); const bf16_t* ZR = (const bf16_t*)(ws + WS_ZR);
    LAS unsigned char* Cs = lds; LAS unsigned char* Ks = lds + ML_MAT; LAS unsigned char* Vs = lds + 2 * ML_MAT;
    __syncthreads();
    {
        const bf16_t* CS = (const bf16_t*)(ws + T_CST) + ((size_t)(h * 128 + c) * 128) * 128;
        const bf16_t* kc = KC + (size_t)t0 * 512 + h * 128;
        const bf16_t* vt = ZT + (size_t)(ZT_MV + h * 128) * ZTP + t0;
#pragma unroll
        for (int q = 0; q < 4; ++q) { const int cc = tid + 512 * q; const int row = cc >> 4, part = cc & 15;
            const u32x4 a = *(const u32x4*)(CS + (size_t)row * 128 + part * 8);
            const u32x4 b = *(const u32x4*)(kc + (size_t)row * 512 + part * 8);
            const u32x4 d = *(const u32x4*)(vt + (size_t)row * ZTP + part * 8);
            *(LAS u32x4*)(Cs + row * ML_PITCHB + part * 16) = a; *(LAS u32x4*)(Ks + row * ML_PITCHB + part * 16) = b; *(LAS u32x4*)(Vs + row * ML_PITCHB + part * 16) = d; }
    }
    const float* ma = (const float*)(ws + SM_MA) + (size_t)h * S + t0;
    const float mc = ((const float*)(ws + SM_MLSC))[1024 + h * 128 + c];
    const float bt = ((const float*)(ws + SM_MB))[(size_t)h * S + t];
    const float Mx = fmaxf(mc, ((const float*)(ws + SM_MPX))[(size_t)h * S + t]);
    const float w_inter = __expf(mc - Mx);
    bf16x8 Qf[4];
#pragma unroll
    for (int ks = 0; ks < 4; ++ks) Qf[ks] = *(const bf16x8*)(QC + (size_t)t * 512 + h * 128 + 32 * ks + 8 * g);
    float qn = 0.f;
    {
        const float* ns = (const float*)(ws + SM_NST) + (size_t)(h * 128 + c) * 128;
#pragma unroll
        for (int ks = 0; ks < 4; ++ks) { const f32x4 n0 = *(const f32x4*)(ns + 32 * ks + 8 * g), n1 = *(const f32x4*)(ns + 32 * ks + 8 * g + 4);
            qn += bf2f((unsigned short)Qf[ks][0]) * n0.x + bf2f((unsigned short)Qf[ks][1]) * n0.y + bf2f((unsigned short)Qf[ks][2]) * n0.z + bf2f((unsigned short)Qf[ks][3]) * n0.w
                + bf2f((unsigned short)Qf[ks][4]) * n1.x + bf2f((unsigned short)Qf[ks][5]) * n1.y + bf2f((unsigned short)Qf[ks][6]) * n1.z + bf2f((unsigned short)Qf[ks][7]) * n1.w; }
        qn = grp_sum(qn);
    }
    u32x2 mow[8];
    {
        const bf16_t* mo = ZR + (size_t)t * ZRW + ZR_MO + h * 128;
#pragma unroll
        for (int dt = 0; dt < 8; ++dt) mow[dt] = *(const u32x2*)(mo + 16 * dt + 4 * g);
    }
    __syncthreads();
    f32x4 On[8];
#pragma unroll
    for (int dt = 0; dt < 8; ++dt) On[dt] = (f32x4){0.f, 0.f, 0.f, 0.f};
#pragma unroll
    for (int ks = 0; ks < 4; ++ks)
#pragma unroll
        for (int dt = 0; dt < 8; ++dt) { const bf16x8 a = *(const LAS bf16x8*)(Cs + (16 * dt + i) * ML_PITCHB + (32 * ks + 8 * g) * 2); On[dt] = MFMA16(a, Qf[ks], On[dt]); }
#pragma unroll
    for (int dt = 0; dt < 8; ++dt) On[dt] = On[dt] * w_inter;
    float den = 0.f;
    for (int sp = 0; sp <= (wave >> 1); ++sp) {
        f32x4 s0 = {0.f, 0.f, 0.f, 0.f}, s1 = {0.f, 0.f, 0.f, 0.f};
        const LAS unsigned char* k0p = Ks + (32 * sp + i) * ML_PITCHB + 16 * g;
        const LAS unsigned char* k1p = k0p + 16 * ML_PITCHB;
#pragma unroll
        for (int ks = 0; ks < 4; ++ks) { s0 = MFMA16(*(const LAS bf16x8*)(k0p + 64 * ks), Qf[ks], s0); s1 = MFMA16(*(const LAS bf16x8*)(k1p + 64 * ks), Qf[ks], s1); }
        const f32x4 a0 = *(const f32x4*)(ma + 32 * sp + 4 * g), a1 = *(const f32x4*)(ma + 32 * sp + 16 + 4 * g);
        float p0[4], p1[4];
#pragma unroll
        for (int r = 0; r < 4; ++r) {
            const int sl0 = 32 * sp + 4 * g + r, sl1 = sl0 + 16;
            p0[r] = (sl0 <= tl) ? s0[r] * __expf(a0[r] - Mx) : 0.f;
            p1[r] = (sl1 <= tl) ? s1[r] * __expf(a1[r] - Mx) : 0.f;
            den += p0[r] + p1[r];
        }
        u32x4 pw; pw.x = pk2(p0[0], p0[1]); pw.y = pk2(p0[2], p0[3]); pw.z = pk2(p1[0], p1[1]); pw.w = pk2(p1[2], p1[3]);
        const bf16x8 pb = __builtin_bit_cast(bf16x8, pw);
#pragma unroll
        for (int dt = 0; dt < 8; ++dt) { const LAS unsigned char* vp = Vs + (16 * dt + i) * ML_PITCHB + (32 * sp + 4 * g) * 2;
            u32x4 vw; const u32x2 lo = *(const LAS u32x2*)vp, hi = *(const LAS u32x2*)(vp + 32); vw.x = lo.x; vw.y = lo.y; vw.z = hi.x; vw.w = hi.y;
            On[dt] = MFMA16(__builtin_bit_cast(bf16x8, vw), pb, On[dt]); }
    }
    den = grp_sum(den) + w_inter * qn;
    const float dn = fmaxf(fabsf(den), __expf(-(bt + Mx)));
    const float inv = 1.f / dn;
    float ss = 0.f;
#pragma unroll
    for (int dt = 0; dt < 8; ++dt) { const u32x2 w = mow[dt];
        const f32x4 og = {sigmoidf(bflo(w.x)), sigmoidf(bfhi(w.x)), sigmoidf(bflo(w.y)), sigmoidf(bfhi(w.y))};
        On[dt] = On[dt] * inv * og;
        ss += (On[dt].x * On[dt].x + On[dt].y * On[dt].y) + (On[dt].z * On[dt].z + On[dt].w * On[dt].w); }
    ss = grp_sum(ss);
    const float rs = rsqrtf(ss * (1.f / 128.f) + EPS);
    bf16_t* yrow = (bf16_t*)(ws + WS_Y) + (size_t)t * DM + 256 + h * 128;
#pragma unroll
    for (int dt = 0; dt < 8; ++dt) { const f32x4 gg = *(const f32x4*)(g_mlstm + h * 128 + 16 * dt + 4 * g); const f32x4 o = On[dt] * rs * gg;
        u32x2 w; w.x = pk2(o.x, o.y); w.y = pk2(o.z, o.w); *(u32x2*)(yrow + 16 * dt + 4 * g) = w; }
}
struct SchedDenseIn {
    const char* X; const char* W; int G, c;
    __device__ __forceinline__ bool next(int i, pg8::GUnit& u) const {
        constexpr int nM = 64, nN = 14, nwg = nM * nN;
        const long L = (long)i * G + c; if (L >= nwg) return false;
        int wgid = (int)L; { const int q = nwg / pg8::NXCD, r = nwg % pg8::NXCD, xcd = wgid % pg8::NXCD, off = wgid / pg8::NXCD; wgid = (xcd < r ? xcd * (q + 1) : r * (q + 1) + (xcd - r) * q) + off; }
        const int nig = pg8::WGM * nN, gid = wgid / nig, fm = gid * pg8::WGM, gsz = (nM - fm) < pg8::WGM ? (nM - fm) : pg8::WGM;
        const int pm = fm + ((wgid % nig) % gsz), pn = (wgid % nig) / gsz;
        u.pm = pm; u.pn = pn; u.x0 = 0;
        if (pn < 10) { u.A = X + (size_t)pm * 256 * DM * 2; u.B = W + (size_t)pn * 256 * DM * 2; }
        else { u.A = W + (size_t)pn * 256 * DM * 2; u.B = X + (size_t)pm * 256 * DM * 2; }
        return true;
    }
};
struct EpiZ {
    bf16_t* ZR; bf16_t* ZT; int nostore;
    __device__ __forceinline__ void operator()(const f32x4 (&acc)[2][2][4][2], const pg8::GUnit& u, int wr, int wc, int fr, int fq) const {
        if (nostore) return;
        const bool sw = u.pn >= 10;
        bf16_t* base; size_t pitch;
        if (!sw) { base = ZR + (size_t)(256 * u.pm) * ZRW + 256 * u.pn; pitch = ZRW; }
        else { base = ZT + (size_t)(256 * (u.pn - 10)) * ZTP + 256 * u.pm; pitch = ZTP; }
#pragma unroll
        for (int ai = 0; ai < 2; ++ai)
#pragma unroll
            for (int m = 0; m < 4; ++m) { bf16_t* rowp = base + (size_t)(ai * 128 + wr * 64 + m * 16 + fr) * pitch + wc * 32 + 8 * fq;
#pragma unroll
                for (int bj = 0; bj < 2; ++bj) { const f32x4 v0 = acc[ai][bj][m][0], v1 = acc[ai][bj][m][1];
                    u32x4 w; w.x = pk2(v0[0], v0[1]); w.y = pk2(v0[2], v0[3]); w.z = pk2(v1[0], v1[1]); w.w = pk2(v1[2], v1[3]);
                    *(u32x4*)(rowp + bj * 128) = w; } }
    }
};
struct SchedDense4 {
    const char* X; const char* W; int K; int G, c;
    __device__ __forceinline__ bool next(int i, pg8::GUnit& u) const {
        const int L = i * G + c; if (L >= 256) return false;
        const int pm = L >> 2, pn = L & 3;
        u.pm = pm; u.pn = pn; u.x0 = 0;
        u.A = X + (size_t)pm * 256 * K * 2; u.B = W + (size_t)pn * 256 * K * 2;
        return true;
    }
};
template <bool XBF16> struct EpiPre1 {
    const void* xin; bf16_t* out;
    __device__ __forceinline__ void operator()(const f32x4 (&acc)[2][2][4][2], const pg8::GUnit& u, int wr, int wc, int fr, int fq) const {
#pragma unroll
        for (int ai = 0; ai < 2; ++ai)
#pragma unroll
            for (int m = 0; m < 4; ++m) { const size_t off = (size_t)(256 * u.pm + ai * 128 + wr * 64 + m * 16 + fr) * DM + 256 * u.pn + wc * 32 + 8 * fq;
#pragma unroll
                for (int bj = 0; bj < 2; ++bj) {
                    f32x4 x0, x1;
                    if (XBF16) { const u32x4 xw = *(const u32x4*)((const bf16_t*)xin + off + bj * 128); x0 = (f32x4){bflo(xw.x), bfhi(xw.x), bflo(xw.y), bfhi(xw.y)}; x1 = (f32x4){bflo(xw.z), bfhi(xw.z), bflo(xw.w), bfhi(xw.w)}; }
                    else { x0 = *(const f32x4*)((const float*)xin + off + bj * 128); x1 = *(const f32x4*)((const float*)xin + off + bj * 128 + 4); }
                    const f32x4 v0 = x0 * ALPHA + acc[ai][bj][m][0], v1 = x1 * ALPHA + acc[ai][bj][m][1];
                    u32x4 w; w.x = pk2(v0[0], v0[1]); w.y = pk2(v0[2], v0[3]); w.z = pk2(v1[0], v1[1]); w.w = pk2(v1[2], v1[3]);
                    *(u32x4*)(out + off + bj * 128) = w; } }
    }
};
__device__ __forceinline__ void moe_table(const unsigned* ecnt, LAS int* tab, int tid) {
    __syncthreads();
    if (tid < 64) {
        const int e = tid; const unsigned cnt_e = e < NE ? xb_ld((unsigned*)ecnt + e) : 0u; const int n = (int)((cnt_e + 255u) >> 8);
        if (e < NE) tab[216 + e] = (int)cnt_e;
        int inc = n;
#pragma unroll
        for (int o = 1; o < 32; o <<= 1) { const int v = __shfl_up(inc, o); if (e >= o) inc += v; }
        const int exc = inc - n;
        if (e < NE) { tab[1 + e] = exc; for (int j = 0; j < n; ++j) tab[40 + exc + j] = e; }
        if (e == NE - 1) { tab[1 + NE] = inc; tab[0] = inc; }
    }
    __syncthreads();
}
struct SchedMoE {
    const char* Abase; const char* Wbase; const LAS int* tab; size_t wstride; int K; int G, c; int maxr; const int* elist; unsigned* guc; unsigned* tmo;
    __device__ __forceinline__ int unit_of(int i, int U) const {
        if (elist) return i * G + c;
        const int r = U % G; if (r == 0) return i * G + c;
        const int nl = G - r;
        if (c >= r) return i < 2 ? i * nl + (c - r) : 2 * nl + (i - 2) * G + c;
        return 2 * nl + i * G + c;
    }
    __device__ __forceinline__ void a_ready(const pg8::GUnit& u, int wid, int lane) const {
        if (wid == 0) {
            unsigned polls = 0;
            while ((unsigned)__builtin_amdgcn_readfirstlane(__hip_atomic_load(guc + 16 * u.pm, __ATOMIC_RELAXED, __HIP_MEMORY_SCOPE_AGENT)) < 32u) {
                if ((++polls & 255u) == 0u) { if (__builtin_amdgcn_readfirstlane(__hip_atomic_load(tmo, __ATOMIC_RELAXED, __HIP_MEMORY_SCOPE_AGENT)) != 0u) break;
                    if (polls > (1u << 22)) { if (lane == 0) atomicAdd(tmo, 1u); break; } }
                __builtin_amdgcn_s_sleep(2); }
            asm volatile("s_waitcnt vmcnt(0)" ::: "memory");
        }
        asm volatile("" ::: "memory"); __builtin_amdgcn_s_barrier(); asm volatile("" ::: "memory");
    }
    __device__ __forceinline__ bool next(int i, pg8::GUnit& u) const {
        if (i >= maxr) return false;
        const int T = __builtin_amdgcn_readfirstlane(tab[0]); const int L = unit_of(i, 4 * T); if (L >= 4 * T) return false;
        const int tile = L >> 2, pn = L & 3; const int e = __builtin_amdgcn_readfirstlane(tab[40 + tile]);
        u.pm = tile; u.pn = pn; u.x0 = e;
        u.B = Wbase + (size_t)e * wstride + (size_t)pn * 256 * K * 2;
        if (elist) { u.A = Abase; u.list = elist + (size_t)e * S; u.l0 = 256 * (tile - __builtin_amdgcn_readfirstlane(tab[1 + e])); u.nl = __builtin_amdgcn_readfirstlane(tab[216 + e]); }
        else { u.A = Abase + (size_t)tile * 256 * K * 2; u.list = nullptr; u.l0 = 0; u.nl = 0; }
        return true;
    }
};
struct EpiGU {
    bf16_t* H; unsigned* guc;
    __device__ __forceinline__ void operator()(const f32x4 (&acc)[2][2][4][2], const pg8::GUnit& u, int wr, int wc, int fr, int fq) const {
#pragma unroll
        for (int ai = 0; ai < 2; ++ai)
#pragma unroll
            for (int m = 0; m < 4; ++m) { bf16_t* rowp = H + (size_t)(256 * u.pm + ai * 128 + wr * 64 + m * 16 + fr) * DE + (256 * u.pn + wc * 32 + 8 * fq) / 2;
#pragma unroll
                for (int bj = 0; bj < 2; ++bj) { const f32x4 gt = acc[ai][bj][m][0], up = acc[ai][bj][m][1];
                    const unsigned long long w = (unsigned long long)pk2(siluf(gt[0]) * up[0], siluf(gt[1]) * up[1]) | ((unsigned long long)pk2(siluf(gt[2]) * up[2], siluf(gt[3]) * up[3]) << 32);
                    __hip_atomic_store((unsigned long long*)(rowp + bj * 64), w, __ATOMIC_RELAXED, __HIP_MEMORY_SCOPE_AGENT); } }
        asm volatile("s_waitcnt vmcnt(0)" ::: "memory");
        if (fr == 0 && fq == 0) (void)__hip_atomic_fetch_add(guc + 16 * u.pm, 1u, __ATOMIC_RELAXED, __HIP_MEMORY_SCOPE_AGENT);
    }
};
struct EpiY {
    bf16_t* Y;
    __device__ __forceinline__ void operator()(const f32x4 (&acc)[2][2][4][2], const pg8::GUnit& u, int wr, int wc, int fr, int fq) const {
#pragma unroll
        for (int ai = 0; ai < 2; ++ai)
#pragma unroll
            for (int m = 0; m < 4; ++m) { bf16_t* rowp = Y + (size_t)(256 * u.pm + ai * 128 + wr * 64 + m * 16 + fr) * DM + 256 * u.pn + wc * 32 + 8 * fq;
#pragma unroll
                for (int bj = 0; bj < 2; ++bj) { const f32x4 v0 = acc[ai][bj][m][0], v1 = acc[ai][bj][m][1];
                    u32x4 w; w.x = pk2(v0[0], v0[1]); w.y = pk2(v0[2], v0[3]); w.z = pk2(v1[0], v1[1]); w.w = pk2(v1[2], v1[3]);
                    *(u32x4*)(rowp + bj * 128) = w; } }
    }
};

constexpr int R6_WG = 0, R6_WE = 16384, R6_G = 16384 + 131072, R6_B = R6_G + 4096, R6_END = R6_B + 4096;
static_assert(R6_END <= LDS_TAB, "router weights fit under the table region");
__device__ __forceinline__ void ln1_router_load(const float* g1, const float* b1, const float* w_grp, const float* w_er, LAS unsigned char* lds, int tid) {
    LAS float* wgT = (LAS float*)(lds + R6_WG); LAS float* weT = (LAS float*)(lds + R6_WE); LAS float* gg = (LAS float*)(lds + R6_G); LAS float* bb = (LAS float*)(lds + R6_B);
    for (int i = tid; i < 1024; i += 512) { const f32x4 w = *(const f32x4*)(w_grp + 4 * i); wgT[i] = w.x; wgT[1024 + i] = w.y; wgT[2048 + i] = w.z; wgT[3072 + i] = w.w; gg[i] = g1[i]; bb[i] = b1[i]; }
    for (int i = tid; i < 1024 * 8; i += 512) { const int k = i >> 3, c4 = (i & 7) * 4; const f32x4 w = *(const f32x4*)(w_er + (size_t)k * 32 + c4);
        weT[(c4 + 0) * 1024 + k] = w.x; weT[(c4 + 1) * 1024 + k] = w.y; weT[(c4 + 2) * 1024 + k] = w.z; weT[(c4 + 3) * 1024 + k] = w.w; }
}
__device__ __forceinline__ void ln1_router_row(int t, unsigned char* ws, const LAS unsigned char* lds, const float* b_grp, const float* b_er, unsigned* ecnt, int lane) {
    const LAS float* wgT = (const LAS float*)(lds + R6_WG); const LAS float* weT = (const LAS float*)(lds + R6_WE); const LAS float* gg = (const LAS float*)(lds + R6_G); const LAS float* bb = (const LAS float*)(lds + R6_B);
    const bf16_t* p1 = (const bf16_t*)(ws + WS_ZT) + (size_t)t * DM;
    f32x4 v[4];
#pragma unroll
    for (int j = 0; j < 4; ++j) { const u32x2 w = *(const u32x2*)(p1 + 256 * j + 4 * lane); v[j] = (f32x4){bflo(w.x), bfhi(w.x), bflo(w.y), bfhi(w.y)}; }
    {
        float s = 0.f;
#pragma unroll
        for (int j = 0; j < 4; ++j) s += (v[j].x + v[j].y) + (v[j].z + v[j].w);
        const float mean = wave_sum(s) * (1.f / DM); float s2 = 0.f;
#pragma unroll
        for (int j = 0; j < 4; ++j) { v[j] = v[j] - mean; s2 += (v[j].x * v[j].x + v[j].y * v[j].y) + (v[j].z * v[j].z + v[j].w * v[j].w); }
        const float rstd = rsqrtf(wave_sum(s2) * (1.f / DM) + EPS);
#pragma unroll
        for (int j = 0; j < 4; ++j) { const f32x4 g = *(const LAS f32x4*)(gg + 256 * j + 4 * lane), b = *(const LAS f32x4*)(bb + 256 * j + 4 * lane); v[j] = v[j] * rstd * g + b; }
    }
    store_row_bf16(v, (bf16_t*)(ws + WS_ACTB) + (size_t)t * DM, lane);
    float gl[4];
#pragma unroll
    for (int q = 0; q < 4; ++q) { float s = 0.f;
#pragma unroll
        for (int j = 0; j < 4; ++j) { const f32x4 w = *(const LAS f32x4*)(wgT + q * 1024 + 256 * j + 4 * lane); s += (v[j].x * w.x + v[j].y * w.y) + (v[j].z * w.z + v[j].w * w.w); }
        gl[q] = wave_sum(s) + b_grp[q]; }
    int gs = 0; float gm = gl[0];
#pragma unroll
    for (int q = 1; q < 4; ++q) if (gl[q] > gm) { gm = gl[q]; gs = q; }
    float den = 0.f;
#pragma unroll
    for (int q = 0; q < 4; ++q) den += __expf(gl[q] - gm);
    const float pg = 1.f / den;
    float el[8];
#pragma unroll
    for (int q = 0; q < 8; ++q) { float s = 0.f; const LAS float* wc = weT + (gs * 8 + q) * 1024;
#pragma unroll
        for (int j = 0; j < 4; ++j) { const f32x4 w = *(const LAS f32x4*)(wc + 256 * j + 4 * lane); s += (v[j].x * w.x + v[j].y * w.y) + (v[j].z * w.z + v[j].w * w.w); }
        el[q] = wave_sum(s) + b_er[gs * 8 + q]; }
    int i0 = 0; float v0 = el[0];
#pragma unroll
    for (int q = 1; q < 8; ++q) if (el[q] > v0) { v0 = el[q]; i0 = q; }
    int i1 = -1; float v1 = -INFINITY;
#pragma unroll
    for (int q = 0; q < 8; ++q) if (q != i0 && el[q] > v1) { v1 = el[q]; i1 = q; }
    const float e1 = __expf(v1 - v0); const float w0g = pg / (1.f + e1), w1g = pg * e1 / (1.f + e1);
    if (lane < 2) {
        const int e = gs * 8 + (lane == 0 ? i0 : i1);
        const unsigned slot = atomicAdd(ecnt + e, 1u);
        ((int*)(ws + SM_ELIST))[(size_t)e * S + slot] = t;
        ((int*)(ws + SM_EID))[2 * t + lane] = e; ((int*)(ws + SM_SLOT))[2 * t + lane] = (int)slot; ((float*)(ws + SM_WT))[2 * t + lane] = lane == 0 ? w0g : w1g;
    }
}
__device__ __forceinline__ void ln2_row(int t, unsigned char* ws, const LAS int* tab, const LAS float* g2, const LAS float* b2, float* out, bool last,
                                        const LAS float* w12, const float* bff, const float* bmi, const float* bmf, int lane, int dbg = 0) {
    const bf16_t* x1 = (const bf16_t*)(ws + WS_ACTB) + (size_t)t * DM;
    const int e0 = ((const int*)(ws + SM_EID))[2 * t], e1 = ((const int*)(ws + SM_EID))[2 * t + 1];
    const int s0 = ((const int*)(ws + SM_SLOT))[2 * t], s1 = ((const int*)(ws + SM_SLOT))[2 * t + 1];
    const float w0 = ((const float*)(ws + SM_WT))[2 * t], w1 = ((const float*)(ws + SM_WT))[2 * t + 1];
    const bf16_t* y0 = (const bf16_t*)(ws + T_YE) + (size_t)(256 * tab[1 + e0] + s0) * DM; const bf16_t* y1 = (const bf16_t*)(ws + T_YE) + (size_t)(256 * tab[1 + e1] + s1) * DM;
    f32x4 v[4];
#pragma unroll
    for (int j = 0; j < 4; ++j) { const u32x2 xw = *(const u32x2*)(x1 + 256 * j + 4 * lane);
        const f32x4 x = {bflo(xw.x), bfhi(xw.x), bflo(xw.y), bfhi(xw.y)};
        const u32x2 a = *(const u32x2*)(y0 + 256 * j + 4 * lane), b = *(const u32x2*)(y1 + 256 * j + 4 * lane);
        const f32x4 ya = {bflo(a.x), bfhi(a.x), bflo(a.y), bfhi(a.y)}, yb = {bflo(b.x), bfhi(b.x), bflo(b.y), bfhi(b.y)};
        v[j] = x * ALPHA + ya * w0 + yb * w1; }
    {
        float s = 0.f;
#pragma unroll
        for (int j = 0; j < 4; ++j) s += (v[j].x + v[j].y) + (v[j].z + v[j].w);
        const float mean = wave_sum(s) * (1.f / DM); float s2 = 0.f;
#pragma unroll
        for (int j = 0; j < 4; ++j) { v[j] = v[j] - mean; s2 += (v[j].x * v[j].x + v[j].y * v[j].y) + (v[j].z * v[j].z + v[j].w * v[j].w); }
        const float rstd = rsqrtf(wave_sum(s2) * (1.f / DM) + EPS);
#pragma unroll
        for (int j = 0; j < 4; ++j) { const f32x4 g = *(const LAS f32x4*)(g2 + 256 * j + 4 * lane), b = *(const LAS f32x4*)(b2 + 256 * j + 4 * lane); v[j] = v[j] * rstd * g + b; }
    }
    if (dbg & 1) { if (!(dbg & 2) && !last) gates_row(v, w12, bff, bmi, bmf, (float*)(ws + WS_ROPE), (float*)(ws + WS_ROPE), (float*)(ws + WS_ROPE), -1, lane); return; }
    if (last) {
#pragma unroll
        for (int j = 0; j < 4; ++j) *(f32x4*)(out + (size_t)t * DM + 256 * j + 4 * lane) = v[j];
    } else {
        store_row_bf16(v, (bf16_t*)(ws + WS_ACTB) + (size_t)t * DM, lane);
        gates_row(v, w12, bff, bmi, bmf, (float*)(ws + SM_FLF), (float*)(ws + SM_MLI), (float*)(ws + SM_MLF), t, lane);
    }
}

__device__ __forceinline__ const void* ldarg(int k) { int kk = k; asm volatile("" : "+s"(kk)); return ((const void* const*)__builtin_amdgcn_kernarg_segment_ptr())[kk]; }
#ifndef PH_MASK
#define PH_MASK 0x7ff
#endif
#define PHM(k) (((PH_MASK) >> (k)) & 1)
#define IN(k) (lo <= (k) && (k) < hi)
#define SEAM(k) do { if (IN(k) && IN((k) + 1)) { XcdBarrier _b; _b.bar = (unsigned*)ldarg(23) + CW_BAR; _b.x = xb_xcc_id(); _b.st = (volatile LAS unsigned*)(lds + LDS_MISC); xcd_barrier(_b, wave0 == 0 && __builtin_amdgcn_mbcnt_hi(~0u, __builtin_amdgcn_mbcnt_lo(~0u, 0u)) == 0u); } } while (0)
#define VCU ((G % 8 == 0) ? (bid % 8) * (G / 8) + bid / 8 : bid)
#define MOE_HALF(slot) moe_half_item(INP(17) + (size_t)l * NE * DM * DE, INP(18) + (size_t)l * NE * DM * DE, INP(19) + (size_t)l * NE * DE * DM, ws, lds, lane, wave, MOE_FILL, (slot) * NGW + gw)
#define PHASE_IDS unsigned char* ws = (unsigned char*)ldarg(23); unsigned* ctl = (unsigned*)ws; float* outp = (float*)ldarg(22); (void)ctl; (void)outp; int tid = wave0 * 64 + (int)__builtin_amdgcn_mbcnt_hi(~0u, __builtin_amdgcn_mbcnt_lo(~0u, 0u)); asm volatile("" : "+v"(tid)); const int lane = tid & 63, wave = __builtin_amdgcn_readfirstlane(tid >> 6); const int gw = bid * 8 + wave, NGW = G * 8; (void)lane; (void)gw; (void)NGW;
#define INP(k) ((const float*)ldarg(k))
template <int l>
__device__ __forceinline__ void layer_phases(LAS unsigned char* lds, const int wave0, const int bid, const int G, const int lo, const int hi, const int sub) {
    constexpr int P = 1 + 10 * l;

        if (PHM(0) && IN(P + 0)) { PHASE_IDS;
            SchedDenseIn Sd{(const char*)(ws + WS_ACTB), (const char*)(ws + WS_WIN) + (size_t)l * NZ * DM * 2, G, bid};
            EpiZ E{(bf16_t*)(ws + WS_ZR), (bf16_t*)(ws + WS_ZT), (sub >> 12) & 1};
            pg8::gemm_phase<EpiZ, SchedDenseIn>(lds, DM, Sd, E, tid);
            if (G == 256 && bid >= 128 && !((sub >> 13) & 1))
                moe_weights(INP(17) + (size_t)l * NE * DM * DE, INP(18) + (size_t)l * NE * DM * DE, INP(19) + (size_t)l * NE * DE * DM, ws, lds, lane, wave, (bid - 128) * 8 + wave, 128 * 8, 0, MOE_FILL);
        }
        SEAM(P + 0);
        if (PHM(1) && IN(P + 1)) { PHASE_IDS;
            if (sub & 1) for (int u = bid; u < 256; u += G) mix1_unit(u, ws, ctl + CW_KMAX(l), lds, tid, lane, wave);
            if ((sub & 2) && G != 256) { const bool split = false;
                moe_weights(INP(17) + (size_t)l * NE * DM * DE, INP(18) + (size_t)l * NE * DM * DE, INP(19) + (size_t)l * NE * DE * DM, ws, lds, lane, wave, gw, NGW, split ? MOE_FILL : 0, MOE_ITEMS); }
        }
        SEAM(P + 1);
        if (PHM(2) && IN(P + 2)) { PHASE_IDS;
            for (int u = VCU; u < 1536; u += G) {
                const int ty = u >> 9, r = u & 511, h = r >> 7, q = r & 127;
                if (!((sub >> ty) & 1)) continue;
                if (ty == 0) { const float kmaxn = sqrtf(__builtin_bit_cast(float, xb_ld(ctl + CW_KMAX(l) + h))); fox_unit(h, q, ws, kmaxn, INP(7) + l * 256, lds, tid, lane, wave, (sub & 256) ? 1 : ((sub & 512) ? 3 : (1 << 30)), (sub & 768) ? (bf16_t*)(ws + WS_X1) : nullptr); }
                else if (ty == 1) mlstm_local_unit(h, q, ws, INP(6) + (size_t)l * 4 * 1024, lds, tid, lane, wave);
                else moba_gate_unit(h, q, ws, lds, tid, lane, wave);
                if (G == 256) { const int ui = u >> 8;
                    MOE_HALF(2 * ui); MOE_HALF(2 * ui + 1); }
            }
        }
        SEAM(P + 2);
        if (PHM(3) && IN(P + 3)) { PHASE_IDS;
            if (sub & 1) for (int vb = bid; vb < 256; vb += G) mlstm_scan(ws, lds, tid, lane, wave, vb);
            LAS unsigned char* ltab = lds + LDS_TAB;
            LAS int* tot = (LAS int*)ltab;
            LAS int* pre = (LAS int*)(ltab + 1024);
            __syncthreads();
            if (tid < 256) { const int* cq = (const int*)(ws + SM_CNTQ) + (size_t)tid * 128; int a = 0;
                for (int i = 0; i < 128; i += 4) { const u32x4 v = *(const u32x4*)(cq + i); a += (int)(v.x + v.y + v.z + v.w); }
                tot[tid] = a; pre[tid] = (a + 255) >> 8; }
            __syncthreads();
            if (tid < 64) {
                const int c0 = pre[4 * tid], c1 = pre[4 * tid + 1], c2 = pre[4 * tid + 2], c3 = pre[4 * tid + 3]; const int tsum = c0 + c1 + c2 + c3; int inc = tsum;
#pragma unroll
                for (int o = 1; o < 64; o <<= 1) { const int v = __shfl_up(inc, o); if (tid >= o) inc += v; }
                const int exc = inc - tsum;
                pre[4 * tid] = exc; pre[4 * tid + 1] = exc + c0; pre[4 * tid + 2] = exc + c0 + c1; pre[4 * tid + 3] = exc + c0 + c1 + c2;
                if (tid == 63) pre[256] = inc;
            }
            __syncthreads();
            const int total = (sub & 2) ? pre[256] : 0;
            const int per = (total + G - 1) / G; const int u0 = VCU * per, u1 = (u0 + per < total) ? u0 + per : total;
            int prev = -1;
            for (int u = u0; u < u1; ++u) {
                int loi = 0, hii = 255;
                while (loi < hii) { const int mid = (loi + hii + 1) >> 1; if (pre[mid] <= u) loi = mid; else hii = mid - 1; }
                moba_part_unit(loi >> 6, loi & 63, u - pre[loi], tot[loi], ws, lds, ltab, tid, lane, wave, (sub >> 10) & 3, loi == prev);
                prev = loi;
            }
        }
        SEAM(P + 3);
        if (PHM(4) && IN(P + 4)) { PHASE_IDS;
            for (int u = VCU; u < 768; u += G) {
                if (u < 512) { if (sub & 1) mlstm_out_unit(u >> 7, u & 127, ws, INP(8) + l * 512, lds, tid, lane, wave); }
                else if (sub & 2) { const int r = u - 512; moba_own_unit(r >> 6, r & 63, ws, INP(9) + l * 256, lds, tid, lane, wave); }
                if (G == 256) { const int ui = u >> 8;
                    MOE_HALF(12 + 2 * ui); MOE_HALF(13 + 2 * ui); }
            }
        }
        SEAM(P + 4);
        if (PHM(5) && IN(P + 5)) { PHASE_IDS;
            SchedDense4 Sd{(const char*)(ws + WS_Y), (const char*)(ws + WS_WOUT) + (size_t)l * DM * DM * 2, DM, G, (G % 8 == 0) ? (bid % 8) * (G / 8) + bid / 8 : bid};
            EpiPre1<(l > 0)> E{l == 0 ? (const void*)INP(0) : (const void*)(ws + WS_ACTB), (bf16_t*)(ws + WS_ZT)};
            pg8::gemm_phase<EpiPre1<(l > 0)>, SchedDense4>(lds, DM, Sd, E, tid);
        }
        SEAM(P + 5);
        if (PHM(6) && IN(P + 6)) { PHASE_IDS;
            ln1_router_load(INP(11) + l * DM, INP(12) + l * DM, INP(13) + (size_t)l * DM * 4, INP(15) + (size_t)l * DM * 32, lds, tid);
            __syncthreads();
            const float* bgp = INP(14) + l * 4; const float* bep = INP(16) + l * 32;
#pragma unroll 8
            for (int t = gw; t < S; t += NGW)
                ln1_router_row(t, ws, lds, bgp, bep, ctl + CW_ECNT(l), lane);
            __syncthreads();
        }
        SEAM(P + 6);
        if (PHM(7) && IN(P + 7)) { PHASE_IDS;
            LAS int* tab = (LAS int*)(lds + LDS_TAB);
            moe_table(ctl + CW_ECNT(l), tab, tid);
            SchedMoE Sm{(const char*)(ws + WS_ACTB), (const char*)(ws + WS_WGU), tab, (size_t)DM * DM * 2, DM, G, (G % 8 == 0) ? (bid % 8) * (G / 8) + bid / 8 : bid, (sub & 16) ? 1 : ((sub & 32) ? 2 : 1000), (const int*)(ws + SM_ELIST), nullptr, nullptr};
            EpiGU E{(bf16_t*)(ws + T_H), ctl + CW_GUC(l)};
            pg8::gemm_phase<EpiGU, SchedMoE, true>(lds, DM, Sm, E, tid, (LAS unsigned*)(lds + LDS_TAB + 1024));
        }
        if (PHM(8) && IN(P + 8)) { PHASE_IDS;
            LAS int* tab = (LAS int*)(lds + LDS_TAB);
            if (!IN(P + 7)) moe_table(ctl + CW_ECNT(l), tab, tid);
            SchedMoE Sm{(const char*)(ws + T_H), (const char*)(ws + WS_WD), tab, (size_t)DM * DE * 2, DE, G, (G % 8 == 0) ? (bid % 8) * (G / 8) + bid / 8 : bid, (sub & 16) ? 1 : ((sub & 32) ? 2 : 1000), nullptr, ctl + CW_GUC(l), ctl + CW_BAR + XB_TMO};
            EpiY E{(bf16_t*)(ws + T_YE)};
            pg8::gemm_phase<EpiY, SchedMoE, false, true>(lds, DE, Sm, E, tid);
        }
        SEAM(P + 8);
        if (PHM(9) && IN(P + 9)) { PHASE_IDS;
            LAS int* tab = (LAS int*)(lds + LDS_TAB);
            if (!IN(P + 7)) moe_table(ctl + CW_ECNT(l), tab, tid);
            const bool last = (l == NL - 1);
            LAS float* w12 = (LAS float*)lds;
            if (!last) { load_w12(INP(2) + (size_t)(l + 1) * DM * INW, w12, tid); __syncthreads(); }
            LAS float* g2l = (LAS float*)(lds + 49152); LAS float* b2l = g2l + 1024;
            { const float* g2p = INP(20) + l * DM; const float* b2p = INP(21) + l * DM; for (int i = tid; i < 1024; i += 512) { g2l[i] = g2p[i]; b2l[i] = b2p[i]; } }
            __syncthreads();
            const float* bffp = INP(3) + (l + 1) * 4; const float* bmip = INP(4) + (l + 1) * 4; const float* bmfp = INP(5) + (l + 1) * 4;
#pragma unroll 8
            for (int t = gw; t < S; t += NGW)
                ln2_row(t, ws, tab, g2l, b2l, outp, last, w12, bffp, bmip, bmfp, lane, (sub >> 14) & 3);
            __syncthreads();
        }
        SEAM(P + 9);
}
struct Args { const void* in[22]; float* out; unsigned char* ws; int ph_lo, ph_hi, sub, pad; };
__global__ void __launch_bounds__(512, 2) fwd(Args args) {
    extern __shared__ __attribute__((aligned(16))) unsigned char lds_raw[];
    LAS unsigned char* lds = (LAS unsigned char*)lds_raw;
    const int tid0 = threadIdx.x; const int wave0 = __builtin_amdgcn_readfirstlane(tid0 >> 6);
    const int bid = blockIdx.x, G = gridDim.x;
    if (tid0 < 4) ((LAS unsigned*)(lds + LDS_MISC))[tid0] = 0u;
    __syncthreads();
    const int lo = args.ph_lo, hi = args.ph_hi;
    if (hi - lo > 1 && lo != 99) (void)xcd_barrier_post((unsigned*)ldarg(23) + CW_BAR, (volatile LAS unsigned*)(lds + LDS_MISC));
    if (PHM(10) && IN(0)) { PHASE_IDS; p0_prologue(INP(0), (const int*)ldarg(1), INP(2), INP(10), INP(3), INP(4), INP(5), ws, lds, tid, lane, wave, bid, G); }
    SEAM(0);
    layer_phases<0>(lds, wave0, bid, G, lo, hi, args.sub);
    layer_phases<1>(lds, wave0, bid, G, lo, hi, args.sub);
#undef IN
#undef SEAM
}

extern "C" void kernel_launch(void* const* d_in, const int* in_sizes, int n_in, void* d_out, int out_size, void* d_ws, size_t ws_size, hipStream_t stream) {
    static int grid = 0;
    if (grid == 0) {
        if (n_in != 22 || out_size != S * DM || ws_size < WS_END) { fprintf(stderr, "kernel_launch: unexpected shapes (n_in %d, out %d, ws %zu < %zu); nothing launched\n", n_in, out_size, ws_size, (size_t)WS_END); grid = -1; return; }
        int dev = 0, cus = 0;
        if (hipGetDevice(&dev) != hipSuccess || hipDeviceGetAttribute(&cus, hipDeviceAttributeMultiprocessorCount, dev) != hipSuccess) { grid = -1; return; }
        if (hipFuncSetAttribute((const void*)fwd, hipFuncAttributeMaxDynamicSharedMemorySize, LDS_BYTES) != hipSuccess) { fprintf(stderr, "kernel_launch: hipFuncSetAttribute failed\n"); grid = -1; return; }
        int per_cu = 0;
        (void)hipOccupancyMaxActiveBlocksPerMultiprocessor(&per_cu, (const void*)fwd, 512, LDS_BYTES);
        (void)hipGetLastError();
        if (per_cu < 1) fprintf(stderr, "kernel_launch: occupancy query reports %d blocks per CU\n", per_cu);
        grid = cus > 0 ? cus : 256;
    }
    if (grid < 0) return;
    (void)hipMemsetAsync((char*)d_ws + WS_CTL, 0, CTL_BYTES, stream);
    Args a{};
    for (int i = 0; i < 22; ++i) a.in[i] = d_in[i];
    a.out = (float*)d_out; a.ws = (unsigned char*)d_ws; a.sub = 7;
    if (N_LAUNCHES == 1) {
        a.ph_lo = 0; a.ph_hi = NPH;
        hipLaunchKernelGGL(fwd, dim3(grid), dim3(512), LDS_BYTES, stream, a);
    } else {
        for (int p = 0; p < NPH; ++p) { a.ph_lo = p; a.ph_hi = p + 1; hipLaunchKernelGGL(fwd, dim3(grid), dim3(512), LDS_BYTES, stream, a);
#ifdef DUP_MASK
            if (((unsigned long long)(DUP_MASK) >> p) & 1ull) { a.sub = DUP_SUB; hipLaunchKernelGGL(fwd, dim3(grid), dim3(512), LDS_BYTES, stream, a); a.sub = 7; }
#endif
        }
    }
}
```
